# Optimizing an MI355X kernel written in HIP

```python
import math
import jax, jax.numpy as jnp
from jax import lax
import numpy as np

D_MODEL = 1024
BATCH = 16
SEQ = 4096
DEPTH = 1

MIX_WIDTH = D_MODEL
DA_HEADS = 4
DA_QK_DIM = 64
DA_V_DIM = 2 * DA_QK_DIM
DA_WIDTH = DA_HEADS * DA_V_DIM
Q_BLOCK = 128
ML_HEADS = 4
ML_QK_DIM = 64
ML_V_DIM = 128
ML_WIDTH = ML_HEADS * ML_V_DIM
ML_CONV = 4
ML_CHUNK = 64
FORGET_BIAS_LO = 3.0
FORGET_BIAS_HI = 6.0
REL_BUCKETS = 32
REL_MAX_DIST = 128
N_EXPERTS = 32
TOP_K = 4
D_FF = D_MODEL
SWIGLU_LIMIT = 7.0
SWIGLU_ALPHA = 1.702
MOE_BLOCK = 128
NORM_EPS = 1e-5
DA_Q_COLS = DA_HEADS * 2 * DA_QK_DIM
DA_K_COLS = DA_HEADS * 2 * DA_QK_DIM
DA_V_COLS = DA_WIDTH
ML_Q_COLS = ML_HEADS * ML_QK_DIM
ML_K_COLS = ML_HEADS * ML_QK_DIM
ML_V_COLS = ML_WIDTH
ML_O_COLS = ML_WIDTH
ML_GATE_COLS = 2 * ML_HEADS
IN_COLS = DA_Q_COLS + DA_K_COLS + DA_V_COLS + ML_Q_COLS + ML_K_COLS + ML_V_COLS + ML_O_COLS + ML_GATE_COLS

kernel_name = "hymba_diffattn_mlstm_moe_block"


def rms_norm(x, g):
    xf = x.astype(jnp.float32)
    y = xf * lax.rsqrt(jnp.mean(xf * xf, axis=-1, keepdims=True) + NORM_EPS)
    return (y * g.astype(jnp.float32)).astype(x.dtype)


def head_rms_norm(x, g):
    H, d = x.shape[-2], x.shape[-1]
    return rms_norm(x, g.reshape(H, d))


def lambda_init_fn(layer):
    return 0.8 - 0.6 * math.exp(-0.3 * layer)


def t5_bucket(rel):
    n = jnp.maximum(rel, 0)
    max_exact = REL_BUCKETS // 2
    nf = jnp.maximum(n, 1).astype(jnp.float32)
    large = max_exact + (jnp.log(nf / max_exact) / math.log(REL_MAX_DIST / max_exact)
                         * (REL_BUCKETS - max_exact)).astype(jnp.int32)
    large = jnp.minimum(large, REL_BUCKETS - 1)
    return jnp.where(n < max_exact, n, large)


def diff_attention(q, k, v, table, lam):
    S = q.shape[1]
    q = jnp.transpose(q, (0, 2, 3, 1, 4))
    k = jnp.transpose(k, (0, 2, 3, 1, 4))
    v = jnp.transpose(v, (0, 2, 1, 3))
    scale = DA_QK_DIM ** -0.5
    table = table.astype(jnp.float32)
    outs = []
    for blk in range(S // Q_BLOCK):
        qs = blk * Q_BLOCK
        end = qs + Q_BLOCK
        logits = jnp.einsum('bhmqd,bhmkd->bhmqk', q[:, :, :, qs:end], k[:, :, :, :end]).astype(jnp.float32) * scale
        rel = (qs + jnp.arange(Q_BLOCK))[:, None] - jnp.arange(end)[None, :]
        bias = jnp.transpose(table[t5_bucket(rel)], (2, 0, 1))
        logits = jnp.where(rel >= 0, logits + bias[None, :, None], -jnp.inf)
        p = jax.nn.softmax(logits, axis=-1)
        a = p[:, :, 0] - lam * p[:, :, 1]
        outs.append(jnp.einsum('bhqk,bhkd->bhqd', a.astype(v.dtype), v[:, :, :end]))
    out = jnp.concatenate(outs, axis=2)
    return jnp.transpose(out, (0, 2, 1, 3))


def causal_conv(x, w, b):
    K = w.shape[0]
    S = x.shape[1]
    xp = jnp.pad(x, ((0, 0), (K - 1, 0), (0, 0)))
    y = b
    for tap in range(K):
        y = y + xp[:, tap:tap + S] * w[tap]
    return y


def mlstm_chunkwise(q, k, v, log_i, log_f):
    B, H, S, dk = q.shape
    dv = v.shape[-1]
    L = ML_CHUNK
    nc = S // L

    def chunks(a):
        return jnp.moveaxis(a.reshape(a.shape[:2] + (nc, L) + a.shape[3:]), 2, 0)

    causal = jnp.tril(jnp.ones((L, L), dtype=bool))

    def step(carry, inp):
        C, n, m = carry
        qc, kc, vc, li, lf = inp
        b = jnp.cumsum(lf, axis=-1)
        dlog = jnp.where(causal, b[..., :, None] - b[..., None, :] + li[..., None, :], -jnp.inf)
        inter = b + m[..., None]
        m_t = jnp.maximum(jnp.max(dlog, axis=-1), inter)
        w_intra = jnp.exp(dlog - m_t[..., None])
        w_inter = jnp.exp(inter - m_t)
        s = jnp.einsum('bhtd,bhjd->bhtj', qc, kc) * w_intra
        num = jnp.einsum('bhtj,bhje->bhte', s, vc) + w_inter[..., None] * jnp.einsum('bhtd,bhde->bhte', qc, C)
        den = jnp.sum(s, axis=-1) + w_inter * jnp.einsum('bhtd,bhd->bht', qc, n)
        h = num / jnp.maximum(jnp.abs(den), jnp.exp(-m_t))[..., None]
        g = b[..., -1]
        wlog = g[..., None] - b + li
        m_new = jnp.maximum(g + m, jnp.max(wlog, axis=-1))
        decay = jnp.exp(g + m - m_new)
        wk = jnp.exp(wlog - m_new[..., None])
        C_new = decay[..., None, None] * C + jnp.einsum('bhj,bhjd,bhje->bhde', wk, kc, vc)
        n_new = decay[..., None] * n + jnp.einsum('bhj,bhjd->bhd', wk, kc)
        return (C_new, n_new, m_new), h

    init = (jnp.zeros((B, H, dk, dv), jnp.float32), jnp.zeros((B, H, dk), jnp.float32),
            jnp.zeros((B, H), jnp.float32))
    _, hs = lax.scan(step, init, (chunks(q), chunks(k), chunks(v), chunks(log_i), chunks(log_f)))
    return jnp.moveaxis(hs, 0, 2).reshape(B, H, S, dv)


def moe(h, router_w, router_b, w_gu, b_gu, w_down, b_down):
    B, S, D = h.shape
    T = B * S
    xt = h.reshape(T, D)
    logits = (xt @ router_w + router_b).astype(jnp.float32)
    top_val, top_idx = lax.top_k(logits, TOP_K)
    gates = jax.nn.softmax(top_val, axis=-1)
    P = T * TOP_K
    e_flat = top_idx.reshape(P)
    tok_flat = jnp.repeat(jnp.arange(T, dtype=jnp.int32), TOP_K)
    g_flat = gates.reshape(P)
    order = jnp.argsort(e_flat)
    e_sorted = e_flat[order]
    counts = jnp.bincount(e_flat, length=N_EXPERTS)
    padded = (counts + MOE_BLOCK - 1) // MOE_BLOCK * MOE_BLOCK
    start = jnp.cumsum(counts) - counts
    pstart = jnp.cumsum(padded) - padded
    dest = pstart[e_sorted] + (jnp.arange(P) - start[e_sorted])
    n_rows = (P + MOE_BLOCK - 1) // MOE_BLOCK * MOE_BLOCK + N_EXPERTS * MOE_BLOCK
    n_blocks = n_rows // MOE_BLOCK
    row_tok = jnp.zeros((n_rows,), jnp.int32).at[dest].set(tok_flat[order])
    row_gate = jnp.zeros((n_rows,), jnp.float32).at[dest].set(g_flat[order])
    block_expert = jnp.minimum(
        jnp.searchsorted(jnp.cumsum(padded), jnp.arange(n_blocks) * MOE_BLOCK, side='right'),
        N_EXPERTS - 1)

    def expert_block(args):
        rows, e = args
        xb = xt[rows]
        gu = xb @ w_gu[e] + b_gu[e]
        glu = jnp.minimum(gu[:, :D_FF], SWIGLU_LIMIT)
        lin = jnp.clip(gu[:, D_FF:], -SWIGLU_LIMIT, SWIGLU_LIMIT)
        act = glu * jax.nn.sigmoid(SWIGLU_ALPHA * glu) * (lin + 1)
        return act @ w_down[e] + b_down[e]

    ys = lax.map(expert_block, (row_tok.reshape(n_blocks, MOE_BLOCK), block_expert)).reshape(n_rows, D)
    y = jax.ops.segment_sum(ys * row_gate[:, None].astype(ys.dtype), row_tok, num_segments=T)
    return y.reshape(B, S, D)


def setup_inputs(seed: int = 0) -> dict:
    key = jax.random.key(seed)
    ks = jax.random.split(key, 24)

    def nrm(k, shape, s):
        return s * jax.random.normal(k, shape, jnp.float32)

    forget_b = jnp.linspace(FORGET_BIAS_LO, FORGET_BIAS_HI, ML_HEADS, dtype=jnp.float32)[None] + nrm(ks[10], (DEPTH, ML_HEADS), 0.1)
    input_b = nrm(ks[11], (DEPTH, ML_HEADS), 0.1)
    return {
        "x": jax.random.normal(ks[0], (BATCH, SEQ, D_MODEL), jnp.float32),
        "norm_attn_g": 1.0 + nrm(ks[1], (DEPTH, D_MODEL), 0.02),
        "w_in": nrm(ks[2], (DEPTH, D_MODEL, IN_COLS), D_MODEL ** -0.5),
        "rel_bias_table": nrm(ks[3], (REL_BUCKETS, DA_HEADS), 0.5),
        "lambda_q1": nrm(ks[4], (DEPTH, DA_QK_DIM), 0.1),
        "lambda_k1": nrm(ks[5], (DEPTH, DA_QK_DIM), 0.1),
        "lambda_q2": nrm(ks[6], (DEPTH, DA_QK_DIM), 0.1),
        "lambda_k2": nrm(ks[7], (DEPTH, DA_QK_DIM), 0.1),
        "diff_norm_g": 1.0 + nrm(ks[8], (DEPTH, DA_WIDTH), 0.02),
        "mlstm_conv_w": nrm(ks[9], (DEPTH, ML_CONV, ML_Q_COLS + ML_K_COLS), 0.5),
        "mlstm_conv_b": nrm(ks[12], (DEPTH, ML_Q_COLS + ML_K_COLS), 0.02),
        "mlstm_gate_b": jnp.concatenate([input_b, forget_b], axis=-1),
        "mlstm_o_b": nrm(ks[13], (DEPTH, ML_WIDTH), 0.1),
        "mlstm_norm_g": 1.0 + nrm(ks[14], (DEPTH, ML_WIDTH), 0.02),
        "w_out": nrm(ks[15], (DEPTH, MIX_WIDTH, D_MODEL), MIX_WIDTH ** -0.5),
        "norm_ffn_g": 1.0 + nrm(ks[16], (DEPTH, D_MODEL), 0.02),
        "router_w": nrm(ks[17], (DEPTH, D_MODEL, N_EXPERTS), D_MODEL ** -0.5),
        "router_b": nrm(ks[18], (DEPTH, N_EXPERTS), 0.01),
        "expert_w_gu": nrm(ks[19], (DEPTH, N_EXPERTS, D_MODEL, 2 * D_FF), D_MODEL ** -0.5),
        "expert_b_gu": nrm(ks[20], (DEPTH, N_EXPERTS, 2 * D_FF), 0.01),
        "expert_w_down": nrm(ks[21], (DEPTH, N_EXPERTS, D_FF, D_MODEL), D_FF ** -0.5),
        "expert_b_down": nrm(ks[22], (DEPTH, N_EXPERTS, D_MODEL), 0.01),
        "final_norm_g": 1.0 + nrm(ks[23], (D_MODEL,), 0.02),
    }


def reference(x, norm_attn_g, w_in, rel_bias_table, lambda_q1, lambda_k1, lambda_q2, lambda_k2,
              diff_norm_g, mlstm_conv_w, mlstm_conv_b, mlstm_gate_b, mlstm_o_b, mlstm_norm_g,
              w_out, norm_ffn_g, router_w, router_b, expert_w_gu, expert_b_gu, expert_w_down,
              expert_b_down, final_norm_g):
    B, S, _ = x.shape
    split_at = list(np.cumsum([DA_Q_COLS, DA_K_COLS, DA_V_COLS, ML_Q_COLS + ML_K_COLS, ML_V_COLS, ML_O_COLS]))
    for l in range(DEPTH):
        h = rms_norm(x, norm_attn_g[l])
        proj = h @ w_in[l]
        da_q, da_k, da_v, ml_qk, ml_v, ml_o, ml_g = jnp.split(proj, split_at, axis=-1)

        lam_init = lambda_init_fn(l)
        lam = (jnp.exp(jnp.sum(lambda_q1[l] * lambda_k1[l])) - jnp.exp(jnp.sum(lambda_q2[l] * lambda_k2[l]))
               + lam_init).astype(jnp.float32)
        a_out = diff_attention(da_q.reshape(B, S, DA_HEADS, 2, DA_QK_DIM),
                               da_k.reshape(B, S, DA_HEADS, 2, DA_QK_DIM),
                               da_v.reshape(B, S, DA_HEADS, DA_V_DIM), rel_bias_table, lam)
        a_out = head_rms_norm(a_out, diff_norm_g[l]) * (1.0 - lam_init)

        qk = jax.nn.silu(causal_conv(ml_qk, mlstm_conv_w[l], mlstm_conv_b[l]))
        ml_q = qk[..., :ML_Q_COLS].reshape(B, S, ML_HEADS, ML_QK_DIM).transpose(0, 2, 1, 3).astype(jnp.float32)
        ml_k = qk[..., ML_Q_COLS:].reshape(B, S, ML_HEADS, ML_QK_DIM).transpose(0, 2, 1, 3).astype(jnp.float32)
        ml_k = ml_k * (ML_QK_DIM ** -0.5)
        ml_vh = ml_v.reshape(B, S, ML_HEADS, ML_V_DIM).transpose(0, 2, 1, 3).astype(jnp.float32)
        gate_pre = (ml_g + mlstm_gate_b[l]).astype(jnp.float32)
        log_i = jnp.transpose(gate_pre[..., :ML_HEADS], (0, 2, 1))
        log_f = jnp.transpose(jax.nn.log_sigmoid(gate_pre[..., ML_HEADS:]), (0, 2, 1))
        m_out = mlstm_chunkwise(ml_q, ml_k, ml_vh, log_i, log_f)
        m_out = jnp.transpose(m_out, (0, 2, 1, 3)).astype(x.dtype)
        o_gate = jax.nn.sigmoid(ml_o + mlstm_o_b[l]).reshape(B, S, ML_HEADS, ML_V_DIM)
        m_out = head_rms_norm(m_out, mlstm_norm_g[l]) * o_gate

        mixed = jnp.concatenate([a_out.reshape(B, S, DA_WIDTH), m_out.reshape(B, S, ML_WIDTH)], axis=-1)
        x = x + mixed @ w_out[l]

        x = x + moe(rms_norm(x, norm_ffn_g[l]), router_w[l], router_b[l], expert_w_gu[l],
                    expert_b_gu[l], expert_w_down[l], expert_b_down[l])
    return rms_norm(x, final_norm_g)
```

```cpp
#include <hip/hip_runtime.h>
#include <cstdio>
#include <cstdint>

#define GAS __attribute__((address_space(1)))
#define LAS __attribute__((address_space(3)))
typedef unsigned short bf16;
typedef unsigned v4u __attribute__((ext_vector_type(4)));
typedef unsigned v2u __attribute__((ext_vector_type(2)));
typedef float f32x4 __attribute__((ext_vector_type(4)));
typedef short bf16x8 __attribute__((ext_vector_type(8)));
#define RLX_AGENT __ATOMIC_RELAXED, __HIP_MEMORY_SCOPE_AGENT
#define LDS_WAIT() asm volatile("s_waitcnt lgkmcnt(0)" ::: "memory")
#define VM_WAIT() asm volatile("s_waitcnt vmcnt(0)" ::: "memory")

constexpr int NWAVES = 8, NTHR = 512;
constexpr int NB = 16, SEQ = 4096, T = NB * SEQ, D = 1024, INC = 3080;
constexpr int NE = 32, DFF = 1024;
constexpr float EPS = 1e-5f, LOG2E = 1.4426950408889634f, C2 = 0.125f * LOG2E;
constexpr float LAM_INIT = 0.2f;
constexpr int NR_MAX = 270336;

constexpr size_t MiB = 1u << 20;
constexpr size_t WS_CTL = 0, CTL_ZERO_BYTES = 1 * MiB;
constexpr size_t WS_GATES = 1 * MiB;
constexpr size_t WS_RSTD2 = 3 * MiB;
constexpr size_t WS_HIST = 3 * MiB + 512 * 1024;
constexpr size_t WS_TOKINFO = 4 * MiB;
constexpr size_t WS_GATE = 5 * MiB;
constexpr size_t WS_LIST = 6 * MiB;
constexpr size_t WS_WDOWN = 16 * MiB;
constexpr size_t WS_X1B = 80 * MiB;
constexpr size_t WS_ACT = 208 * MiB;
constexpr size_t WS_YK = 480 * MiB;
constexpr size_t WS_WGU = 480 * MiB;
constexpr size_t WS_X1F8 = 744 * MiB;
constexpr size_t WS_WIN = 608 * MiB;
constexpr size_t WS_WOUT = 614 * MiB;
constexpr size_t WS_XN = 616 * MiB;
constexpr size_t WS_LISTRS = 1008 * MiB;
constexpr size_t WS_END = 1024 * MiB;
__host__ __device__ constexpr size_t proj_off(int buf) { return buf < 2 ? (208 + 64 * (size_t)buf) * MiB : (744 + 64 * (size_t)(buf - 2)) * MiB; }
constexpr size_t DO_OTMP = 128 * MiB;

constexpr int CW_TMO = 0;
constexpr int CW_BAR = 4096;
constexpr int CW_Q = 12288;
constexpr int CW_CNT = 8192;

constexpr int RING_BYTES = 131072;
constexpr int LDSCTL_OFF = RING_BYTES;
constexpr int L_HIST = LDSCTL_OFF, L_BASE = LDSCTL_OFF + 128, MISC_OFF = LDSCTL_OFF + 320, L_ETAB = LDSCTL_OFF + 512;
constexpr int LDS_BYTES = 147456;

__device__ __forceinline__ unsigned f2bf(float f) { unsigned u = __builtin_bit_cast(unsigned, f); return (u + 0x7fffu + ((u >> 16) & 1u)) >> 16; }
__device__ __forceinline__ unsigned pk2(float lo, float hi) { return f2bf(lo) | (f2bf(hi) << 16); }
typedef float f32x2_t __attribute__((ext_vector_type(2))); typedef __bf16 bf16x2_t __attribute__((ext_vector_type(2)));
__device__ __forceinline__ unsigned pkh(float lo, float hi) { f32x2_t v = {lo, hi}; bf16x2_t b = __builtin_convertvector(v, bf16x2_t); return __builtin_bit_cast(unsigned, b); }
__device__ __forceinline__ unsigned pk4_fp8(float a, float b, float c, float d) { int r = __builtin_amdgcn_cvt_pk_fp8_f32(a, b, 0, false); r = __builtin_amdgcn_cvt_pk_fp8_f32(c, d, r, true); return (unsigned)r; }
__device__ __forceinline__ float bflo(unsigned u) { return __uint_as_float(u << 16); }
__device__ __forceinline__ float bfhi(unsigned u) { return __uint_as_float(u & 0xffff0000u); }
__device__ __forceinline__ float bf2f(bf16 b) { return __uint_as_float((unsigned)b << 16); }
__device__ __forceinline__ float wave_sum(float v) {
#pragma unroll
    for (int o = 1; o < 64; o <<= 1) v += __shfl_xor(v, o);
    return v;
}
__device__ __forceinline__ float sigmoidf_(float x) { return 1.f / (1.f + __expf(-x)); }

#define XB_TMO      128
#define XB_XCNT(j)  (256  + 64 * (j))
#define XB_XSUB(j)  (1280 + 64 * (j))
#define XB_XGEN(j)  (2304 + 64 * (j))
#define XB_TOP      3328
#define XB_TOPGEN   3392
#define XCD_BAR_WORDS 3456
#define XB_SPIN_CAP (1u << 18)
__device__ __forceinline__ unsigned xb_ld(unsigned* p)              { return __hip_atomic_load(p, __ATOMIC_RELAXED, __HIP_MEMORY_SCOPE_AGENT); }
__device__ __forceinline__ unsigned xb_add(unsigned* p, unsigned v) { return __hip_atomic_fetch_add(p, v, __ATOMIC_RELAXED, __HIP_MEMORY_SCOPE_AGENT); }
__device__ __forceinline__ unsigned xb_xcc_id() { return (unsigned)__builtin_amdgcn_s_getreg((3 << 11) | 20) & 0xFu; }
#define XB_SPIN(cond, bar) do { unsigned _sp = 0; while (cond) { __builtin_amdgcn_s_sleep(1); \
    if ((++_sp & 255u) == 0u) { if (xb_ld(&(bar)[XB_TMO])) break; if (_sp > XB_SPIN_CAP) { atomicAdd(&(bar)[XB_TMO], 1u); break; } } } } while (0)
struct XcdBarrier { unsigned* bar; unsigned x; volatile LAS unsigned* st; };
__device__ __forceinline__ XcdBarrier xcd_barrier_post(unsigned* bar, volatile LAS unsigned* st) {
    XcdBarrier b; b.bar = bar; b.x = xb_xcc_id(); b.st = st;
    if (threadIdx.x == 0) (void)xb_add(&bar[XB_XCNT(b.x)], 1u);
    return b;
}
__device__ __forceinline__ void xcd_barrier_complete(unsigned* bar, unsigned x, unsigned& nloc, unsigned& nx) {
    const unsigned G = gridDim.x * gridDim.y * gridDim.z;
    unsigned sum, cnt, mine, sp = 0u;
    for (;;) {
        sum = 0u; cnt = 0u; mine = 0u;
#pragma unroll
        for (unsigned j = 0; j < 16; ++j) { const unsigned c = xb_ld(&bar[XB_XCNT(j)]); sum += c; cnt += (c > 0u) ? 1u : 0u; mine = (j == x) ? c : mine; }
        if (sum == G) break;
        __builtin_amdgcn_s_sleep(1);
        if ((++sp & 255u) == 0u) { if (xb_ld(&bar[XB_TMO])) break; if (sp > XB_SPIN_CAP) { atomicAdd(&bar[XB_TMO], 1u); break; } }
    }
    nloc = mine > 0u ? mine : 1u; nx = cnt > 0u ? cnt : 1u;
}
__device__ __forceinline__ void xcd_barrier(const XcdBarrier& b) {
    asm volatile("s_waitcnt vmcnt(0)" ::: "memory");
    __syncthreads();
    if (threadIdx.x == 0) {
        unsigned* bar = b.bar;
        __builtin_amdgcn_s_waitcnt(0);
        unsigned nloc = b.st[0], nx = b.st[1];
        if (nloc == 0u) { xcd_barrier_complete(bar, b.x, nloc, nx); b.st[0] = nloc; b.st[1] = nx; }
        const unsigned old = xb_add(&bar[XB_XSUB(b.x)], 1u);
        const unsigned gen = old / nloc;
        if (old + 1u == (gen + 1u) * nloc) {
            __builtin_amdgcn_fence(__ATOMIC_RELEASE, "agent");
            asm volatile("s_waitcnt vmcnt(0)" ::: "memory");
            const unsigned og = xb_add(&bar[XB_TOP], 1u);
            const unsigned tg = og / nx;
            if (og + 1u == (tg + 1u) * nx) xb_add(&bar[XB_TOPGEN], 1u);
            else XB_SPIN(xb_ld(&bar[XB_TOPGEN]) == tg, bar);
            __builtin_amdgcn_fence(__ATOMIC_ACQUIRE, "agent");
            xb_add(&bar[XB_XGEN(b.x)], 1u);
            asm volatile("s_waitcnt vmcnt(0)" ::: "memory");
        } else {
            XB_SPIN(xb_ld(&bar[XB_XGEN(b.x)]) == gen, bar);
            __builtin_amdgcn_fence(__ATOMIC_ACQUIRE, "agent");
            asm volatile("s_waitcnt vmcnt(0)" ::: "memory");
        }
    }
    __syncthreads();
}

struct Args { const float* in[23]; float* out; unsigned char* ws; };
struct Frame {
    LAS unsigned char* lds;
    unsigned* ctl;
    int tid, lane, wave, G, vcu;
    const float* in[23];
    unsigned char* ws; unsigned char* dout;
};
enum { I_X = 0, I_G1, I_WIN, I_REL, I_LQ1, I_LK1, I_LQ2, I_LK2, I_DNG, I_CONVW, I_CONVB, I_GATEB, I_OB, I_MLG, I_WOUT, I_G2, I_RW, I_RB, I_WGU, I_BGU, I_WDN, I_BDN, I_GF };

__device__ __forceinline__ bf16* proj_buf(const Frame& F, int b) { return (bf16*)(F.ws + proj_off(b)); }

__device__ __forceinline__ void tr_item(const float* W, int ldw, int k0, int n0, bf16* WT, int K, int r0, const float* gk, LAS float* scr, int lane) {
#pragma unroll 8
    for (int i = 0; i < 32; ++i) { const int kk = 2 * i + (lane >> 5); scr[kk * 33 + (lane & 31)] = W[(size_t)(k0 + kk) * ldw + n0 + (lane & 31)]; }
    LDS_WAIT(); asm volatile("" ::: "memory");
    const int c = lane & 7;
    float gv[8];
#pragma unroll
    for (int i = 0; i < 8; ++i) gv[i] = gk ? gk[k0 + 8 * c + i] : 1.f;
#pragma unroll
    for (int j = 0; j < 4; ++j) { const int n = (lane >> 3) + 8 * j; const LAS float* s = scr + (8 * c) * 33 + n;
        v4u o; o.x = pk2(s[0 * 33] * gv[0], s[1 * 33] * gv[1]); o.y = pk2(s[2 * 33] * gv[2], s[3 * 33] * gv[3]); o.z = pk2(s[4 * 33] * gv[4], s[5 * 33] * gv[5]); o.w = pk2(s[6 * 33] * gv[6], s[7 * 33] * gv[7]);
        *(v4u*)(WT + (size_t)(r0 + n) * K + k0 + 8 * c) = o; }
    LDS_WAIT(); asm volatile("" ::: "memory");
}

__device__ __forceinline__ void tr_item8(const float* W, int ldw, int k0, int n0, unsigned char* WT, int K, int r0, const float* gk, float wscale, LAS float* scr, int lane) {
#pragma unroll 8
    for (int i = 0; i < 32; ++i) { const int kk = 2 * i + (lane >> 5); scr[kk * 33 + (lane & 31)] = W[(size_t)(k0 + kk) * ldw + n0 + (lane & 31)]; }
    LDS_WAIT(); asm volatile("" ::: "memory");
    const int c = lane & 7;
    float gv[8];
#pragma unroll
    for (int i = 0; i < 8; ++i) gv[i] = (gk ? gk[k0 + 8 * c + i] : 1.f) * wscale;
#pragma unroll
    for (int j = 0; j < 4; ++j) { const int n = (lane >> 3) + 8 * j; const LAS float* sp = scr + (8 * c) * 33 + n;
        v2u o; o.x = pk4_fp8(sp[0 * 33] * gv[0], sp[1 * 33] * gv[1], sp[2 * 33] * gv[2], sp[3 * 33] * gv[3]); o.y = pk4_fp8(sp[4 * 33] * gv[4], sp[5 * 33] * gv[5], sp[6 * 33] * gv[6], sp[7 * 33] * gv[7]);
        *(v2u*)(WT + (size_t)(r0 + n) * K + k0 + 8 * c) = o; }
    LDS_WAIT(); asm volatile("" ::: "memory");
}

__device__ __forceinline__ float log_sigmoid(float x) { return fminf(x, 0.f) - log1pf(__expf(-fabsf(x))); }

__device__ __forceinline__ void p0_prologue(Frame& F_) {
    Frame F = F_; { int t_ = F.tid; asm volatile("" : "+v"(t_)); F.tid = t_; F.lane = t_ & 63; }
    LAS float* scr = (LAS float*)(F.lds + F.wave * 8704);
    const int gw = F.vcu * NWAVES + F.wave, NGW = F.G * NWAVES;
    constexpr int I_IN = 16 * 96, I_OUT = 16 * 32, I_GU = 16 * 64 * NE, I_DN = 16 * 32 * NE;
    constexpr int NITEMS = I_IN + I_OUT + I_GU + I_DN;
    for (int it = gw; it < NITEMS; it += NGW) {
        int r = it;
        if (r < I_IN) { const int kb = r / 96, nb = r % 96; tr_item(F.in[I_WIN], INC, 64 * kb, 32 * nb, (bf16*)(F.ws + WS_WIN), D, 32 * nb, nullptr, scr, F.lane); continue; } r -= I_IN;
        if (r < I_OUT) { const int kb = r / 32, nb = r % 32; tr_item(F.in[I_WOUT], D, 64 * kb, 32 * nb, (bf16*)(F.ws + WS_WOUT), D, 32 * nb, nullptr, scr, F.lane); continue; } r -= I_OUT;
        if (r < I_GU) { const int e = r / 1024, q = r % 1024, kb = q / 64, nb = q % 64, n0 = 32 * nb;
            const int bj = n0 >> 10, j = n0 & 1023, r0 = 256 * (j >> 7) + 128 * bj + (j & 127);
            tr_item8(F.in[I_WGU] + (size_t)e * D * 2 * DFF, 2 * DFF, 64 * kb, n0, F.ws + WS_WGU + (size_t)e * 2 * DFF * D, D, r0, F.in[I_G2], 64.f, scr, F.lane); continue; } r -= I_GU;
        { const int e = r / 512, q = r % 512, kb = q / 32, nb = q % 32;
            tr_item8(F.in[I_WDN] + (size_t)e * DFF * D, D, 64 * kb, 32 * nb, F.ws + WS_WDOWN + (size_t)e * D * DFF, DFF, 32 * nb, nullptr, 64.f, scr, F.lane); }
    }
    __syncthreads();
    LAS float* wg = (LAS float*)F.lds;
    for (int i = F.tid; i < D * 8; i += NTHR) wg[(i & 7) * D + (i >> 3)] = F.in[I_WIN][(size_t)(i >> 3) * INC + 3072 + (i & 7)];
    __syncthreads();
    const float* x = F.in[I_X]; const float* g1 = F.in[I_G1]; const float* gb = F.in[I_GATEB];
    bf16* XN = (bf16*)(F.ws + WS_XN); float* GT = (float*)(F.ws + WS_GATES);
    f32x4 gn[4];
#pragma unroll
    for (int j = 0; j < 4; ++j) gn[j] = *((const f32x4*)g1 + F.lane + 64 * j);
    constexpr int RPS = 4;
    for (int m0 = gw; m0 < T; m0 += RPS * NGW) {
        f32x4 v[RPS][4]; float s[RPS];
#pragma unroll
        for (int r = 0; r < RPS; ++r) { const int mm = m0 + r * NGW; const int m = mm < T ? mm : m0; const f32x4* xr = (const f32x4*)(x + (size_t)m * D) + F.lane;
#pragma unroll
            for (int j = 0; j < 4; ++j) v[r][j] = xr[64 * j]; }
#pragma unroll
        for (int r = 0; r < RPS; ++r) { s[r] = 0.f;
#pragma unroll
            for (int j = 0; j < 4; ++j) s[r] += (v[r][j].x * v[r][j].x + v[r][j].y * v[r][j].y) + (v[r][j].z * v[r][j].z + v[r][j].w * v[r][j].w); }
#pragma unroll
        for (int r = 0; r < RPS; ++r) s[r] = wave_sum(s[r]);
#pragma unroll
        for (int r = 0; r < RPS; ++r) { const int m = m0 + r * NGW; if (m >= T) break;
            const float rstd = rsqrtf(s[r] * (1.f / D) + EPS);
            float ga[8];
#pragma unroll
            for (int i = 0; i < 8; ++i) ga[i] = 0.f;
            unsigned long long* o8 = (unsigned long long*)(XN + (size_t)m * D) + F.lane;
#pragma unroll
            for (int j = 0; j < 4; ++j) {
                const f32x4 h = v[r][j] * rstd * gn[j];
                o8[64 * j] = (unsigned long long)pkh(h.x, h.y) | ((unsigned long long)pkh(h.z, h.w) << 32);
#pragma unroll
                for (int gi = 0; gi < 8; ++gi) { const f32x4 w = *(const LAS f32x4*)(wg + gi * D + 256 * j + 4 * F.lane); ga[gi] += (h.x * w.x + h.y * w.y) + (h.z * w.z + h.w * w.w); }
            }
#pragma unroll
            for (int i = 0; i < 4; ++i) { const bool up = (F.lane & 32) != 0; const float send = up ? ga[i] : ga[4 + i], keep = up ? ga[4 + i] : ga[i]; ga[i] = keep + __shfl_xor(send, 32); }
#pragma unroll
            for (int i = 0; i < 2; ++i) { const bool up = (F.lane & 16) != 0; const float send = up ? ga[i] : ga[2 + i], keep = up ? ga[2 + i] : ga[i]; ga[i] = keep + __shfl_xor(send, 16); }
            { const bool up = (F.lane & 8) != 0; const float send = up ? ga[0] : ga[1], keep = up ? ga[1] : ga[0]; ga[0] = keep + __shfl_xor(send, 8); }
            ga[0] += __shfl_xor(ga[0], 4); ga[0] += __shfl_xor(ga[0], 2); ga[0] += __shfl_xor(ga[0], 1);
            { const int gi = (F.lane >> 3) & 7; const float vv = ga[0] + gb[gi];
              if ((F.lane & 7) == 0) GT[(size_t)m * 8 + gi] = gi < 4 ? vv : log_sigmoid(vv); }
        }
    }
}


namespace pg8 {
#define PG8_LAS __attribute__((address_space(3)))
constexpr int BM = 256, BK = 64, HALF = 128, HTB = HALF * BK * 2, STAGE_BYTES = 8 * HTB, NXCD = 8, WGM = 8;
__host__ __device__ __forceinline__ int lds_byte(int r, int c) { const int st = (r >> 4) * 2 + (c >> 5), rr = r & 15, cc = c & 31, ob = rr * 64 + cc * 2; return st * 1024 + (ob ^ (((ob >> 9) & 1) << 5)); }
__host__ __device__ __forceinline__ void stage_rc(int b, int& R, int& C) { const int st = b / 1024, sb = b % 1024, swz = sb ^ (((sb >> 9) & 1) << 5); R = (st >> 1) * 16 + swz / 64; C = (st & 1) * 32 + (swz % 64) / 2; }
__host__ __device__ __forceinline__ int perm32(int rho) { const int n = rho >> 4, i = rho & 15; return 8 * (i >> 2) + 4 * n + (i & 3); }
struct Unit { int pm, pn, e; };
struct TileOrder {
    int nM, nN, nwg, G, c;
    __device__ void init(int nM_, int nN_, int G_, int c_) { nM = nM_; nN = nN_; nwg = nM * nN; G = G_; c = c_; }
    __device__ bool next_tile(int i, int& pm, int& pn) const {
        const long L = (long)i * G + c; if (L >= nwg) return false;
        int wgid = (int)L; { const int q = nwg / NXCD, r = nwg % NXCD, xcd = wgid % NXCD, off = wgid / NXCD; wgid = (xcd < r ? xcd * (q + 1) : r * (q + 1) + (xcd - r) * q) + off; }
        const int nig = WGM * nN, gid = wgid / nig, fm = gid * WGM, gsz = (nM - fm) < WGM ? (nM - fm) : WGM;
        pm = fm + ((wgid % nig) % gsz); pn = (wgid % nig) / gsz; return true;
    }
};
__device__ __forceinline__ unsigned cvt_pk_bf16(float lo, float hi) { unsigned r; asm volatile("v_cvt_pk_bf16_f32 %0, %1, %2" : "=v"(r) : "v"(lo), "v"(hi)); return r; }

typedef int v8i_t __attribute__((ext_vector_type(8))); typedef int v4i_t __attribute__((ext_vector_type(4)));
template <class Epi, class Sched, bool ALIGN_EPI, bool SP2, bool F8 = false, int SCA = 0x7f7f7f7f, int SCB = 0x7f7f7f7f>
__device__ __forceinline__ void gemm_phase(PG8_LAS unsigned char* lds, const int nt, const int pitchB, const Sched& S, const Epi& E) {
    static_assert(SP2, "only the SP2 loop is carried here");
    int tid = threadIdx.x; asm volatile("" : "+v"(tid));
    const int wid = __builtin_amdgcn_readfirstlane(tid >> 6), lane = tid & 63, wr = wid >> 2, wc = wid & 3, fr = lane & 15, fq = lane >> 4;
    int RA[2], CA[2]; unsigned voffB[2];
#pragma unroll
    for (int i = 0; i < 2; ++i) { int R, C; stage_rc(tid * 16 + i * 8192, R, C); RA[i] = R; CA[i] = C; const int Rb = (R & ~31) + perm32(R & 31); voffB[i] = (unsigned)(Rb * pitchB + C * 2); }
    const size_t kstep = (size_t)(BK * 2);
    const size_t hstep = (size_t)HALF * pitchB;
    const unsigned ldsw = (unsigned)wid * 1024u;
    const int aoff = lds_byte(wr * 64 + fr, fq * 8), boff = lds_byte(wc * 32 + fr, fq * 8);
#define PG8_SA(b, h) (((b) * 2 + (h)) * HTB)
#define PG8_SB(b, h) ((4 + (b) * 2 + (h)) * HTB)
#define PG8_STAGE(bufoff, gbase, voff) do { _Pragma("unroll") for (int _i = 0; _i < 2; ++_i) \
        __builtin_amdgcn_global_load_lds((const unsigned*)((const char*)(gbase) + (voff)[_i]), (PG8_LAS unsigned*)(lds + (bufoff) + ldsw + _i * 8192), 16, 0, 0); } while (0)
#define PG8_LDA(dst, b, h) do { if constexpr (F8) { _Pragma("unroll") for (int m = 0; m < 4; ++m) { dst##8[m].lo = *(const PG8_LAS v4i_t*)(lds + PG8_SA(b, h) + aoff + m * 2048); dst##8[m].hi = *(const PG8_LAS v4i_t*)(lds + PG8_SA(b, h) + aoff + m * 2048 + 1024); } } \
        else { _Pragma("unroll") for (int m = 0; m < 4; ++m) _Pragma("unroll") for (int k = 0; k < 2; ++k) dst[m][k] = *(const PG8_LAS bf16x8*)(lds + PG8_SA(b, h) + aoff + m * 2048 + k * 1024); } } while (0)
#define PG8_LDB(dst, b, h) do { if constexpr (F8) { _Pragma("unroll") for (int n = 0; n < 2; ++n) { dst##8[n].lo = *(const PG8_LAS v4i_t*)(lds + PG8_SB(b, h) + boff + n * 2048); dst##8[n].hi = *(const PG8_LAS v4i_t*)(lds + PG8_SB(b, h) + boff + n * 2048 + 1024); } } \
        else { _Pragma("unroll") for (int n = 0; n < 2; ++n) _Pragma("unroll") for (int k = 0; k < 2; ++k) dst[n][k] = *(const PG8_LAS bf16x8*)(lds + PG8_SB(b, h) + boff + n * 2048 + k * 1024); } } while (0)
#define PG8_MMA(ai, bj, At, Bt) do { __builtin_amdgcn_s_setprio(1); _Pragma("unroll") for (int m = 0; m < 4; ++m) _Pragma("unroll") for (int n = 0; n < 2; ++n) { \
        if constexpr (F8) asm volatile("v_mfma_scale_f32_16x16x128_f8f6f4 %0, %1, %2, %0, %3, %4 op_sel_hi:[0,0,0]" : "+v"(acc[ai][bj][m][n]) : "v"(Bt##8[n]), "v"(At##8[m]), "v"(sca_), "v"(scb_));   \
        else { _Pragma("unroll") for (int k = 0; k < 2; ++k) acc[ai][bj][m][n] = __builtin_amdgcn_mfma_f32_16x16x32_bf16(Bt[n][k], At[m][k], acc[ai][bj][m][n], 0, 0, 0); } } \
        __builtin_amdgcn_s_setprio(0); } while (0)
#define PG8_WAIT_V(n) asm volatile("s_waitcnt vmcnt(" #n ")" ::: "memory")
#define PG8_WAIT_L(n) asm volatile("s_waitcnt lgkmcnt(" #n ")" ::: "memory")
#define PG8_BAR __builtin_amdgcn_s_barrier()
#define PG8_SCHED __builtin_amdgcn_sched_barrier(0)
    Unit cur, nxt; int ui = 0;
    if (!S.next(0, cur)) return;
    f32x4 acc[2][2][4][2];
#pragma unroll
    for (int a = 0; a < 2; ++a)
#pragma unroll
        for (int b = 0; b < 2; ++b)
#pragma unroll
            for (int m = 0; m < 4; ++m)
#pragma unroll
                for (int n = 0; n < 2; ++n) acc[a][b][m][n] = (f32x4){0.f, 0.f, 0.f, 0.f};
    const int sca_ = SCA, scb_ = SCB;
    bf16x8 At[4][2], B0[2][2], B1[2][2];
    v8i_t At8[4], B08[2], B18[2];
    const char* cA; unsigned cAo[2][2]; S.a_view(cur, RA, CA, cA, cAo);
    const char* cB = S.b_base(cur);
    PG8_STAGE(PG8_SB(0, 0), cB, voffB); PG8_STAGE(PG8_SB(0, 1), cB + hstep, voffB); PG8_STAGE(PG8_SA(0, 0), cA, cAo[0]); PG8_STAGE(PG8_SA(0, 1), cA, cAo[1]);
    if (wr == 1) PG8_BAR;
    PG8_WAIT_V(2); PG8_BAR;
    PG8_STAGE(PG8_SB(1, 0), cB + kstep, voffB); PG8_STAGE(PG8_SA(1, 0), cA + kstep, cAo[0]); PG8_STAGE(PG8_SB(1, 1), cB + hstep + kstep, voffB);
    PG8_WAIT_V(6); PG8_BAR;
    for (;;) {
        const bool has_next = S.next(ui + 1, nxt);
        const char* nA = cA; const char* nB = cB; unsigned nAo[2][2];
#pragma unroll
        for (int h = 0; h < 2; ++h)
#pragma unroll
            for (int i = 0; i < 2; ++i) nAo[h][i] = cAo[h][i];
        unsigned pre[2][2] = {{0u, 0u}, {0u, 0u}};
        if (has_next) { S.a_pre(nxt, RA, pre); nB = S.b_base(nxt); }
        for (int t = 0; t < nt; t += 2) {
            const bool last = (t == nt - 2);
            if (last && has_next) S.a_post(nxt, pre, RA, CA, nA, nAo);
            const char* a1 = cA + (size_t)(t + 1) * kstep;
            const char* a2 = last ? nA : cA + (size_t)(t + 2) * kstep; const char* b2 = last ? nB : cB + (size_t)(t + 2) * kstep;
            const char* a3 = a2 + kstep; const char* b3 = b2 + kstep;
            unsigned o2[2][2];
#pragma unroll
            for (int h = 0; h < 2; ++h)
#pragma unroll
                for (int i = 0; i < 2; ++i) o2[h][i] = last ? nAo[h][i] : cAo[h][i];
            PG8_LDB(B0, 0, 0); PG8_LDB(B1, 0, 1); PG8_SCHED; PG8_LDA(At, 0, 0); PG8_STAGE(PG8_SA(1, 1), a1, cAo[1]);
            PG8_WAIT_V(8); PG8_WAIT_L(0); PG8_BAR; PG8_MMA(0, 0, At, B0); PG8_MMA(0, 1, At, B1); PG8_BAR; PG8_SCHED;
            PG8_LDA(At, 0, 1); PG8_STAGE(PG8_SB(0, 0), b2, voffB); PG8_STAGE(PG8_SB(0, 1), b2 + hstep, voffB); PG8_STAGE(PG8_SA(0, 0), a2, o2[0]);
            PG8_WAIT_V(8); PG8_WAIT_L(0); PG8_BAR; PG8_MMA(1, 0, At, B0); PG8_MMA(1, 1, At, B1); PG8_BAR; PG8_SCHED;
            PG8_LDB(B0, 1, 0); PG8_LDB(B1, 1, 1); PG8_SCHED; PG8_LDA(At, 1, 0); PG8_STAGE(PG8_SA(0, 1), a2, o2[1]);
            PG8_WAIT_V(8); PG8_WAIT_L(0); PG8_BAR; PG8_MMA(0, 0, At, B0); PG8_MMA(0, 1, At, B1); PG8_BAR; PG8_SCHED;
            PG8_LDA(At, 1, 1); PG8_STAGE(PG8_SB(1, 0), b3, voffB); PG8_STAGE(PG8_SB(1, 1), b3 + hstep, voffB); PG8_STAGE(PG8_SA(1, 0), a3, o2[0]);
            PG8_WAIT_V(8); PG8_WAIT_L(0); PG8_BAR; PG8_MMA(1, 0, At, B0); PG8_MMA(1, 1, At, B1); PG8_BAR; PG8_SCHED;
        }
        if constexpr (ALIGN_EPI) { if (wr == 0) PG8_BAR; }
        if constexpr (F8) asm volatile("s_nop 15\n\ts_nop 7" ::: "memory");
        E(acc, cur, wr, wc, fr, fq);
        if (!has_next) break;
#pragma unroll
        for (int a = 0; a < 2; ++a)
#pragma unroll
            for (int b = 0; b < 2; ++b)
#pragma unroll
                for (int m = 0; m < 4; ++m)
#pragma unroll
                    for (int n = 0; n < 2; ++n) acc[a][b][m][n] = (f32x4){0.f, 0.f, 0.f, 0.f};
        cur = nxt; cA = nA; cB = nB; ++ui;
#pragma unroll
        for (int h = 0; h < 2; ++h)
#pragma unroll
            for (int i = 0; i < 2; ++i) cAo[h][i] = nAo[h][i];
        if constexpr (ALIGN_EPI) { if (wr == 1) PG8_BAR; }
    }
    PG8_WAIT_V(0);
    if constexpr (!ALIGN_EPI) { if (wr == 0) PG8_BAR; }
    PG8_BAR;
#undef PG8_SA
#undef PG8_SB
#undef PG8_STAGE
#undef PG8_LDA
#undef PG8_LDB
#undef PG8_MMA
#undef PG8_WAIT_V
#undef PG8_WAIT_L
#undef PG8_BAR
#undef PG8_SCHED
}
}

__device__ const unsigned char T5_BUCKET[128] = {0, 1, 2, 3, 4, 5, 6, 7, 8, 9, 10, 11, 12, 13, 14, 15, 16, 16, 16, 17, 17, 18, 18, 18, 19, 19, 19, 20, 20, 20, 20, 21, 21, 21, 21, 22, 22, 22, 22, 22, 23, 23, 23, 23, 23, 23, 24, 24, 24, 24, 24, 24, 25, 25, 25, 25, 25, 25, 25, 26, 26, 26, 26, 26, 26, 26, 26, 27, 27, 27, 27, 27, 27, 27, 27, 27, 27, 28, 28, 28, 28, 28, 28, 28, 28, 28, 28, 29, 29, 29, 29, 29, 29, 29, 29, 29, 29, 29, 29, 30, 30, 30, 30, 30, 30, 30, 30, 30, 30, 30, 30, 30, 30, 31, 31, 31, 31, 31, 31, 31, 31, 31, 31, 31, 31, 31, 31, 31};

__device__ __forceinline__ float compute_lambda(const Frame& F) {
    float s1 = 0.f, s2 = 0.f;
    for (int i = 0; i < 64; ++i) { s1 += F.in[I_LQ1][i] * F.in[I_LK1][i]; s2 += F.in[I_LQ2][i] * F.in[I_LK2][i]; }
    return __expf(s1) - __expf(s2) + LAM_INIT;
}

namespace attn_body {
using bf16=unsigned short;
using bf16x8=__attribute__((ext_vector_type(8)))short;
using s16x4=__attribute__((ext_vector_type(4)))short;
using f32x16=__attribute__((ext_vector_type(16)))float;
using u32x4=__attribute__((ext_vector_type(4)))unsigned;
constexpr int SEQ=4096,D=64,DM=512,OP=1024;
constexpr int NW=8,QBLK=32,QB=QBLK*NW,KVBLK=64,NQB=SEQ/QB;
__device__ __forceinline__ int crow(int r,int hi){return (r&3)+8*(r>>2)+4*hi;}
#define SBAR() __builtin_amdgcn_sched_barrier(0)
__device__ __forceinline__ void cmask(f32x16&p0,f32x16&p1,int jb,int qrel,int hi){
  const float NEG=-INFINITY; int kb=64*jb+4*hi;
  #pragma unroll
  for(int r=0;r<16;++r){int kv=kb+(r&3)+8*(r>>2); if(kv>qrel)p0[r]=NEG; if(kv+32>qrel)p1[r]=NEG;}
}

typedef __attribute__((address_space(3))) const float* lds_cfptr;
__device__ __forceinline__ void bcorr(f32x16&p0,f32x16&p1,int jb,int qrel,int hi,lds_cfptr dtab){
  lds_cfptr tp=dtab+(qrel+256-64*jb-4*hi-59);
  #pragma unroll
  for(int r=0;r<16;++r){const int c=(r&3)+8*(r>>2); p0[r]+=tp[59-c]; p1[r]+=tp[27-c];}
}
constexpr int NSLOT=3, SLOTB=8192;
constexpr int LDS_K=0, LDS_V=NSLOT*SLOTB, LDS_WS=2*NSLOT*SLOTB, LDS_OST=LDS_WS+NW*64*4, LDS_BYTES=LDS_OST+NW*4096;
__device__ __forceinline__ void glds16(const void*gsrc,unsigned lds_dst){unsigned keep;
  asm volatile("s_mov_b32 %0, m0\n\ts_mov_b32 m0, %2\n\ts_nop 0\n\tglobal_load_lds_dwordx4 %1, off\n\ts_mov_b32 m0, %0":"=&s"(keep):"v"(gsrc),"s"(lds_dst):"memory");}
__device__ __forceinline__ float max3f(float a,float b,float c){float r;asm("v_max3_f32 %0, %1, %2, %3":"=v"(r):"v"(a),"v"(b),"v"(c));return r;}
__device__ __forceinline__ float max2f(float a,float b){float r;asm("v_max_f32_e32 %0, %1, %2":"=v"(r):"v"(a),"v"(b));return r;}
__device__ __forceinline__ float fadd_s(float a,float b){float r;asm("v_add_f32_e32 %0, %1, %2":"=v"(r):"v"(a),"v"(b));return r;}
__device__ __forceinline__ float fsub_s(float a,float b){float r;asm("v_sub_f32_e32 %0, %1, %2":"=v"(r):"v"(a),"v"(b));return r;}
typedef float f32x2_t __attribute__((ext_vector_type(2))); typedef __bf16 bf16x2_t __attribute__((ext_vector_type(2)));
__device__ __forceinline__ unsigned cvtpk_s(float lo,float hi){f32x2_t v={lo,hi};bf16x2_t b=__builtin_convertvector(v,bf16x2_t);return __builtin_bit_cast(unsigned,b);}
#define WAIT_BAR(N) asm volatile("s_waitcnt vmcnt(" #N ") lgkmcnt(0)\n\ts_barrier":::"memory")

__device__ __forceinline__ void qkt(f32x16&p0,f32x16&p1,const char*Kslot,const bf16x8*qr,const f32x16&negm,int r32,int hi){
  const char*kb=Kslot+hi*1024+r32*16;
  #pragma unroll
  for(int d0=0;d0<4;++d0){
    const bf16x8 b0=*reinterpret_cast<const bf16x8*>(kb+d0*2048);
    const bf16x8 b1=*reinterpret_cast<const bf16x8*>(kb+d0*2048+512);
    if(d0==0){p0=__builtin_amdgcn_mfma_f32_32x32x16_bf16(b0,qr[0],negm,0,0,0);p1=__builtin_amdgcn_mfma_f32_32x32x16_bf16(b1,qr[0],negm,0,0,0);}
    else{p0=__builtin_amdgcn_mfma_f32_32x32x16_bf16(b0,qr[d0],p0,0,0,0);p1=__builtin_amdgcn_mfma_f32_32x32x16_bf16(b1,qr[d0],p1,0,0,0);}}
}
typedef __attribute__((address_space(3))) const char* lds_cptr;
typedef short v4i16_t __attribute__((ext_vector_type(4)));
__device__ __forceinline__ void kload8(bf16x8*kf,lds_cptr kp){
  kf[0]=*(const __attribute__((address_space(3))) bf16x8*)(kp);      kf[1]=*(const __attribute__((address_space(3))) bf16x8*)(kp+512);
  kf[2]=*(const __attribute__((address_space(3))) bf16x8*)(kp+2048); kf[3]=*(const __attribute__((address_space(3))) bf16x8*)(kp+2560);
  kf[4]=*(const __attribute__((address_space(3))) bf16x8*)(kp+4096); kf[5]=*(const __attribute__((address_space(3))) bf16x8*)(kp+4608);
  kf[6]=*(const __attribute__((address_space(3))) bf16x8*)(kp+6144); kf[7]=*(const __attribute__((address_space(3))) bf16x8*)(kp+6656);
}
__device__ __forceinline__ void kload2(bf16x8*kf,lds_cptr kp,int j){ kf[2*j]=*(const __attribute__((address_space(3))) bf16x8*)(kp+j*2048); kf[2*j+1]=*(const __attribute__((address_space(3))) bf16x8*)(kp+j*2048+512); }
__device__ __forceinline__ s16x4 vtr(lds_cptr p){ return __builtin_bit_cast(s16x4,__builtin_amdgcn_ds_read_tr16_b64_v4i16((__attribute__((address_space(3))) v4i16_t*)p)); }
__device__ __forceinline__ float rowmax(const f32x16&p0,const f32x16&p1){
  float a=max3f(p0[0],p0[1],p1[0]),b=max3f(p0[2],p0[3],p1[1]);a=max3f(a,p1[2],p1[3]);
  #pragma unroll
  for(int r=4;r<16;r+=4){a=max3f(a,p0[r],p0[r+1]);b=max3f(b,p0[r+2],p0[r+3]);a=max3f(a,p1[r],p1[r+1]);b=max3f(b,p1[r+2],p1[r+3]);}
  const float m=max2f(a,b);
  auto rr=__builtin_amdgcn_permlane32_swap(__float_as_uint(m),__float_as_uint(m),false,false);
  return max2f(__uint_as_float(rr[0]),__uint_as_float(rr[1]));
}
__device__ __forceinline__ void pv(f32x16*o,int vb,bf16x8 pa0,bf16x8 pa1,bf16x8 pa2,bf16x8 pa3){
  #pragma unroll
  for(int d0=0;d0<2;++d0){s16x4 lo[4],hi[4];
    #pragma unroll
    for(int ks=0;ks<4;++ks){
      asm volatile("ds_read_b64_tr_b16 %0,%1 offset:%c2":"=&v"(lo[ks]):"v"(vb),"i"(d0*4096+ks*1024):"memory");
      asm volatile("ds_read_b64_tr_b16 %0,%1 offset:%c2":"=&v"(hi[ks]):"v"(vb),"i"(d0*4096+ks*1024+512):"memory");}
    asm volatile("s_waitcnt lgkmcnt(0)":::"memory");SBAR();
    #define PK(k) (bf16x8){lo[k][0],lo[k][1],lo[k][2],lo[k][3],hi[k][0],hi[k][1],hi[k][2],hi[k][3]}
    o[d0]=__builtin_amdgcn_mfma_f32_32x32x16_bf16(pa0,PK(0),o[d0],0,0,0);
    o[d0]=__builtin_amdgcn_mfma_f32_32x32x16_bf16(pa1,PK(1),o[d0],0,0,0);
    o[d0]=__builtin_amdgcn_mfma_f32_32x32x16_bf16(pa2,PK(2),o[d0],0,0,0);
    o[d0]=__builtin_amdgcn_mfma_f32_32x32x16_bf16(pa3,PK(3),o[d0],0,0,0);
    #undef PK
  }
}

#ifndef ATTN_STORE16
#define ATTN_STORE16(p,v) (*(u32x4*)(p)=(v))
#endif
constexpr int L2_K=0, L2_V=3*8192, L2_WS=L2_V+4*16384, L2_OST=L2_V, L2_BYTES=L2_WS+NW*64*4;
__device__ __forceinline__ float rowmax_c(const f32x16&p0,const f32x16&p1){
  float a=__builtin_fmaxf(__builtin_fmaxf(p0[0],p0[1]),p1[0]),b=__builtin_fmaxf(__builtin_fmaxf(p0[2],p0[3]),p1[1]); a=__builtin_fmaxf(__builtin_fmaxf(a,p1[2]),p1[3]);
  #pragma unroll
  for(int r=4;r<16;r+=4){a=__builtin_fmaxf(__builtin_fmaxf(a,p0[r]),p0[r+1]);b=__builtin_fmaxf(__builtin_fmaxf(b,p0[r+2]),p0[r+3]);a=__builtin_fmaxf(__builtin_fmaxf(a,p1[r]),p1[r+1]);b=__builtin_fmaxf(__builtin_fmaxf(b,p1[r+2]),p1[r+3]);}
  float m=__builtin_fmaxf(a,b);
  auto rr=__builtin_amdgcn_permlane32_swap(__float_as_uint(m),__float_as_uint(m),false,false);
  return __builtin_fmaxf(__uint_as_float(rr[0]),__uint_as_float(rr[1]));
}
__device__ __forceinline__ void pv128(f32x16 (&o)[4],const bf16x8 (&pa)[4],lds_cptr vp_){
  s16x4 vl[2][4],vh_[2][4];
  #pragma unroll
  for(int ks=0;ks<4;++ks){vl[0][ks]=vtr(vp_+ks*1024);vh_[0][ks]=vtr(vp_+ks*1024+512);}
  #pragma unroll
  for(int d0=0;d0<4;++d0){
    if(d0<3){
      #pragma unroll
      for(int ks=0;ks<4;++ks){vl[(d0+1)&1][ks]=vtr(vp_+(d0+1)*4096+ks*1024);vh_[(d0+1)&1][ks]=vtr(vp_+(d0+1)*4096+ks*1024+512);} }
    #pragma unroll
    for(int ks=0;ks<4;++ks){ const s16x4 a_=vl[d0&1][ks],b_=vh_[d0&1][ks];
      o[d0]=__builtin_amdgcn_mfma_f32_32x32x16_bf16(pa[ks],(bf16x8){a_[0],a_[1],a_[2],a_[3],b_[0],b_[1],b_[2],b_[3]},o[d0],0,0,0); }
  }
}
template<int THRL,bool KEEP> __device__ __forceinline__ void attn_unit128(int b,int qb,const bf16*Q,const bf16*__restrict__ K,const bf16*__restrict__ V,bf16*O,char*shm,const float cfar,lds_cfptr dtab){
  int tid=threadIdx.x; asm volatile("":"+v"(tid));
  const int lane=tid&63,r32=lane&31,hi=lane>>5; const int wid=__builtin_amdgcn_readfirstlane(tid>>6);
  constexpr bool grpB=true;
  const long rowbase=(long)b*SEQ; const int q0=qb*QB;
  const bf16*Qw=Q+(rowbase+q0+wid*QBLK)*DM;
  const bf16*Kh=K+rowbase*DM,*Vh=V+rowbase*DM;
  const unsigned lds0=(unsigned)(uintptr_t)shm;
  float*wsf=(float*)(shm+L2_WS)+wid*64;
  const bf16*ksrc=Kh+(long)lane*DM+wid*8;
  const bf16*vsrc=Vh+(long)(16*(wid&3)+(lane>>2))*DM+(wid>>2)*32+(lane&3)*8;
  const unsigned kdst=lds0+L2_K+wid*1024, vdst=lds0+L2_V+wid*1024;
  #define DMA2_K(t,slot) glds16(ksrc+(long)(t)*KVBLK*DM,(unsigned)__builtin_amdgcn_readfirstlane(kdst+(slot)*8192))
  #define DMA2_V(t,slot) do{ glds16(vsrc+(long)(t)*KVBLK*DM,(unsigned)__builtin_amdgcn_readfirstlane(vdst+(slot)*16384)); glds16(vsrc+64+(long)(t)*KVBLK*DM,(unsigned)__builtin_amdgcn_readfirstlane(vdst+8192+(slot)*16384)); }while(0)
  const int NT=(q0+QB)/KVBLK;
  const int NTw=NT-3+(wid>>1);
  DMA2_K(0,0);DMA2_V(0,0);DMA2_K(1,1);DMA2_V(1,1);
  bf16x8 qr[4];
  #pragma unroll
  for(int d0=0;d0<4;++d0)qr[d0]=*reinterpret_cast<const bf16x8*>(&Qw[(long)r32*DM+d0*16+hi*8]);
  __builtin_amdgcn_s_waitcnt(0x0F70);
  float mhat=0.f,l_reg=0.f; f32x16 o[4];
  #pragma unroll
  for(int d=0;d<4;++d)o[d]=f32x16{};
  f32x16 negm;
  #pragma unroll
  for(int r=0;r<16;++r)negm[r]=cfar;
  const int qrel=wid*QBLK+r32;
  const lds_cptr shm3=(lds_cptr)shm; const lds_cptr vp0=shm3+L2_V+((lane>>4)&1)*32+(lane&3)*8+(4*hi+((lane&15)>>2))*64; const lds_cptr kp0=shm3+L2_K+hi*1024+r32*16;
  int kslot=0,vslot=0;
  bf16x8 pa[4];
  #pragma unroll
  for(int i=0;i<4;++i)pa[i]=bf16x8{};
  #define PIN8(A,B) asm volatile("":"+v"(A[0]),"+v"(A[1]),"+v"(A[2]),"+v"(A[3]),"+v"(B[0]),"+v"(B[1]),"+v"(B[2]),"+v"(B[3]))
  #define VLD(buf,blk) do{ _Pragma("unroll") for(int ks=0;ks<4;++ks){vl[buf][ks]=vtr(vp_+(blk)*4096+ks*1024);vh_[buf][ks]=vtr(vp_+(blk)*4096+ks*1024+512);} }while(0)
  #define VFRAG(buf,ks) (bf16x8){vl[buf][ks][0],vl[buf][ks][1],vl[buf][ks][2],vl[buf][ks][3],vh_[buf][ks][0],vh_[buf][ks][1],vh_[buf][ks][2],vh_[buf][ks][3]}
  #pragma unroll 1
  for(int t=0;t<NT;++t){
    if(t+1<NT){WAIT_BAR(3);}else{WAIT_BAR(0);}
    if(t+2<NT){int k2=kslot+2; if(k2>=3)k2-=3; const int v2=(vslot+2)&3; DMA2_K(t+2,k2); DMA2_V(t+2,v2);}
    if(t>=NTw){ kslot=(kslot==2)?0:kslot+1; vslot=(vslot+1)&3; continue; }
    f32x16 p0,p1;
    { bf16x8 kf[8]; kload8(kf,kp0+kslot*8192);
      asm volatile("":"+v"(kf[0]),"+v"(kf[1]),"+v"(kf[2]),"+v"(kf[3]),"+v"(kf[4]),"+v"(kf[5]),"+v"(kf[6]),"+v"(kf[7]));
      p0=__builtin_amdgcn_mfma_f32_32x32x16_bf16(kf[0],qr[0],negm,0,0,0); SBAR(); p1=__builtin_amdgcn_mfma_f32_32x32x16_bf16(kf[1],qr[0],negm,0,0,0); SBAR();
      p0=__builtin_amdgcn_mfma_f32_32x32x16_bf16(kf[2],qr[1],p0,0,0,0);   SBAR(); p1=__builtin_amdgcn_mfma_f32_32x32x16_bf16(kf[3],qr[1],p1,0,0,0);   SBAR();
      p0=__builtin_amdgcn_mfma_f32_32x32x16_bf16(kf[4],qr[2],p0,0,0,0);   SBAR(); p1=__builtin_amdgcn_mfma_f32_32x32x16_bf16(kf[5],qr[2],p1,0,0,0);   SBAR();
      p0=__builtin_amdgcn_mfma_f32_32x32x16_bf16(kf[6],qr[3],p0,0,0,0);   SBAR(); p1=__builtin_amdgcn_mfma_f32_32x32x16_bf16(kf[7],qr[3],p1,0,0,0);   SBAR(); }
    { const int jb_=t-(NT-4); if(jb_>=-3)bcorr(p0,p1,jb_,qrel,hi,dtab); if(jb_>=0)cmask(p0,p1,jb_,qrel,hi); }
    const float rm=rowmax_c(p0,p1);
    const bool resc=(t==0)||__any(rm>(float)THRL);
    if(resc){
      const float dl=(t==0)?rm:__builtin_fmaxf(rm,0.f); mhat+=dl;
      #pragma unroll
      for(int r=0;r<16;++r){p0[r]-=dl;p1[r]-=dl;negm[r]=cfar-mhat;}
      const float f=__builtin_amdgcn_exp2f(-dl); l_reg*=f; if(hi==0)wsf[r32]=f; }
    { const lds_cptr vp_=vp0+((t>0)?((vslot+3)&3):vslot)*16384;
      s16x4 vl[2][4],vh_[2][4]; f32x2_t sacc2={0.f,0.f}; unsigned q0w[8],q1w[8];
      #define GAPX(d0,ks,i) do{ o[d0]=__builtin_amdgcn_mfma_f32_32x32x16_bf16(pa[ks],VFRAG((d0)&1,ks),o[d0],0,0,0); \
          p0[i]=__builtin_amdgcn_exp2f(p0[i]); p1[i]=__builtin_amdgcn_exp2f(p1[i]); sacc2=sacc2+(f32x2_t){p0[i],p1[i]}; \
          if((i)&1){ q0w[(i)>>1]=cvtpk_s(p0[(i)-1],p0[i]); q1w[(i)>>1]=cvtpk_s(p1[(i)-1],p1[i]); asm volatile("":"+v"(q0w[(i)>>1]),"+v"(q1w[(i)>>1])); } \
          asm volatile("":"+v"(sacc2)); SBAR(); }while(0)
      VLD(0,0); VLD(1,1); PIN8(vl[0],vh_[0]); PIN8(vl[1],vh_[1]);
      GAPX(0,0,0); GAPX(1,0,1); GAPX(0,1,2); GAPX(1,1,3); GAPX(0,2,4); GAPX(1,2,5); GAPX(0,3,6); GAPX(1,3,7);
      VLD(0,2); VLD(1,3); PIN8(vl[0],vh_[0]); PIN8(vl[1],vh_[1]);
      GAPX(2,0,8); GAPX(3,0,9); GAPX(2,1,10); GAPX(3,1,11); GAPX(2,2,12); GAPX(3,2,13); GAPX(2,3,14); GAPX(3,3,15);
      #undef GAPX
      l_reg+=sacc2.x+sacc2.y;
      pa[0]=__builtin_bit_cast(bf16x8,(u32x4){q0w[0],q0w[1],q0w[2],q0w[3]}); pa[1]=__builtin_bit_cast(bf16x8,(u32x4){q0w[4],q0w[5],q0w[6],q0w[7]});
      pa[2]=__builtin_bit_cast(bf16x8,(u32x4){q1w[0],q1w[1],q1w[2],q1w[3]}); pa[3]=__builtin_bit_cast(bf16x8,(u32x4){q1w[4],q1w[5],q1w[6],q1w[7]}); }
    if(resc&&t>0){ asm volatile("s_waitcnt lgkmcnt(0)":::"memory");
      #pragma unroll
      for(int r=0;r<16;++r){const float fr_=wsf[crow(r,hi)]; o[0][r]*=fr_;o[1][r]*=fr_;o[2][r]*=fr_;o[3][r]*=fr_;} }
    kslot=(kslot==2)?0:kslot+1; vslot=(vslot+1)&3;
  }
  { const lds_cptr vp_=vp0+((NTw-1)&3)*16384; s16x4 vl[2][4],vh_[2][4];
    VLD(0,0);
    #pragma unroll
    for(int d0=0;d0<4;++d0){ if(d0<3)VLD((d0+1)&1,d0+1);
      #pragma unroll
      for(int ks=0;ks<4;++ks)o[d0]=__builtin_amdgcn_mfma_f32_32x32x16_bf16(pa[ks],VFRAG(d0&1,ks),o[d0],0,0,0);
      SBAR(); } }
  #undef PIN8
  #undef VLD
  #undef VFRAG
  asm volatile("s_waitcnt lgkmcnt(0)\n\ts_barrier":::"memory");
  {auto rr=__builtin_amdgcn_permlane32_swap(__float_as_uint(l_reg),__float_as_uint(l_reg),false,false);l_reg=__uint_as_float(rr[0])+__uint_as_float(rr[1]);}
  if(hi==0)wsf[32+r32]=l_reg;asm volatile("s_waitcnt lgkmcnt(0)":::"memory");
  float rli[16];
  #pragma unroll
  for(int r=0;r<16;++r)rli[r]=__builtin_amdgcn_rcpf(wsf[32+crow(r,hi)]);
  bf16*Ow=O+(rowbase+q0+wid*QBLK)*OP;
  if constexpr(KEEP){
    bf16*stg=(bf16*)(shm+L2_OST)+wid*4096;
    #pragma unroll
    for(int r=0;r<16;++r){const int orow=crow(r,hi);
      #pragma unroll
      for(int d0=0;d0<4;++d0)stg[orow*128+d0*32+r32]=(bf16)f2bf(o[d0][r]*rli[r]);}
  } else {
  bf16*stg=(bf16*)(shm+L2_OST)+wid*2048;
  #pragma unroll
  for(int hf=0;hf<2;++hf){
    #pragma unroll
    for(int r=0;r<16;++r){const int orow=crow(r,hi);
      #pragma unroll
      for(int d0=0;d0<2;++d0)stg[orow*64+d0*32+r32]=(bf16)f2bf(o[2*hf+d0][r]*rli[r]);}
    asm volatile("s_waitcnt lgkmcnt(0)":::"memory");
    #pragma unroll
    for(int i=0;i<4;++i){const int row=i*8+(lane>>3),ch=lane&7; const u32x4 v=*(const u32x4*)(stg+row*64+ch*8); ATTN_STORE16(Ow+(long)row*OP+hf*64+ch*8,v);}
    asm volatile("s_waitcnt lgkmcnt(0)":::"memory");
  }
  }
  asm volatile("s_waitcnt lgkmcnt(0)\n\ts_barrier":::"memory");
  #undef DMA2_K
  #undef DMA2_V
}
static_assert(L2_BYTES<=110592,"attention LDS map vs DTAB_OFF");
constexpr int ATTN_LDS_BYTES=LDS_BYTES;
#undef SBAR
#undef WAIT_BAR
}

constexpr int DTAB_OFF = 110592, DTAB_N = 704;
__device__ __forceinline__ void p2_attn_setup(Frame& F_) {
    Frame F = F_; { int t_ = F.tid; asm volatile("" : "+v"(t_)); F.tid = t_; F.lane = t_ & 63; }
    LAS float* dt = (LAS float*)(F.lds + DTAB_OFF);
    for (int i = F.tid; i < 4 * DTAB_N; i += NTHR) { const int h = i / DTAB_N, rel = i % DTAB_N - 256;
        dt[i] = (rel >= 0 && rel < 128) ? (F.in[I_REL][T5_BUCKET[rel] * 4 + h] - F.in[I_REL][31 * 4 + h]) * LOG2E : 0.f; }
    __syncthreads();
}
__device__ __forceinline__ void p2_attn_unit(Frame& F, unsigned char* lds_generic, int bh, int qb, float lam) {
    const int b = bh >> 2, h = bh & 3;
    const bf16* QA = proj_buf(F, 0); const bf16* KA = proj_buf(F, 1); const bf16* VA = proj_buf(F, 2);
    bf16* OT = (bf16*)(F.dout + DO_OTMP); bf16* MIX = (bf16*)(F.ws + WS_XN);
    const float cfar = F.in[I_REL][31 * 4 + h] * LOG2E;
    attn_body::lds_cfptr dtab = (attn_body::lds_cfptr)(F.lds + DTAB_OFF) + h * DTAB_N;
    attn_body::attn_unit128<8, false>(b, qb, QA + h * 128, KA + h * 128, VA + h * 128, OT + h * 256, (char*)lds_generic, cfar, dtab);
    attn_body::attn_unit128<8, true>(b, qb, QA + h * 128 + 64, KA + h * 128 + 64, VA + h * 128, OT + h * 256 + 128, (char*)lds_generic, cfar, dtab);
    int ln = F.lane; asm volatile("" : "+v"(ln));
    const size_t R = (size_t)b * SEQ + qb * 256 + F.wave * 32 + (ln >> 1); const int half = ln & 1;
    const v4u* o0 = (const v4u*)(OT + R * 1024 + h * 256 + half * 64);
    const LAS v4u* o1 = (const LAS v4u*)(F.lds + attn_body::L2_OST + F.wave * 8192 + (ln >> 1) * 256 + half * 128);
    float d[64]; float ss = 0.f;
#pragma unroll
    for (int c = 0; c < 8; ++c) { const v4u a = o0[c], bb = o1[c];
        d[8 * c] = bflo(a.x) - lam * bflo(bb.x); d[8 * c + 1] = bfhi(a.x) - lam * bfhi(bb.x); d[8 * c + 2] = bflo(a.y) - lam * bflo(bb.y); d[8 * c + 3] = bfhi(a.y) - lam * bfhi(bb.y);
        d[8 * c + 4] = bflo(a.z) - lam * bflo(bb.z); d[8 * c + 5] = bfhi(a.z) - lam * bfhi(bb.z); d[8 * c + 6] = bflo(a.w) - lam * bflo(bb.w); d[8 * c + 7] = bfhi(a.w) - lam * bfhi(bb.w); }
#pragma unroll
    for (int i = 0; i < 64; ++i) ss += d[i] * d[i];
    ss += __shfl_xor(ss, 1);
    const float rs = rsqrtf(ss * (1.f / 128.f) + EPS) * (1.f - LAM_INIT);
    const float* g = F.in[I_DNG] + h * 128 + half * 64; v4u* mp = (v4u*)(MIX + R * 1024 + h * 128 + half * 64);
    f32x4 gg[16];
#pragma unroll
    for (int c = 0; c < 16; ++c) gg[c] = *(const f32x4*)(g + 4 * c);
#pragma unroll
    for (int c = 0; c < 8; ++c) { const f32x4 g0 = gg[2 * c], g1 = gg[2 * c + 1];
        v4u w; w.x = pk2(d[8 * c] * rs * g0.x, d[8 * c + 1] * rs * g0.y); w.y = pk2(d[8 * c + 2] * rs * g0.z, d[8 * c + 3] * rs * g0.w);
        w.z = pk2(d[8 * c + 4] * rs * g1.x, d[8 * c + 5] * rs * g1.y); w.w = pk2(d[8 * c + 6] * rs * g1.z, d[8 * c + 7] * rs * g1.w); mp[c] = w; }
    asm volatile("s_waitcnt lgkmcnt(0)\n\ts_barrier" ::: "memory");
}
namespace ml {
constexpr int STR = 72;
constexpr int QS = 0, KS = 9216, KTS = 18432, VTS = 27648, PS = 46080, CWL = 55296, GSL = 57856, WV = 58368, HS = 74752, HSTR = 132, END = HS + 64 * HSTR * 4;
static_assert(END <= 131072, "mLSTM LDS map");
__device__ __forceinline__ f32x4 mfma16(bf16x8 a, bf16x8 b, f32x4 c) { return __builtin_amdgcn_mfma_f32_16x16x32_bf16(a, b, c, 0, 0, 0); }
__device__ __forceinline__ float red_q(float v) { v += __shfl_xor(v, 16); v += __shfl_xor(v, 32); return v; }
__device__ __forceinline__ float bfe(const bf16x8& v, int i) { return __uint_as_float(((unsigned)(unsigned short)v[i]) << 16); }
}
__device__ __forceinline__ void p2_mlstm_fast(Frame& F, int bh) {
    using namespace ml;
#define ML_BAR() asm volatile("s_waitcnt lgkmcnt(0)\n\ts_barrier" ::: "memory")
    int tid = F.tid; asm volatile("" : "+v"(tid));
    const int lane = tid & 63, w = __builtin_amdgcn_readfirstlane(tid >> 6), c = lane & 15, q = lane >> 4;
    const int b = bh >> 2, h = bh & 3; const size_t R0 = (size_t)b * SEQ;
    LAS unsigned char* L = F.lds;
    LAS bf16* Qs = (LAS bf16*)(L + QS); LAS bf16* Ks = (LAS bf16*)(L + KS); LAS bf16* KTs = (LAS bf16*)(L + KTS); LAS bf16* VTs = (LAS bf16*)(L + VTS); LAS bf16* Ps = (LAS bf16*)(L + PS);
    LAS float* cwl = (LAS float*)(L + CWL); LAS float* gs = (LAS float*)(L + GSL); LAS float* wv = (LAS float*)(L + WV) + w * 512; LAS float* Hs = (LAS float*)(L + HS);
    LAS float* Aw = wv, *Mw = wv + 64, *WIw = wv + 128, *EMw = wv + 192, *WKw = wv + 256, *Nw = wv + 320, *DNw = wv + 384;
    const bf16* MQK = proj_buf(F, 3); const bf16* MV = proj_buf(F, 4); const bf16* MO = proj_buf(F, 5); const float* GT = (const float*)(F.ws + WS_GATES);
    bf16* MIX = (bf16*)(F.ws + WS_XN);
    __syncthreads();
    for (int i = tid; i < 5 * 128; i += NTHR) { const int tap = i >> 7, cc = i & 127; const int chn = cc < 64 ? h * 64 + cc : 256 + h * 64 + (cc - 64); cwl[i] = tap < 4 ? F.in[I_CONVW][tap * 512 + chn] : F.in[I_CONVB][chn]; }
    f32x4 accC[4], nacc[4];
#pragma unroll
    for (int i = 0; i < 4; ++i) { accC[i] = (f32x4){0.f, 0.f, 0.f, 0.f}; nacc[i] = (f32x4){0.f, 0.f, 0.f, 0.f}; }
    float m_prev = 0.f;
    const int sc = tid & 31, jg = tid >> 5, cc = 4 * sc;
    const int chq = (cc < 64) ? h * 64 + cc : 256 + h * 64 + (cc - 64);
    const bool isk = cc >= 64; const float kscale = isk ? 0.125f : 1.f;
    f32x4 cw4[5];
#pragma unroll
    for (int tap = 0; tap < 5; ++tap) cw4[tap] = (f32x4){0.f, 0.f, 0.f, 0.f};
    const float mg0 = F.in[I_MLG][h * 128 + 2 * lane], mg1 = F.in[I_MLG][h * 128 + 2 * lane + 1], ob0 = F.in[I_OB][h * 128 + 2 * lane], ob1 = F.in[I_OB][h * 128 + 2 * lane + 1];
    v2u raw[7], vr[4]; float gli = 0.f, glf = 0.f;
#define ML_LOAD(ch_) do { const int ch__ = (ch_); \
        _Pragma("unroll") for (int i = 0; i < 7; ++i) { const int rr = 64 * ch__ + 4 * jg - 3 + i; \
            if (rr >= 0) raw[i] = *(const v2u*)(MQK + (R0 + rr) * 512 + chq); else raw[i] = (v2u){0u, 0u}; } \
        _Pragma("unroll") for (int i = 0; i < 4; ++i) vr[i] = *(const v2u*)(MV + (R0 + 64 * ch__ + 4 * jg + i) * 512 + h * 128 + cc); \
        gli = GT[(R0 + 64 * ch__ + lane) * 8 + h]; glf = GT[(R0 + 64 * ch__ + lane) * 8 + 4 + h]; } while (0)
    ML_LOAD(0);
    __syncthreads();
#pragma unroll
    for (int tap = 0; tap < 5; ++tap) cw4[tap] = *(const LAS f32x4*)(cwl + 128 * tap + cc);
#pragma unroll 1
    for (int ch = 0; ch < SEQ / 64; ++ch) {
        unsigned moc[8];
#pragma unroll
        for (int i = 0; i < 8; ++i) moc[i] = *(const unsigned*)(MO + (R0 + 64 * ch + 8 * w + i) * 512 + h * 128 + 2 * lane);
        ML_BAR();
        {
            float x[7][4];
#pragma unroll
            for (int i = 0; i < 7; ++i) { x[i][0] = bflo(raw[i].x); x[i][1] = bfhi(raw[i].x); x[i][2] = bflo(raw[i].y); x[i][3] = bfhi(raw[i].y); }
            float y[4][4];
#pragma unroll
            for (int r = 0; r < 4; ++r)
#pragma unroll
                for (int k = 0; k < 4; ++k) { const float t_ = cw4[4][k] + cw4[0][k] * x[r][k] + cw4[1][k] * x[r + 1][k] + cw4[2][k] * x[r + 2][k] + cw4[3][k] * x[r + 3][k]; y[r][k] = t_ * __builtin_amdgcn_rcpf(1.f + __expf(-t_)) * kscale; }
            LAS bf16* dst = isk ? Ks + (cc - 64) : Qs + cc;
#pragma unroll
            for (int r = 0; r < 4; ++r) { v2u o; o.x = pkh(y[r][0], y[r][1]); o.y = pkh(y[r][2], y[r][3]); *(LAS v2u*)(dst + (4 * jg + r) * STR) = o; }
            if (isk) {
#pragma unroll
                for (int k = 0; k < 4; ++k) { v2u o; o.x = pkh(y[0][k], y[1][k]); o.y = pkh(y[2][k], y[3][k]); *(LAS v2u*)(KTs + (cc - 64 + k) * STR + 4 * jg) = o; } }
            { v2u o;
              o.x = (vr[0].x & 0xffffu) | (vr[1].x << 16); o.y = (vr[2].x & 0xffffu) | (vr[3].x << 16); *(LAS v2u*)(VTs + (cc + 0) * STR + 4 * jg) = o;
              o.x = (vr[0].x >> 16) | (vr[1].x & 0xffff0000u); o.y = (vr[2].x >> 16) | (vr[3].x & 0xffff0000u); *(LAS v2u*)(VTs + (cc + 1) * STR + 4 * jg) = o;
              o.x = (vr[0].y & 0xffffu) | (vr[1].y << 16); o.y = (vr[2].y & 0xffffu) | (vr[3].y << 16); *(LAS v2u*)(VTs + (cc + 2) * STR + 4 * jg) = o;
              o.x = (vr[0].y >> 16) | (vr[1].y & 0xffff0000u); o.y = (vr[2].y >> 16) | (vr[3].y & 0xffff0000u); *(LAS v2u*)(VTs + (cc + 3) * STR + 4 * jg) = o; }
        }
        float decay, m_next;
        {   const float li = gli, lf = glf;
            float bsum = lf;
#pragma unroll
            for (int o = 1; o < 64; o <<= 1) { const float v_ = __shfl_up(bsum, o); if (lane >= o) bsum += v_; }
            const float a = li - bsum; float am = a;
#pragma unroll
            for (int o = 1; o < 64; o <<= 1) { const float v_ = __shfl_up(am, o); if (lane >= o) am = fmaxf(am, v_); }
            const float M = fmaxf(am, m_prev);
            const float g = __shfl(bsum, 63), M63 = __shfl(M, 63);
            Aw[lane] = a; Mw[lane] = M; WIw[lane] = __expf(m_prev - M); EMw[lane] = __expf(-(bsum + M)); WKw[lane] = __expf(a - M63);
            decay = __expf(m_prev - M63); m_next = g + M63;
        }
        if (ch + 1 < SEQ / 64) ML_LOAD(ch + 1);
        ML_BAR();
        {   const int tt = w >> 1; const bf16x8 qb0 = *(const LAS bf16x8*)(Qs + (16 * tt + c) * STR + 8 * q), qb1 = *(const LAS bf16x8*)(Qs + (16 * tt + c) * STR + 32 + 8 * q);
            const float Mt = Mw[16 * tt + c];
#pragma unroll
            for (int jj = 0; jj < 2; ++jj) { const int jt = 2 * (w & 1) + jj;
                const bf16x8 ka0 = *(const LAS bf16x8*)(Ks + (16 * jt + c) * STR + 8 * q), ka1 = *(const LAS bf16x8*)(Ks + (16 * jt + c) * STR + 32 + 8 * q);
                f32x4 sacc = mfma16(ka0, qb0, (f32x4){0.f, 0.f, 0.f, 0.f}); sacc = mfma16(ka1, qb1, sacc);
                const f32x4 a4 = *(const LAS f32x4*)(Aw + 16 * jt + 4 * q);
                float p[4];
#pragma unroll
                for (int r = 0; r < 4; ++r) p[r] = (16 * jt + 4 * q + r <= 16 * tt + c) ? sacc[r] * __expf(a4[r] - Mt) : 0.f;
                v2u pw; pw.x = pkh(p[0], p[1]); pw.y = pkh(p[2], p[3]);
                *(LAS v2u*)(Ps + (16 * tt + c) * STR + 16 * jt + 4 * q) = pw; }
        }
        ML_BAR();
        {   bf16x8 vb[2]; vb[0] = *(const LAS bf16x8*)(VTs + (16 * w + c) * STR + 8 * q); vb[1] = *(const LAS bf16x8*)(VTs + (16 * w + c) * STR + 32 + 8 * q);
            bf16x8 cbf[2];
#pragma unroll
            for (int ks = 0; ks < 2; ++ks) { v4u t_; t_.x = pkh(accC[2 * ks][0], accC[2 * ks][1]); t_.y = pkh(accC[2 * ks][2], accC[2 * ks][3]); t_.z = pkh(accC[2 * ks + 1][0], accC[2 * ks + 1][1]); t_.w = pkh(accC[2 * ks + 1][2], accC[2 * ks + 1][3]); cbf[ks] = __builtin_bit_cast(bf16x8, t_); }
            bf16x8 nb[2];
#pragma unroll
            for (int ks = 0; ks < 2; ++ks) { v4u t_; t_.x = pkh(nacc[2 * ks][0], nacc[2 * ks][1]); t_.y = pkh(nacc[2 * ks][2], nacc[2 * ks][3]); t_.z = pkh(nacc[2 * ks + 1][0], nacc[2 * ks + 1][1]); t_.w = pkh(nacc[2 * ks + 1][2], nacc[2 * ks + 1][3]); nb[ks] = __builtin_bit_cast(bf16x8, t_); }
            const bf16x8 ones8 = {(short)0x3f80, (short)0x3f80, (short)0x3f80, (short)0x3f80, (short)0x3f80, (short)0x3f80, (short)0x3f80, (short)0x3f80};
#pragma unroll
            for (int m = 0; m < 4; ++m) {
                f32x4 ia = (f32x4){0.f, 0.f, 0.f, 0.f}, ie = (f32x4){0.f, 0.f, 0.f, 0.f}, rs4 = (f32x4){0.f, 0.f, 0.f, 0.f}, qn4 = (f32x4){0.f, 0.f, 0.f, 0.f};
#pragma unroll
                for (int ks = 0; ks < 2; ++ks) {
                    const bf16x8 pa = *(const LAS bf16x8*)(Ps + (16 * m + c) * STR + 32 * ks + 8 * q);
                    ia = mfma16(pa, vb[ks], ia); rs4 = mfma16(pa, ones8, rs4);
                    const v2u qlo = *(const LAS v2u*)(Qs + (16 * m + c) * STR + 32 * ks + 4 * q), qhi = *(const LAS v2u*)(Qs + (16 * m + c) * STR + 32 * ks + 16 + 4 * q);
                    v4u qq; qq.x = qlo.x; qq.y = qlo.y; qq.z = qhi.x; qq.w = qhi.y; const bf16x8 qa = __builtin_bit_cast(bf16x8, qq);
                    ie = mfma16(qa, cbf[ks], ie); qn4 = mfma16(qa, nb[ks], qn4);
                }
                const f32x4 wi4 = *(const LAS f32x4*)(WIw + 16 * m + 4 * q), em4 = *(const LAS f32x4*)(EMw + 16 * m + 4 * q);
#pragma unroll
                for (int r = 0; r < 4; ++r) { const float den = rs4[r] + wi4[r] * qn4[r]; const float rden = __builtin_amdgcn_rcpf(fmaxf(fabsf(den), em4[r]));
                    Hs[(16 * m + 4 * q + r) * HSTR + 16 * w + c] = (ia[r] + wi4[r] * ie[r]) * rden; }
            }
            f32x4 wk8[2][2];
#pragma unroll
            for (int ks = 0; ks < 2; ++ks) { wk8[ks][0] = *(const LAS f32x4*)(WKw + 32 * ks + 8 * q); wk8[ks][1] = *(const LAS f32x4*)(WKw + 32 * ks + 8 * q + 4); }
            bf16x8 vs[2], wkb[2];
#pragma unroll
            for (int ks = 0; ks < 2; ++ks) { v4u t_; t_.x = pkh(bfe(vb[ks], 0) * wk8[ks][0][0], bfe(vb[ks], 1) * wk8[ks][0][1]); t_.y = pkh(bfe(vb[ks], 2) * wk8[ks][0][2], bfe(vb[ks], 3) * wk8[ks][0][3]);
                t_.z = pkh(bfe(vb[ks], 4) * wk8[ks][1][0], bfe(vb[ks], 5) * wk8[ks][1][1]); t_.w = pkh(bfe(vb[ks], 6) * wk8[ks][1][2], bfe(vb[ks], 7) * wk8[ks][1][3]); vs[ks] = __builtin_bit_cast(bf16x8, t_);
                v4u u_; u_.x = pkh(wk8[ks][0][0], wk8[ks][0][1]); u_.y = pkh(wk8[ks][0][2], wk8[ks][0][3]); u_.z = pkh(wk8[ks][1][0], wk8[ks][1][1]); u_.w = pkh(wk8[ks][1][2], wk8[ks][1][3]); wkb[ks] = __builtin_bit_cast(bf16x8, u_); }
#pragma unroll
            for (int dt = 0; dt < 4; ++dt) { f32x4 ca = accC[dt] * decay, na = nacc[dt] * decay;
#pragma unroll
                for (int ks = 0; ks < 2; ++ks) { const bf16x8 ka = *(const LAS bf16x8*)(KTs + (16 * dt + c) * STR + 32 * ks + 8 * q); ca = mfma16(ka, vs[ks], ca); na = mfma16(ka, wkb[ks], na); }
                accC[dt] = ca; nacc[dt] = na; }
            m_prev = m_next;
        }
        ML_BAR();
#pragma unroll
        for (int i = 0; i < 8; ++i) { const int t = 8 * w + i; const float h0 = Hs[t * HSTR + 2 * lane], h1 = Hs[t * HSTR + 2 * lane + 1];
            const float rsn = rsqrtf(wave_sum(h0 * h0 + h1 * h1) * (1.f / 128.f) + EPS);
            const float o0 = h0 * rsn * mg0 * sigmoidf_(bflo(moc[i]) + ob0), o1 = h1 * rsn * mg1 * sigmoidf_(bfhi(moc[i]) + ob1);
            *(unsigned*)(MIX + (R0 + 64 * ch + t) * 1024 + 512 + h * 128 + 2 * lane) = pkh(o0, o1); }
    }
#undef ML_LOAD
#undef ML_BAR
    __syncthreads();
}

__device__ __forceinline__ void p4_route(Frame& F_) {
    Frame F = F_; { int t_ = F.tid; asm volatile("" : "+v"(t_)); F.tid = t_; F.lane = t_ & 63; }
    LAS v4u* wf = (LAS v4u*)F.lds;
    LAS unsigned* hist = (LAS unsigned*)(F.lds + L_HIST);
    for (int i = F.tid; i < 32 * 2 * 64; i += NTHR) { const int ln = i & 63, nt = (i >> 6) & 1, s_ = i >> 7, e = 16 * nt + (ln & 15), k0 = 32 * s_ + 8 * (ln >> 4);
        float w[8]; unsigned hi16[8], lo16[8];
#pragma unroll
        for (int j = 0; j < 8; ++j) { w[j] = F.in[I_RW][(k0 + j) * NE + e] * F.in[I_G2][k0 + j]; hi16[j] = f2bf(w[j]); lo16[j] = f2bf(w[j] - __uint_as_float(hi16[j] << 16)); }
        v4u h4, l4; h4.x = hi16[0] | (hi16[1] << 16); h4.y = hi16[2] | (hi16[3] << 16); h4.z = hi16[4] | (hi16[5] << 16); h4.w = hi16[6] | (hi16[7] << 16);
        l4.x = lo16[0] | (lo16[1] << 16); l4.y = lo16[2] | (lo16[3] << 16); l4.z = lo16[4] | (lo16[5] << 16); l4.w = lo16[6] | (lo16[7] << 16);
        wf[((s_ * 2 + nt) * 2 + 0) * 64 + ln] = h4; wf[((s_ * 2 + nt) * 2 + 1) * 64 + ln] = l4; }
    const bf16* X1 = (const bf16*)(F.ws + WS_X1B);
    float* RS = (float*)(F.ws + WS_RSTD2); unsigned* TI = (unsigned*)(F.ws + WS_TOKINFO); float* GA = (float*)(F.ws + WS_GATE); unsigned* HIST = (unsigned*)(F.ws + WS_HIST);
    const int c = F.lane & 15, q = F.lane >> 4;
    const float rb0 = F.in[I_RB][c], rb1 = F.in[I_RB][16 + c];
    for (int blk = F.vcu; blk < T / 256; blk += F.G) {
        if (F.tid < 32) hist[F.tid] = 0u;
        __syncthreads();
#pragma unroll 1
        for (int grp = 0; grp < 2; ++grp) {
            const int t0 = blk * 256 + F.wave * 32 + grp * 16;
            const bf16x8* xr = (const bf16x8*)(X1 + (size_t)(t0 + c) * D + 8 * q);
            bf16x8 xa[32];
#pragma unroll
            for (int s_ = 0; s_ < 32; ++s_) xa[s_] = xr[4 * s_];
            f32x4 l0 = (f32x4){0.f, 0.f, 0.f, 0.f}, l1 = (f32x4){0.f, 0.f, 0.f, 0.f}; float ss = 0.f;
#pragma unroll
            for (int s_ = 0; s_ < 32; ++s_) {
                const bf16x8 b0h = __builtin_bit_cast(bf16x8, wf[((s_ * 2 + 0) * 2 + 0) * 64 + F.lane]), b0l = __builtin_bit_cast(bf16x8, wf[((s_ * 2 + 0) * 2 + 1) * 64 + F.lane]);
                const bf16x8 b1h = __builtin_bit_cast(bf16x8, wf[((s_ * 2 + 1) * 2 + 0) * 64 + F.lane]), b1l = __builtin_bit_cast(bf16x8, wf[((s_ * 2 + 1) * 2 + 1) * 64 + F.lane]);
                l0 = __builtin_amdgcn_mfma_f32_16x16x32_bf16(xa[s_], b0h, l0, 0, 0, 0); l0 = __builtin_amdgcn_mfma_f32_16x16x32_bf16(xa[s_], b0l, l0, 0, 0, 0);
                l1 = __builtin_amdgcn_mfma_f32_16x16x32_bf16(xa[s_], b1h, l1, 0, 0, 0); l1 = __builtin_amdgcn_mfma_f32_16x16x32_bf16(xa[s_], b1l, l1, 0, 0, 0);
#pragma unroll
                for (int j = 0; j < 8; ++j) { const float xv = __uint_as_float(((unsigned)(unsigned short)xa[s_][j]) << 16); ss += xv * xv; }
            }
            ss += __shfl_xor(ss, 16); ss += __shfl_xor(ss, 32);
            const float rstd_c = rsqrtf(ss * (1.f / D) + EPS);
#pragma unroll
            for (int r = 0; r < 4; ++r) {
                const float rstd = __shfl(rstd_c, 4 * q + r);
                const float g0 = l0[r] * rstd + rb0, g1 = l1[r] * rstd + rb1;
                int k0, k1; { const int b_ = __float_as_int(g0); k0 = b_ ^ ((b_ >> 31) & 0x7fffffff); k0 = (k0 & ~31) | (31 - c); }
                { const int b_ = __float_as_int(g1); k1 = b_ ^ ((b_ >> 31) & 0x7fffffff); k1 = (k1 & ~31) | (15 - c); }
                float tv[4]; int te[4];
#pragma unroll
                for (int k = 0; k < 4; ++k) { int mx = k0 > k1 ? k0 : k1;
#pragma unroll
                    for (int o = 1; o < 16; o <<= 1) { const int other = __shfl_xor(mx, o); mx = other > mx ? other : mx; }
                    te[k] = 31 - (mx & 31); { const int kk = mx & ~31; tv[k] = __int_as_float(kk ^ ((kk >> 31) & 0x7fffffff)); }
                    if (te[k] == c) k0 = (int)0x80000000; if (te[k] == 16 + c) k1 = (int)0x80000000; }
                const float e1 = __expf(tv[1] - tv[0]), e2 = __expf(tv[2] - tv[0]), e3 = __expf(tv[3] - tv[0]); const float inv = 1.f / (1.f + e1 + e2 + e3);
                if (c == 0) { const int t = t0 + 4 * q + r;
                    RS[t] = rstd;
                    f32x4 g; g.x = inv; g.y = e1 * inv; g.z = e2 * inv; g.w = e3 * inv; *(f32x4*)(GA + (size_t)t * 4) = g;
                    v4u ti;
                    ti.x = ((unsigned)te[0] << 20) | atomicAdd((unsigned*)&hist[te[0]], 1u); ti.y = ((unsigned)te[1] << 20) | atomicAdd((unsigned*)&hist[te[1]], 1u);
                    ti.z = ((unsigned)te[2] << 20) | atomicAdd((unsigned*)&hist[te[2]], 1u); ti.w = ((unsigned)te[3] << 20) | atomicAdd((unsigned*)&hist[te[3]], 1u);
                    *(v4u*)(TI + (size_t)t * 4) = ti; }
            }
        }
        __syncthreads();
        if (F.tid < 32) HIST[blk * 32 + F.tid] = hist[F.tid];
        __syncthreads();
    }
}

__device__ __forceinline__ void p4b_lists(Frame& F_) {
    Frame F = F_; { int t_ = F.tid; asm volatile("" : "+v"(t_)); F.tid = t_; F.lane = t_ & 63; }
    LAS int* pb = (LAS int*)F.lds; LAS int* pa = pb + 512; LAS unsigned* basew = (LAS unsigned*)(F.lds + L_BASE);
    LAS int* tb = (LAS int*)(F.lds + L_ETAB); LAS int* cn = tb + 40;
    const unsigned* HIST = (const unsigned*)(F.ws + WS_HIST); const float* RS = (const float*)(F.ws + WS_RSTD2);
    unsigned* TI = (unsigned*)(F.ws + WS_TOKINFO); int* LIST = (int*)(F.ws + WS_LIST); float* LRS = (float*)(F.ws + WS_LISTRS);
    { const int e = F.tid & 31, p = F.tid >> 5; int sa = 0;
#pragma unroll
      for (int i = 0; i < 16; ++i) sa += (int)HIST[(16 * p + i) * 32 + e];
      pa[F.tid] = sa; }
    __syncthreads();
    if (F.tid < 32) { int sa = 0;
#pragma unroll
        for (int p = 0; p < 16; ++p) sa += pa[32 * p + F.tid];
        cn[F.tid] = sa; }
    __syncthreads();
    if (F.tid == 0) { int acc = 0; for (int e = 0; e < NE; ++e) { tb[e] = acc; acc += (cn[e] + 255) >> 8; } tb[NE] = acc; }
    for (int blk = F.vcu; blk < T / 256; blk += F.G) {
        { const int e = F.tid & 31, p = F.tid >> 5; int sb = 0;
#pragma unroll
          for (int i = 0; i < 16; ++i) { const int bb = 16 * p + i; const int hv = (int)HIST[bb * 32 + e]; sb += bb < blk ? hv : 0; }
          pb[F.tid] = sb; }
        __syncthreads();
        if (F.tid < 32) { int sb = 0;
#pragma unroll
            for (int p = 0; p < 16; ++p) sb += pb[32 * p + F.tid];
            basew[F.tid] = (unsigned)sb; }
        __syncthreads();
        for (int i = F.tid; i < 1024; i += NTHR) {
            const int t = blk * 256 + (i >> 2); const unsigned ti = TI[(size_t)t * 4 + (i & 3)]; const unsigned e = ti >> 20, pos = basew[e] + (ti & 0xfffffu);
            TI[(size_t)t * 4 + (i & 3)] = (e << 20) | pos; LIST[(size_t)e * T + pos] = t; LRS[(size_t)e * T + pos] = RS[t];
        }
        __syncthreads();
    }
}

__device__ __forceinline__ int find_expert(const LAS int* tb, int tile256) { int e = 0;
#pragma unroll 1
    for (int i = 1; i < NE; ++i) e = (tile256 >= tb[i]) ? i : e;
    return e; }

struct DenseSched {
    pg8::TileOrder ord; const char* A; const char* Bt; int K;
    __device__ __forceinline__ bool next(int i, pg8::Unit& u) const { u.e = 0; return ord.next_tile(i, u.pm, u.pn); }
    __device__ __forceinline__ void a_view(const pg8::Unit& u, const int (&R)[2], const int (&C)[2], const char*& base, unsigned (&off)[2][2]) const {
        base = A + (size_t)u.pm * 256 * K * 2;
#pragma unroll
        for (int h = 0; h < 2; ++h)
#pragma unroll
            for (int i = 0; i < 2; ++i) off[h][i] = (unsigned)((h * 128 + R[i]) * K + C[i]) * 2u;
    }
    __device__ __forceinline__ void a_pre(const pg8::Unit&, const int (&)[2], unsigned (&)[2][2]) const {}
    __device__ __forceinline__ void a_post(const pg8::Unit& u, unsigned (&)[2][2], const int (&R)[2], const int (&C)[2], const char*& base, unsigned (&off)[2][2]) const { a_view(u, R, C, base, off); }
    __device__ __forceinline__ const char* b_base(const pg8::Unit& u) const { return Bt + (size_t)u.pn * 256 * K * 2; }
};
struct EpiProj {
    unsigned char* ws;
    __device__ __forceinline__ void operator()(const f32x4 (&acc)[2][2][4][2], const pg8::Unit& u, int wr, int wc, int fr, int fq) const {
        asm volatile("" : "+v"(fr));
        const int buf = u.pn >> 1; bf16* base = (bf16*)(ws + proj_off(buf)); const float sc = buf == 0 ? C2 : 1.f;
        const int row0 = u.pm * 256 + wr * 64 + fr, col0 = (u.pn & 1) * 256 + wc * 32 + 8 * fq;
#pragma unroll
        for (int ai = 0; ai < 2; ++ai)
#pragma unroll
            for (int m = 0; m < 4; ++m) { bf16* rowp = base + (size_t)(row0 + ai * 128 + m * 16) * 512 + col0;
#pragma unroll
                for (int bj = 0; bj < 2; ++bj) { const f32x4 v0 = acc[ai][bj][m][0] * sc, v1 = acc[ai][bj][m][1] * sc;
                    v4u w; w.x = pg8::cvt_pk_bf16(v0[0], v0[1]); w.y = pg8::cvt_pk_bf16(v0[2], v0[3]); w.z = pg8::cvt_pk_bf16(v1[0], v1[1]); w.w = pg8::cvt_pk_bf16(v1[2], v1[3]);
                    *(v4u*)(rowp + bj * 128) = w; } }
    }
};
struct EpiOutProj {
    const float* x; bf16* X1; unsigned char* X8;
    __device__ __forceinline__ void operator()(const f32x4 (&acc)[2][2][4][2], const pg8::Unit& u, int wr, int wc, int fr, int fq) const {
        asm volatile("" : "+v"(fr));
        const int row0 = u.pm * 256 + wr * 64 + fr, col0 = u.pn * 256 + wc * 32 + 8 * fq;
#pragma unroll
        for (int ai = 0; ai < 2; ++ai)
#pragma unroll
            for (int m = 0; m < 4; ++m) { const size_t ro = (size_t)(row0 + ai * 128 + m * 16) * D + col0;
#pragma unroll
                for (int bj = 0; bj < 2; ++bj) { const f32x4 v0 = acc[ai][bj][m][0] + *(const f32x4*)(x + ro + bj * 128), v1 = acc[ai][bj][m][1] + *(const f32x4*)(x + ro + bj * 128 + 4);
                    v4u w; w.x = pg8::cvt_pk_bf16(v0[0], v0[1]); w.y = pg8::cvt_pk_bf16(v0[2], v0[3]); w.z = pg8::cvt_pk_bf16(v1[0], v1[1]); w.w = pg8::cvt_pk_bf16(v1[2], v1[3]);
                    *(v4u*)(X1 + ro + bj * 128) = w;
                    v2u w8; w8.x = pk4_fp8(v0[0], v0[1], v0[2], v0[3]); w8.y = pk4_fp8(v1[0], v1[1], v1[2], v1[3]); *(v2u*)(X8 + ro + bj * 128) = w8; } }
    }
};
template <bool GATHER> struct MoeSched8 {
    pg8::TileOrder ord; const LAS int* tb; const LAS int* cn; const char* A; const char* W; const int* LIST; int wrows;
    __device__ __forceinline__ bool next(int i, pg8::Unit& u) const { if (!ord.next_tile(i, u.pm, u.pn)) return false; u.e = find_expert(tb, u.pm); return true; }
    __device__ __forceinline__ void a_view(const pg8::Unit& u, const int (&R)[2], const int (&C)[2], const char*& base, unsigned (&off)[2][2]) const {
        if constexpr (GATHER) {
            base = A; const int pos0 = (u.pm - tb[u.e]) * 256, cnt = cn[u.e]; const int* lst = LIST + (size_t)u.e * T;
#pragma unroll
            for (int h = 0; h < 2; ++h)
#pragma unroll
                for (int i = 0; i < 2; ++i) { int p = pos0 + h * 128 + R[i]; p = p < cnt ? p : cnt - 1; off[h][i] = (unsigned)(lst[p] * D + C[i] * 2); }
        } else {
            base = A + (size_t)u.pm * 256 * DFF;
#pragma unroll
            for (int h = 0; h < 2; ++h)
#pragma unroll
                for (int i = 0; i < 2; ++i) off[h][i] = (unsigned)((h * 128 + R[i]) * DFF + C[i] * 2);
        }
    }
    __device__ __forceinline__ void a_pre(const pg8::Unit& u, const int (&R)[2], unsigned (&pre)[2][2]) const {
        if constexpr (GATHER) { const int pos0 = (u.pm - tb[u.e]) * 256, cnt = cn[u.e]; const int* lst = LIST + (size_t)u.e * T;
#pragma unroll
            for (int h = 0; h < 2; ++h)
#pragma unroll
                for (int i = 0; i < 2; ++i) { int p = pos0 + h * 128 + R[i]; p = p < cnt ? p : cnt - 1; const int* ptr = lst + p;
                    asm volatile("global_load_dword %0, %1, off" : "=v"(pre[h][i]) : "v"(ptr)); }
        }
    }
    __device__ __forceinline__ void a_post(const pg8::Unit& u, unsigned (&pre)[2][2], const int (&R)[2], const int (&C)[2], const char*& base, unsigned (&off)[2][2]) const {
        if constexpr (GATHER) { base = A;
#pragma unroll
            for (int h = 0; h < 2; ++h)
#pragma unroll
                for (int i = 0; i < 2; ++i) { asm volatile("" : "+v"(pre[h][i])); off[h][i] = pre[h][i] * (unsigned)D + (unsigned)(C[i] * 2); }
        } else a_view(u, R, C, base, off);
    }
    __device__ __forceinline__ const char* b_base(const pg8::Unit& u) const { return W + ((size_t)u.e * wrows + (size_t)u.pn * 256) * D; }
};
typedef float f32x2v __attribute__((ext_vector_type(2)));
__device__ __forceinline__ f32x2v swiglu_pk(f32x2v accg, f32x2v accl, f32x2v rs2, f32x2v bgv, f32x2v blv) {
    f32x2v g = __builtin_elementwise_fma(accg, rs2, bgv), l = __builtin_elementwise_fma(accl, rs2, blv);
    g.x = fminf(g.x, 7.f); g.y = fminf(g.y, 7.f); l.x = __builtin_amdgcn_fmed3f(l.x, -7.f, 7.f); l.y = __builtin_amdgcn_fmed3f(l.y, -7.f, 7.f);
    f32x2v z = g * -2.45546696f;
    f32x2v e; e.x = __builtin_amdgcn_exp2f(z.x); e.y = __builtin_amdgcn_exp2f(z.y);
    e = e + 1.0f; f32x2v r; r.x = __builtin_amdgcn_rcpf(e.x); r.y = __builtin_amdgcn_rcpf(e.y);
    return (g * r) * (l + 1.0f);
}
struct EpiGateUp8 {
    const LAS int* tb; const LAS int* cn; const float* LRS; const float* bgu; unsigned char* ACT8;
    __device__ __forceinline__ void operator()(const f32x4 (&acc)[2][2][4][2], const pg8::Unit& u, int wr, int wc, int fr, int fq) const {
        asm volatile("" : "+v"(fr));
        const int pos0 = (u.pm - tb[u.e]) * 256, cnt = cn[u.e]; const float* lrs = LRS + (size_t)u.e * T; const float* bg = bgu + (size_t)u.e * 2 * DFF;
        const int j0 = u.pn * 128 + wc * 32 + 8 * fq;
        const f32x4 bg0 = *(const f32x4*)(bg + j0), bg1 = *(const f32x4*)(bg + j0 + 4), bl0 = *(const f32x4*)(bg + DFF + j0), bl1 = *(const f32x4*)(bg + DFF + j0 + 4);
        unsigned char* abase = ACT8 + (size_t)u.pm * 256 * DFF;
#pragma unroll
        for (int ai = 0; ai < 2; ++ai)
#pragma unroll
            for (int m = 0; m < 4; ++m) { const int rl = ai * 128 + wr * 64 + m * 16 + fr; int p = pos0 + rl; p = p < cnt ? p : cnt - 1; const float rs = lrs[p]; const f32x2v rs2 = {rs, rs};
                const f32x4 ag0 = acc[ai][0][m][0], ag1 = acc[ai][0][m][1], al0 = acc[ai][1][m][0], al1 = acc[ai][1][m][1];
                const f32x2v o0 = swiglu_pk((f32x2v){ag0[0], ag0[1]}, (f32x2v){al0[0], al0[1]}, rs2, (f32x2v){bg0[0], bg0[1]}, (f32x2v){bl0[0], bl0[1]});
                const f32x2v o1 = swiglu_pk((f32x2v){ag0[2], ag0[3]}, (f32x2v){al0[2], al0[3]}, rs2, (f32x2v){bg0[2], bg0[3]}, (f32x2v){bl0[2], bl0[3]});
                const f32x2v o2 = swiglu_pk((f32x2v){ag1[0], ag1[1]}, (f32x2v){al1[0], al1[1]}, rs2, (f32x2v){bg1[0], bg1[1]}, (f32x2v){bl1[0], bl1[1]});
                const f32x2v o3 = swiglu_pk((f32x2v){ag1[2], ag1[3]}, (f32x2v){al1[2], al1[3]}, rs2, (f32x2v){bg1[2], bg1[3]}, (f32x2v){bl1[2], bl1[3]});
                v2u w; w.x = pk4_fp8(o0.x, o0.y, o1.x, o1.y); w.y = pk4_fp8(o2.x, o2.y, o3.x, o3.y);
                *(v2u*)(abase + (size_t)rl * DFF + j0) = w; }
    }
};
struct EpiDown {
    const float* bdn; unsigned char* YK8;
    __device__ __forceinline__ void operator()(const f32x4 (&acc)[2][2][4][2], const pg8::Unit& u, int wr, int wc, int fr, int fq) const {
        asm volatile("" : "+v"(fr));
        const float* bd = bdn + (size_t)u.e * D; const int row0 = u.pm * 256 + wr * 64 + fr, col0 = u.pn * 256 + wc * 32 + 8 * fq;
        f32x4 bv[2][2];
#pragma unroll
        for (int bj = 0; bj < 2; ++bj)
#pragma unroll
            for (int n = 0; n < 2; ++n) bv[bj][n] = *(const f32x4*)(bd + col0 + bj * 128 + 4 * n);
#pragma unroll
        for (int ai = 0; ai < 2; ++ai)
#pragma unroll
            for (int m = 0; m < 4; ++m) { unsigned char* rowp = YK8 + (size_t)(row0 + ai * 128 + m * 16) * D + col0;
#pragma unroll
                for (int bj = 0; bj < 2; ++bj) { const f32x4 v0 = acc[ai][bj][m][0] + bv[bj][0], v1 = acc[ai][bj][m][1] + bv[bj][1];
                    v2u w; w.x = pk4_fp8(v0[0], v0[1], v0[2], v0[3]); w.y = pk4_fp8(v1[0], v1[1], v1[2], v1[3]);
                    *(v2u*)(rowp + bj * 128) = w; } }
    }
};

__device__ __forceinline__ void p7_final(Frame& F_) {
    Frame F = F_; { int t_ = F.tid; asm volatile("" : "+v"(t_)); F.tid = t_; F.lane = t_ & 63; }
    const LAS int* tb = (const LAS int*)(F.lds + L_ETAB);
    const bf16* X1 = (const bf16*)(F.ws + WS_X1B); const unsigned char* YK = F.ws + WS_YK; const unsigned* TI = (const unsigned*)(F.ws + WS_TOKINFO); const float* GA = (const float*)(F.ws + WS_GATE);
    const float* gf = F.in[I_GF]; float* out = (float*)F.dout;
    const int gw = F.vcu * NWAVES + F.wave, NGW = F.G * NWAVES;
    v4u ti_n[2]; f32x4 ga_n[2];
#pragma unroll
    for (int r = 0; r < 2; ++r) { const int tt = gw + r * NGW; const int tc = tt < T ? tt : 0; ti_n[r] = *(const v4u*)(TI + (size_t)tc * 4); ga_n[r] = *(const f32x4*)(GA + (size_t)tc * 4); }
    for (int t0 = gw; t0 < T; t0 += 2 * NGW) {
        v4u ti[2]; f32x4 ga[2];
#pragma unroll
        for (int r = 0; r < 2; ++r) { ti[r] = ti_n[r]; ga[r] = ga_n[r]; }
#pragma unroll
        for (int r = 0; r < 2; ++r) { const int tt = t0 + (2 + r) * NGW; const int tc = tt < T ? tt : 0; ti_n[r] = *(const v4u*)(TI + (size_t)tc * 4); ga_n[r] = *(const f32x4*)(GA + (size_t)tc * 4); }
        v2u xw[2][4]; int yw[2][4][4];
#pragma unroll
        for (int r = 0; r < 2; ++r) { const int tt = t0 + r * NGW; const int t = tt < T ? tt : t0;
            const unsigned tw[4] = {ti[r].x, ti[r].y, ti[r].z, ti[r].w};
#pragma unroll
            for (int j = 0; j < 4; ++j) xw[r][j] = *((const v2u*)(X1 + (size_t)t * D) + F.lane + 64 * j);
#pragma unroll
            for (int k = 0; k < 4; ++k) { const unsigned char* yr = YK + (size_t)(256 * tb[tw[k] >> 20] + (int)(tw[k] & 0xfffffu)) * D;
#pragma unroll
                for (int j = 0; j < 4; ++j) yw[r][k][j] = *((const int*)yr + F.lane + 64 * j); } }
#pragma unroll
        for (int r = 0; r < 2; ++r) { const int t = t0 + r * NGW; if (t >= T) break;
            f32x4 v[4]; float ss = 0.f;
#pragma unroll
            for (int j = 0; j < 4; ++j) { const v2u w = xw[r][j];
                f32x4 a; a.x = bflo(w.x); a.y = bfhi(w.x); a.z = bflo(w.y); a.w = bfhi(w.y);
#pragma unroll
                for (int k = 0; k < 4; ++k) { const int y = yw[r][k][j]; const float gk = ga[r][k];
                    a.x += gk * __builtin_amdgcn_cvt_f32_fp8(y, 0); a.y += gk * __builtin_amdgcn_cvt_f32_fp8(y, 1); a.z += gk * __builtin_amdgcn_cvt_f32_fp8(y, 2); a.w += gk * __builtin_amdgcn_cvt_f32_fp8(y, 3); }
                v[j] = a; ss += a.x * a.x + a.y * a.y + a.z * a.z + a.w * a.w; }
            const float rs = rsqrtf(wave_sum(ss) * (1.f / D) + EPS);
#pragma unroll
            for (int j = 0; j < 4; ++j) { const f32x4 g = *((const f32x4*)gf + F.lane + 64 * j); *((f32x4*)(out + (size_t)t * D) + F.lane + 64 * j) = v[j] * rs * g; }
        }
    }
}

__global__ void __launch_bounds__(NTHR, 2) hymba_fwd(Args args) {
    extern __shared__ __attribute__((aligned(16))) unsigned char lds[];
    Frame F;
    F.lds = (LAS unsigned char*)lds;
    F.tid = threadIdx.x; F.lane = F.tid & 63; F.wave = __builtin_amdgcn_readfirstlane(F.tid >> 6);
    F.G = gridDim.x; { const int bx = blockIdx.x; F.vcu = (F.G % 8 == 0) ? (bx % 8) * (F.G / 8) + bx / 8 : bx; }
    F.ws = args.ws; F.dout = (unsigned char*)args.out; F.ctl = (unsigned*)(args.ws + WS_CTL);
#pragma unroll
    for (int i = 0; i < 23; ++i) F.in[i] = args.in[i];
    for (int u = F.tid; u < (LDS_BYTES - LDSCTL_OFF) / 4; u += NTHR) ((LAS unsigned*)(F.lds + LDSCTL_OFF))[u] = 0u;
    __syncthreads();
    XcdBarrier bar = xcd_barrier_post(F.ctl + CW_BAR, (volatile LAS unsigned*)(F.lds + MISC_OFF) + 8);

#ifndef PROBE_DUP
#define PROBE_DUP (-1)
#endif
#define RUN_PHASE(n, ...) do { __VA_ARGS__; if (PROBE_DUP == (n)) { xcd_barrier(bar); __VA_ARGS__; } } while (0)
    const LAS int* etb = (const LAS int*)(F.lds + L_ETAB);
    RUN_PHASE(0, p0_prologue(F));
    xcd_barrier(bar);
    RUN_PHASE(1, { DenseSched S; S.ord.init(T / 256, 12, F.G, (int)blockIdx.x); S.A = (const char*)(F.ws + WS_XN); S.Bt = (const char*)(F.ws + WS_WIN); S.K = D;
        EpiProj E{F.ws}; pg8::gemm_phase<EpiProj, DenseSched, true, true>(F.lds, D / 64, D * 2, S, E); });
    xcd_barrier(bar);
    { const float lam = compute_lambda(F);
      p2_attn_setup(F);
#pragma unroll 1
      for (int rep = 0; rep < (PROBE_DUP == 2 ? 2 : 1); ++rep) {
          if (rep) xcd_barrier(bar);
          for (int v = F.vcu; v < 256; v += F.G) { const int bh = v >> 2, ty = v & 3;
              if (ty == 0) p2_mlstm_fast(F, bh);
              const unsigned long long sched = ty == 0 ? 0x012ull : ty == 1 ? 0xDEFull : ty == 2 ? 0x8ABCull : 0x345679ull;
              const int nq = ty == 0 ? 3 : ty == 1 ? 3 : ty == 2 ? 4 : 6;
#pragma unroll 1
              for (int i = nq - 1; i >= 0; --i) p2_attn_unit(F, lds, bh, (int)((sched >> (4 * i)) & 15ull), lam);
          }
      }
    }
    xcd_barrier(bar);
    RUN_PHASE(3, { DenseSched S; S.ord.init(T / 256, 4, F.G, (int)blockIdx.x); S.A = (const char*)(F.ws + WS_XN); S.Bt = (const char*)(F.ws + WS_WOUT); S.K = D;
        EpiOutProj E{F.in[I_X], (bf16*)(F.ws + WS_X1B), F.ws + WS_X1F8}; pg8::gemm_phase<EpiOutProj, DenseSched, true, true>(F.lds, D / 64, D * 2, S, E); });
    xcd_barrier(bar);
    p4_route(F);
    xcd_barrier(bar);
    p4b_lists(F);
    xcd_barrier(bar);
    RUN_PHASE(5, { MoeSched8<true> S; S.ord.init(etb[NE], 8, F.G, (int)blockIdx.x); S.tb = etb; S.cn = etb + 40; S.A = (const char*)(F.ws + WS_X1F8); S.W = (const char*)(F.ws + WS_WGU); S.LIST = (const int*)(F.ws + WS_LIST); S.wrows = 2 * DFF;
        EpiGateUp8 E{etb, etb + 40, (const float*)(F.ws + WS_LISTRS), F.in[I_BGU], F.ws + WS_ACT};
        pg8::gemm_phase<EpiGateUp8, MoeSched8<true>, true, true, true, 0x79797979, 0x7f7f7f7f>(F.lds, D / 128, D, S, E); });
    xcd_barrier(bar);
    RUN_PHASE(6, { MoeSched8<false> S; S.ord.init(etb[NE], 4, F.G, (int)blockIdx.x); S.tb = etb; S.cn = etb + 40; S.A = (const char*)(F.ws + WS_ACT); S.W = (const char*)(F.ws + WS_WDOWN); S.LIST = nullptr; S.wrows = D;
        EpiDown E{F.in[I_BDN], F.ws + WS_YK};
        pg8::gemm_phase<EpiDown, MoeSched8<false>, true, true, true, 0x79797979, 0x7f7f7f7f>(F.lds, DFF / 128, DFF, S, E); });
    xcd_barrier(bar);
    RUN_PHASE(7, p7_final(F));
}

extern "C" void kernel_launch(void* const* d_in, const int* in_sizes, int n_in, void* d_out, int out_size, void* d_ws, size_t ws_size, hipStream_t stream) {
    static int grid = 0;
    if (grid == 0) {
        if (n_in != 23 || in_sizes[0] != T * D || out_size != T * D || ws_size < WS_END) { fprintf(stderr, "kernel_launch: unexpected shapes (n_in %d, in0 %d, out %d, ws %zu); nothing launched\n", n_in, n_in > 0 ? in_sizes[0] : -1, out_size, ws_size); grid = -1; return; }
        int dev = 0, cus = 0, per_cu = 0;
        if (hipGetDevice(&dev) != hipSuccess || hipDeviceGetAttribute(&cus, hipDeviceAttributeMultiprocessorCount, dev) != hipSuccess) { grid = -1; return; }
        if (hipFuncSetAttribute((const void*)hymba_fwd, hipFuncAttributeMaxDynamicSharedMemorySize, LDS_BYTES) != hipSuccess) { fprintf(stderr, "kernel_launch: hipFuncSetAttribute failed\n"); grid = -1; return; }
        if (hipOccupancyMaxActiveBlocksPerMultiprocessor(&per_cu, (const void*)hymba_fwd, NTHR, LDS_BYTES) != hipSuccess || per_cu < 1) fprintf(stderr, "kernel_launch: occupancy query reports %d\n", per_cu);
        (void)hipGetLastError();
        grid = cus;
    }
    if (grid < 0) return;
    if (hipMemsetAsync((char*)d_ws + WS_CTL, 0, CTL_ZERO_BYTES, stream) != hipSuccess) return;
    Args a{};
    for (int i = 0; i < 23; ++i) a.in[i] = (const float*)d_in[i];
    a.out = (float*)d_out; a.ws = (unsigned char*)d_ws;
    hipLaunchKernelGGL(hymba_fwd, dim3(grid), dim3(NTHR), LDS_BYTES, stream, a);
}
```

```cpp
#include <hip/hip_runtime.h>
#include <cstdio>
#include <cstdint>

#define GAS __attribute__((address_space(1)))
#define LAS __attribute__((address_space(3)))
typedef unsigned short bf16;
typedef unsigned v4u __attribute__((ext_vector_type(4)));
typedef unsigned v2u __attribute__((ext_vector_type(2)));
typedef float f32x4 __attribute__((ext_vector_type(4)));
typedef short bf16x8 __attribute__((ext_vector_type(8)));
#define RLX_AGENT __ATOMIC_RELAXED, __HIP_MEMORY_SCOPE_AGENT
#define LDS_WAIT() asm volatile("s_waitcnt lgkmcnt(0)" ::: "memory")
#define VM_WAIT() asm volatile("s_waitcnt vmcnt(0)" ::: "memory")

constexpr int NWAVES = 8, NTHR = 512;
constexpr int NB = 16, SEQ = 4096, T = NB * SEQ, D = 1024, INC = 3080;
constexpr int NE = 32, DFF = 1024;
constexpr float EPS = 1e-5f, LOG2E = 1.4426950408889634f, C2 = 0.125f * LOG2E;
constexpr float LAM_INIT = 0.2f;
constexpr int NR_MAX = 270336;

constexpr size_t MiB = 1u << 20;
constexpr size_t WS_CTL = 0, CTL_ZERO_BYTES = 1 * MiB;
constexpr size_t WS_GATES = 1 * MiB;
constexpr size_t WS_RSTD2 = 3 * MiB;
constexpr size_t WS_HIST = 3 * MiB + 512 * 1024;
constexpr size_t WS_TOKINFO = 4 * MiB;
constexpr size_t WS_GATE = 5 * MiB;
constexpr size_t WS_LIST = 6 * MiB;
constexpr size_t WS_WDOWN = 16 * MiB;
constexpr size_t WS_X1B = 80 * MiB;
constexpr size_t WS_ACT = 208 * MiB;
constexpr size_t WS_YK = 480 * MiB;
constexpr size_t WS_WGU = 480 * MiB;
constexpr size_t WS_X1F8 = 744 * MiB;
constexpr size_t WS_WIN = 608 * MiB;
constexpr size_t WS_WOUT = 614 * MiB;
constexpr size_t WS_XN = 616 * MiB;
constexpr size_t WS_LISTRS = 1008 * MiB;
constexpr size_t WS_END = 1024 * MiB;
__host__ __device__ constexpr size_t proj_off(int buf) { return buf < 2 ? (208 + 64 * (size_t)buf) * MiB : (744 + 64 * (size_t)(buf - 2)) * MiB; }
constexpr size_t DO_OTMP = 128 * MiB;

constexpr int CW_TMO = 0;
constexpr int CW_BAR = 4096;
constexpr int CW_Q = 12288;
constexpr int CW_CNT = 8192;

constexpr int RING_BYTES = 131072;
constexpr int LDSCTL_OFF = RING_BYTES;
constexpr int L_HIST = LDSCTL_OFF, L_BASE = LDSCTL_OFF + 128, MISC_OFF = LDSCTL_OFF + 320, L_ETAB = LDSCTL_OFF + 512;
constexpr int LDS_BYTES = 147456;

__device__ __forceinline__ unsigned f2bf(float f) { unsigned u = __builtin_bit_cast(unsigned, f); return (u + 0x7fffu + ((u >> 16) & 1u)) >> 16; }
__device__ __forceinline__ unsigned pk2(float lo, float hi) { return f2bf(lo) | (f2bf(hi) << 16); }
typedef float f32x2_t __attribute__((ext_vector_type(2))); typedef __bf16 bf16x2_t __attribute__((ext_vector_type(2)));
__device__ __forceinline__ unsigned pkh(float lo, float hi) { f32x2_t v = {lo, hi}; bf16x2_t b = __builtin_convertvector(v, bf16x2_t); return __builtin_bit_cast(unsigned, b); }
__device__ __forceinline__ unsigned pk4_fp8(float a, float b, float c, float d) { int r = __builtin_amdgcn_cvt_pk_fp8_f32(a, b, 0, false); r = __builtin_amdgcn_cvt_pk_fp8_f32(c, d, r, true); return (unsigned)r; }
__device__ __forceinline__ float bflo(unsigned u) { return __uint_as_float(u << 16); }
__device__ __forceinline__ float bfhi(unsigned u) { return __uint_as_float(u & 0xffff0000u); }
__device__ __forceinline__ float bf2f(bf16 b) { return __uint_as_float((unsigned)b << 16); }
__device__ __forceinline__ float wave_sum(float v) {
#pragma unroll
    for (int o = 1; o < 64; o <<= 1) v += __shfl_xor(v, o);
    return v;
}
__device__ __forceinline__ float sigmoidf_(float x) { return 1.f / (1.f + __expf(-x)); }

#define XB_TMO      128
#define XB_XCNT(j)  (256  + 64 * (j))
#define XB_XSUB(j)  (1280 + 64 * (j))
#define XB_XGEN(j)  (2304 + 64 * (j))
#define XB_TOP      3328
#define XB_TOPGEN   3392
#define XCD_BAR_WORDS 3456
#define XB_SPIN_CAP (1u << 18)
__device__ __forceinline__ unsigned xb_ld(unsigned* p)              { return __hip_atomic_load(p, __ATOMIC_RELAXED, __HIP_MEMORY_SCOPE_AGENT); }
__device__ __forceinline__ unsigned xb_add(unsigned* p, unsigned v) { return __hip_atomic_fetch_add(p, v, __ATOMIC_RELAXED, __HIP_MEMORY_SCOPE_AGENT); }
__device__ __forceinline__ unsigned xb_xcc_id() { return (unsigned)__builtin_amdgcn_s_getreg((3 << 11) | 20) & 0xFu; }
#define XB_SPIN(cond, bar) do { unsigned _sp = 0; while (cond) { __builtin_amdgcn_s_sleep(1); \
    if ((++_sp & 255u) == 0u) { if (xb_ld(&(bar)[XB_TMO])) break; if (_sp > XB_SPIN_CAP) { atomicAdd(&(bar)[XB_TMO], 1u); break; } } } } while (0)
struct XcdBarrier { unsigned* bar; unsigned x; volatile LAS unsigned* st; };
__device__ __forceinline__ XcdBarrier xcd_barrier_post(unsigned* bar, volatile LAS unsigned* st) {
    XcdBarrier b; b.bar = bar; b.x = xb_xcc_id(); b.st = st;
    if (threadIdx.x == 0) (void)xb_add(&bar[XB_XCNT(b.x)], 1u);
    return b;
}
__device__ __forceinline__ void xcd_barrier_complete(unsigned* bar, unsigned x, unsigned& nloc, unsigned& nx) {
    const unsigned G = gridDim.x * gridDim.y * gridDim.z;
    unsigned sum, cnt, mine, sp = 0u;
    for (;;) {
        sum = 0u; cnt = 0u; mine = 0u;
#pragma unroll
        for (unsigned j = 0; j < 16; ++j) { const unsigned c = xb_ld(&bar[XB_XCNT(j)]); sum += c; cnt += (c > 0u) ? 1u : 0u; mine = (j == x) ? c : mine; }
        if (sum == G) break;
        __builtin_amdgcn_s_sleep(1);
        if ((++sp & 255u) == 0u) { if (xb_ld(&bar[XB_TMO])) break; if (sp > XB_SPIN_CAP) { atomicAdd(&bar[XB_TMO], 1u); break; } }
    }
    nloc = mine > 0u ? mine : 1u; nx = cnt > 0u ? cnt : 1u;
}
__device__ __forceinline__ void xcd_barrier(const XcdBarrier& b) {
    asm volatile("s_waitcnt vmcnt(0)" ::: "memory");
    __syncthreads();
    if (threadIdx.x == 0) {
        unsigned* bar = b.bar;
        __builtin_amdgcn_s_waitcnt(0);
        unsigned nloc = b.st[0], nx = b.st[1];
        if (nloc == 0u) { xcd_barrier_complete(bar, b.x, nloc, nx); b.st[0] = nloc; b.st[1] = nx; }
        const unsigned old = xb_add(&bar[XB_XSUB(b.x)], 1u);
        const unsigned gen = old / nloc;
        if (old + 1u == (gen + 1u) * nloc) {
            __builtin_amdgcn_fence(__ATOMIC_RELEASE, "agent");
            asm volatile("s_waitcnt vmcnt(0)" ::: "memory");
            const unsigned og = xb_add(&bar[XB_TOP], 1u);
            const unsigned tg = og / nx;
            if (og + 1u == (tg + 1u) * nx) xb_add(&bar[XB_TOPGEN], 1u);
            else XB_SPIN(xb_ld(&bar[XB_TOPGEN]) == tg, bar);
            __builtin_amdgcn_fence(__ATOMIC_ACQUIRE, "agent");
            xb_add(&bar[XB_XGEN(b.x)], 1u);
            asm volatile("s_waitcnt vmcnt(0)" ::: "memory");
        } else {
            XB_SPIN(xb_ld(&bar[XB_XGEN(b.x)]) == gen, bar);
            __builtin_amdgcn_fence(__ATOMIC_ACQUIRE, "agent");
            asm volatile("s_waitcnt vmcnt(0)" ::: "memory");
        }
    }
    __syncthreads();
}

struct Args { const float* in[23]; float* out; unsigned char* ws; };
struct Frame {
    LAS unsigned char* lds;
    unsigned* ctl;
    int tid, lane, wave, G, vcu;
    const float* in[23];
    unsigned char* ws; unsigned char* dout;
};
enum { I_X = 0, I_G1, I_WIN, I_REL, I_LQ1, I_LK1, I_LQ2, I_LK2, I_DNG, I_CONVW, I_CONVB, I_GATEB, I_OB, I_MLG, I_WOUT, I_G2, I_RW, I_RB, I_WGU, I_BGU, I_WDN, I_BDN, I_GF };

__device__ __forceinline__ bf16* proj_buf(const Frame& F, int b) { return (bf16*)(F.ws + proj_off(b)); }

__device__ __forceinline__ void tr_item(const float* W, int ldw, int k0, int n0, bf16* WT, int K, int r0, const float* gk, LAS float* scr, int lane) {
#pragma unroll 8
    for (int i = 0; i < 32; ++i) { const int kk = 2 * i + (lane >> 5); scr[kk * 33 + (lane & 31)] = W[(size_t)(k0 + kk) * ldw + n0 + (lane & 31)]; }
    LDS_WAIT(); asm volatile("" ::: "memory");
    const int c = lane & 7;
    float gv[8];
#pragma unroll
    for (int i = 0; i < 8; ++i) gv[i] = gk ? gk[k0 + 8 * c + i] : 1.f;
#pragma unroll
    for (int j = 0; j < 4; ++j) { const int n = (lane >> 3) + 8 * j; const LAS float* s = scr + (8 * c) * 33 + n;
        v4u o; o.x = pk2(s[0 * 33] * gv[0], s[1 * 33] * gv[1]); o.y = pk2(s[2 * 33] * gv[2], s[3 * 33] * gv[3]); o.z = pk2(s[4 * 33] * gv[4], s[5 * 33] * gv[5]); o.w = pk2(s[6 * 33] * gv[6], s[7 * 33] * gv[7]);
        *(v4u*)(WT + (size_t)(r0 + n) * K + k0 + 8 * c) = o; }
    LDS_WAIT(); asm volatile("" ::: "memory");
}

__device__ __forceinline__ void tr_item8(const float* W, int ldw, int k0, int n0, unsigned char* WT, int K, int r0, const float* gk, float wscale, LAS float* scr, int lane) {
#pragma unroll 8
    for (int i = 0; i < 32; ++i) { const int kk = 2 * i + (lane >> 5); scr[kk * 33 + (lane & 31)] = W[(size_t)(k0 + kk) * ldw + n0 + (lane & 31)]; }
    LDS_WAIT(); asm volatile("" ::: "memory");
    const int c = lane & 7;
    float gv[8];
#pragma unroll
    for (int i = 0; i < 8; ++i) gv[i] = (gk ? gk[k0 + 8 * c + i] : 1.f) * wscale;
#pragma unroll
    for (int j = 0; j < 4; ++j) { const int n = (lane >> 3) + 8 * j; const LAS float* sp = scr + (8 * c) * 33 + n;
        v2u o; o.x = pk4_fp8(sp[0 * 33] * gv[0], sp[1 * 33] * gv[1], sp[2 * 33] * gv[2], sp[3 * 33] * gv[3]); o.y = pk4_fp8(sp[4 * 33] * gv[4], sp[5 * 33] * gv[5], sp[6 * 33] * gv[6], sp[7 * 33] * gv[7]);
        *(v2u*)(WT + (size_t)(r0 + n) * K + k0 + 8 * c) = o; }
    LDS_WAIT(); asm volatile("" ::: "memory");
}

__device__ __forceinline__ float log_sigmoid(float x) { return fminf(x, 0.f) - log1pf(__expf(-fabsf(x))); }

__device__ __forceinline__ void p0_prologue(Frame& F_) {
    Frame F = F_; { int t_ = F.tid; asm volatile("" : "+v"(t_)); F.tid = t_; F.lane = t_ & 63; }
    LAS float* scr = (LAS float*)(F.lds + F.wave * 8704);
    const int gw = F.vcu * NWAVES + F.wave, NGW = F.G * NWAVES;
    constexpr int I_IN = 16 * 96, I_OUT = 16 * 32;
    constexpr int NITEMS = I_IN + I_OUT;
    for (int it = gw; it < NITEMS; it += NGW) {
        int r = it;
        if (r < I_IN) { const int kb = r / 96, nb = r % 96; tr_item(F.in[I_WIN], INC, 64 * kb, 32 * nb, (bf16*)(F.ws + WS_WIN), D, 32 * nb, nullptr, scr, F.lane); continue; } r -= I_IN;
        { const int kb = r / 32, nb = r % 32; tr_item(F.in[I_WOUT], D, 64 * kb, 32 * nb, (bf16*)(F.ws + WS_WOUT), D, 32 * nb, nullptr, scr, F.lane); }
    }
    __syncthreads();
    LAS float* wg = (LAS float*)F.lds;
    for (int i = F.tid; i < D * 8; i += NTHR) wg[(i & 7) * D + (i >> 3)] = F.in[I_WIN][(size_t)(i >> 3) * INC + 3072 + (i & 7)];
    __syncthreads();
    const float* x = F.in[I_X]; const float* g1 = F.in[I_G1]; const float* gb = F.in[I_GATEB];
    bf16* XN = (bf16*)(F.ws + WS_XN); float* GT = (float*)(F.ws + WS_GATES);
    f32x4 gn[4];
#pragma unroll
    for (int j = 0; j < 4; ++j) gn[j] = *((const f32x4*)g1 + F.lane + 64 * j);
    constexpr int RPS = 4;
    for (int m0 = gw; m0 < T; m0 += RPS * NGW) {
        f32x4 v[RPS][4]; float s[RPS];
#pragma unroll
        for (int r = 0; r < RPS; ++r) { const int mm = m0 + r * NGW; const int m = mm < T ? mm : m0; const f32x4* xr = (const f32x4*)(x + (size_t)m * D) + F.lane;
#pragma unroll
            for (int j = 0; j < 4; ++j) v[r][j] = xr[64 * j]; }
#pragma unroll
        for (int r = 0; r < RPS; ++r) { s[r] = 0.f;
#pragma unroll
            for (int j = 0; j < 4; ++j) s[r] += (v[r][j].x * v[r][j].x + v[r][j].y * v[r][j].y) + (v[r][j].z * v[r][j].z + v[r][j].w * v[r][j].w); }
#pragma unroll
        for (int r = 0; r < RPS; ++r) s[r] = wave_sum(s[r]);
#pragma unroll
        for (int r = 0; r < RPS; ++r) { const int m = m0 + r * NGW; if (m >= T) break;
            const float rstd = rsqrtf(s[r] * (1.f / D) + EPS);
            float ga[8];
#pragma unroll
            for (int i = 0; i < 8; ++i) ga[i] = 0.f;
            unsigned long long* o8 = (unsigned long long*)(XN + (size_t)m * D) + F.lane;
#pragma unroll
            for (int j = 0; j < 4; ++j) {
                const f32x4 h = v[r][j] * rstd * gn[j];
                o8[64 * j] = (unsigned long long)pkh(h.x, h.y) | ((unsigned long long)pkh(h.z, h.w) << 32);
#pragma unroll
                for (int gi = 0; gi < 8; ++gi) { const f32x4 w = *(const LAS f32x4*)(wg + gi * D + 256 * j + 4 * F.lane); ga[gi] += (h.x * w.x + h.y * w.y) + (h.z * w.z + h.w * w.w); }
            }
#pragma unroll
            for (int i = 0; i < 4; ++i) { const bool up = (F.lane & 32) != 0; const float send = up ? ga[i] : ga[4 + i], keep = up ? ga[4 + i] : ga[i]; ga[i] = keep + __shfl_xor(send, 32); }
#pragma unroll
            for (int i = 0; i < 2; ++i) { const bool up = (F.lane & 16) != 0; const float send = up ? ga[i] : ga[2 + i], keep = up ? ga[2 + i] : ga[i]; ga[i] = keep + __shfl_xor(send, 16); }
            { const bool up = (F.lane & 8) != 0; const float send = up ? ga[0] : ga[1], keep = up ? ga[1] : ga[0]; ga[0] = keep + __shfl_xor(send, 8); }
            ga[0] += __shfl_xor(ga[0], 4); ga[0] += __shfl_xor(ga[0], 2); ga[0] += __shfl_xor(ga[0], 1);
            { const int gi = (F.lane >> 3) & 7; const float vv = ga[0] + gb[gi];
              if ((F.lane & 7) == 0) GT[(size_t)m * 8 + gi] = gi < 4 ? vv : log_sigmoid(vv); }
        }
    }
}


namespace pg8 {
#define PG8_LAS __attribute__((address_space(3)))
constexpr int BM = 256, BK = 64, HALF = 128, HTB = HALF * BK * 2, STAGE_BYTES = 8 * HTB, NXCD = 8, WGM = 8;
__host__ __device__ __forceinline__ int lds_byte(int r, int c) { const int st = (r >> 4) * 2 + (c >> 5), rr = r & 15, cc = c & 31, ob = rr * 64 + cc * 2; return st * 1024 + (ob ^ (((ob >> 9) & 1) << 5)); }
__host__ __device__ __forceinline__ void stage_rc(int b, int& R, int& C) { const int st = b / 1024, sb = b % 1024, swz = sb ^ (((sb >> 9) & 1) << 5); R = (st >> 1) * 16 + swz / 64; C = (st & 1) * 32 + (swz % 64) / 2; }
__host__ __device__ __forceinline__ int perm32(int rho) { const int n = rho >> 4, i = rho & 15; return 8 * (i >> 2) + 4 * n + (i & 3); }
struct Unit { int pm, pn, e; };
struct TileOrder {
    int nM, nN, nwg, G, c;
    __device__ void init(int nM_, int nN_, int G_, int c_) { nM = nM_; nN = nN_; nwg = nM * nN; G = G_; c = c_; }
    __device__ bool next_tile(int i, int& pm, int& pn) const {
        const long L = (long)i * G + c; if (L >= nwg) return false;
        int wgid = (int)L; { const int q = nwg / NXCD, r = nwg % NXCD, xcd = wgid % NXCD, off = wgid / NXCD; wgid = (xcd < r ? xcd * (q + 1) : r * (q + 1) + (xcd - r) * q) + off; }
        const int nig = WGM * nN, gid = wgid / nig, fm = gid * WGM, gsz = (nM - fm) < WGM ? (nM - fm) : WGM;
        pm = fm + ((wgid % nig) % gsz); pn = (wgid % nig) / gsz; return true;
    }
};
__device__ __forceinline__ unsigned cvt_pk_bf16(float lo, float hi) { unsigned r; asm volatile("v_cvt_pk_bf16_f32 %0, %1, %2" : "=v"(r) : "v"(lo), "v"(hi)); return r; }

typedef int v8i_t __attribute__((ext_vector_type(8))); typedef int v4i_t __attribute__((ext_vector_type(4)));
template <class Epi, class Sched, bool ALIGN_EPI, bool SP2, bool F8 = false, int SCA = 0x7f7f7f7f, int SCB = 0x7f7f7f7f>
__device__ __forceinline__ void gemm_phase(PG8_LAS unsigned char* lds, const int nt, const int pitchB, const Sched& S, const Epi& E) {
    static_assert(SP2, "only the SP2 loop is carried here");
    int tid = threadIdx.x; asm volatile("" : "+v"(tid));
    const int wid = __builtin_amdgcn_readfirstlane(tid >> 6), lane = tid & 63, wr = wid >> 2, wc = wid & 3, fr = lane & 15, fq = lane >> 4;
    int RA[2], CA[2]; unsigned voffB[2];
#pragma unroll
    for (int i = 0; i < 2; ++i) { int R, C; stage_rc(tid * 16 + i * 8192, R, C); RA[i] = R; CA[i] = C; const int Rb = (R & ~31) + perm32(R & 31); voffB[i] = (unsigned)(Rb * pitchB + C * 2); }
    const size_t kstep = (size_t)(BK * 2);
    const size_t hstep = (size_t)HALF * pitchB;
    const unsigned ldsw = (unsigned)wid * 1024u;
    const int aoff = lds_byte(wr * 64 + fr, fq * 8), boff = lds_byte(wc * 32 + fr, fq * 8);
#define PG8_SA(b, h) (((b) * 2 + (h)) * HTB)
#define PG8_SB(b, h) ((4 + (b) * 2 + (h)) * HTB)
#define PG8_STAGE(bufoff, gbase, voff) do { _Pragma("unroll") for (int _i = 0; _i < 2; ++_i) \
        __builtin_amdgcn_global_load_lds((const unsigned*)((const char*)(gbase) + (voff)[_i]), (PG8_LAS unsigned*)(lds + (bufoff) + ldsw + _i * 8192), 16, 0, 0); } while (0)
#define PG8_LDA(dst, b, h) do { if constexpr (F8) { _Pragma("unroll") for (int m = 0; m < 4; ++m) { dst##8[m].lo = *(const PG8_LAS v4i_t*)(lds + PG8_SA(b, h) + aoff + m * 2048); dst##8[m].hi = *(const PG8_LAS v4i_t*)(lds + PG8_SA(b, h) + aoff + m * 2048 + 1024); } } \
        else { _Pragma("unroll") for (int m = 0; m < 4; ++m) _Pragma("unroll") for (int k = 0; k < 2; ++k) dst[m][k] = *(const PG8_LAS bf16x8*)(lds + PG8_SA(b, h) + aoff + m * 2048 + k * 1024); } } while (0)
#define PG8_LDB(dst, b, h) do { if constexpr (F8) { _Pragma("unroll") for (int n = 0; n < 2; ++n) { dst##8[n].lo = *(const PG8_LAS v4i_t*)(lds + PG8_SB(b, h) + boff + n * 2048); dst##8[n].hi = *(const PG8_LAS v4i_t*)(lds + PG8_SB(b, h) + boff + n * 2048 + 1024); } } \
        else { _Pragma("unroll") for (int n = 0; n < 2; ++n) _Pragma("unroll") for (int k = 0; k < 2; ++k) dst[n][k] = *(const PG8_LAS bf16x8*)(lds + PG8_SB(b, h) + boff + n * 2048 + k * 1024); } } while (0)
#define PG8_MMA(ai, bj, At, Bt) do { __builtin_amdgcn_s_setprio(1); _Pragma("unroll") for (int m = 0; m < 4; ++m) _Pragma("unroll") for (int n = 0; n < 2; ++n) { \
        if constexpr (F8) asm volatile("v_mfma_scale_f32_16x16x128_f8f6f4 %0, %1, %2, %0, %3, %4 op_sel_hi:[0,0,0]" : "+v"(acc[ai][bj][m][n]) : "v"(Bt##8[n]), "v"(At##8[m]), "v"(sca_), "v"(scb_));   \
        else { _Pragma("unroll") for (int k = 0; k < 2; ++k) acc[ai][bj][m][n] = __builtin_amdgcn_mfma_f32_16x16x32_bf16(Bt[n][k], At[m][k], acc[ai][bj][m][n], 0, 0, 0); } } \
        __builtin_amdgcn_s_setprio(0); } while (0)
#define PG8_WAIT_V(n) asm volatile("s_waitcnt vmcnt(" #n ")" ::: "memory")
#define PG8_WAIT_L(n) asm volatile("s_waitcnt lgkmcnt(" #n ")" ::: "memory")
#define PG8_BAR __builtin_amdgcn_s_barrier()
#define PG8_SCHED __builtin_amdgcn_sched_barrier(0)
    Unit cur, nxt; int ui = 0;
    if (!S.next(0, cur)) return;
    f32x4 acc[2][2][4][2];
#pragma unroll
    for (int a = 0; a < 2; ++a)
#pragma unroll
        for (int b = 0; b < 2; ++b)
#pragma unroll
            for (int m = 0; m < 4; ++m)
#pragma unroll
                for (int n = 0; n < 2; ++n) acc[a][b][m][n] = (f32x4){0.f, 0.f, 0.f, 0.f};
    const int sca_ = SCA, scb_ = SCB;
    bf16x8 At[4][2], B0[2][2], B1[2][2];
    v8i_t At8[4], B08[2], B18[2];
    const char* cA; unsigned cAo[2][2]; S.a_view(cur, RA, CA, cA, cAo);
    const char* cB = S.b_base(cur);
    PG8_STAGE(PG8_SB(0, 0), cB, voffB); PG8_STAGE(PG8_SB(0, 1), cB + hstep, voffB); PG8_STAGE(PG8_SA(0, 0), cA, cAo[0]); PG8_STAGE(PG8_SA(0, 1), cA, cAo[1]);
    if (wr == 1) PG8_BAR;
    PG8_WAIT_V(2); PG8_BAR;
    PG8_STAGE(PG8_SB(1, 0), cB + kstep, voffB); PG8_STAGE(PG8_SA(1, 0), cA + kstep, cAo[0]); PG8_STAGE(PG8_SB(1, 1), cB + hstep + kstep, voffB);
    PG8_WAIT_V(6); PG8_BAR;
    for (;;) {
        const bool has_next = S.next(ui + 1, nxt);
        const char* nA = cA; const char* nB = cB; unsigned nAo[2][2];
#pragma unroll
        for (int h = 0; h < 2; ++h)
#pragma unroll
            for (int i = 0; i < 2; ++i) nAo[h][i] = cAo[h][i];
        unsigned pre[2][2] = {{0u, 0u}, {0u, 0u}};
        if (has_next) { S.a_pre(nxt, RA, pre); nB = S.b_base(nxt); }
        for (int t = 0; t < nt; t += 2) {
            const bool last = (t == nt - 2);
            if (last && has_next) S.a_post(nxt, pre, RA, CA, nA, nAo);
            const char* a1 = cA + (size_t)(t + 1) * kstep;
            const char* a2 = last ? nA : cA + (size_t)(t + 2) * kstep; const char* b2 = last ? nB : cB + (size_t)(t + 2) * kstep;
            const char* a3 = a2 + kstep; const char* b3 = b2 + kstep;
            unsigned o2[2][2];
#pragma unroll
            for (int h = 0; h < 2; ++h)
#pragma unroll
                for (int i = 0; i < 2; ++i) o2[h][i] = last ? nAo[h][i] : cAo[h][i];
            PG8_LDB(B0, 0, 0); PG8_LDB(B1, 0, 1); PG8_SCHED; PG8_LDA(At, 0, 0); PG8_STAGE(PG8_SA(1, 1), a1, cAo[1]);
            PG8_WAIT_V(8); PG8_WAIT_L(0); PG8_BAR; PG8_MMA(0, 0, At, B0); PG8_MMA(0, 1, At, B1); PG8_BAR; PG8_SCHED;
            PG8_LDA(At, 0, 1); PG8_STAGE(PG8_SB(0, 0), b2, voffB); PG8_STAGE(PG8_SB(0, 1), b2 + hstep, voffB); PG8_STAGE(PG8_SA(0, 0), a2, o2[0]);
            PG8_WAIT_V(8); PG8_WAIT_L(0); PG8_BAR; PG8_MMA(1, 0, At, B0); PG8_MMA(1, 1, At, B1); PG8_BAR; PG8_SCHED;
            PG8_LDB(B0, 1, 0); PG8_LDB(B1, 1, 1); PG8_SCHED; PG8_LDA(At, 1, 0); PG8_STAGE(PG8_SA(0, 1), a2, o2[1]);
            PG8_WAIT_V(8); PG8_WAIT_L(0); PG8_BAR; PG8_MMA(0, 0, At, B0); PG8_MMA(0, 1, At, B1); PG8_BAR; PG8_SCHED;
            PG8_LDA(At, 1, 1); PG8_STAGE(PG8_SB(1, 0), b3, voffB); PG8_STAGE(PG8_SB(1, 1), b3 + hstep, voffB); PG8_STAGE(PG8_SA(1, 0), a3, o2[0]);
            PG8_WAIT_V(8); PG8_WAIT_L(0); PG8_BAR; PG8_MMA(1, 0, At, B0); PG8_MMA(1, 1, At, B1); PG8_BAR; PG8_SCHED;
        }
        if constexpr (ALIGN_EPI) { if (wr == 0) PG8_BAR; }
        if constexpr (F8) asm volatile("s_nop 15\n\ts_nop 7" ::: "memory");
        E(acc, cur, wr, wc, fr, fq);
        if (!has_next) break;
#pragma unroll
        for (int a = 0; a < 2; ++a)
#pragma unroll
            for (int b = 0; b < 2; ++b)
#pragma unroll
                for (int m = 0; m < 4; ++m)
#pragma unroll
                    for (int n = 0; n < 2; ++n) acc[a][b][m][n] = (f32x4){0.f, 0.f, 0.f, 0.f};
        cur = nxt; cA = nA; cB = nB; ++ui;
#pragma unroll
        for (int h = 0; h < 2; ++h)
#pragma unroll
            for (int i = 0; i < 2; ++i) cAo[h][i] = nAo[h][i];
        if constexpr (ALIGN_EPI) { if (wr == 1) PG8_BAR; }
    }
    PG8_WAIT_V(0);
    if constexpr (!ALIGN_EPI) { if (wr == 0) PG8_BAR; }
    PG8_BAR;
#undef PG8_SA
#undef PG8_SB
#undef PG8_STAGE
#undef PG8_LDA
#undef PG8_LDB
#undef PG8_MMA
#undef PG8_WAIT_V
#undef PG8_WAIT_L
#undef PG8_BAR
#undef PG8_SCHED
}
}

__device__ const unsigned char T5_BUCKET[128] = {0, 1, 2, 3, 4, 5, 6, 7, 8, 9, 10, 11, 12, 13, 14, 15, 16, 16, 16, 17, 17, 18, 18, 18, 19, 19, 19, 20, 20, 20, 20, 21, 21, 21, 21, 22, 22, 22, 22, 22, 23, 23, 23, 23, 23, 23, 24, 24, 24, 24, 24, 24, 25, 25, 25, 25, 25, 25, 25, 26, 26, 26, 26, 26, 26, 26, 26, 27, 27, 27, 27, 27, 27, 27, 27, 27, 27, 28, 28, 28, 28, 28, 28, 28, 28, 28, 28, 29, 29, 29, 29, 29, 29, 29, 29, 29, 29, 29, 29, 30, 30, 30, 30, 30, 30, 30, 30, 30, 30, 30, 30, 30, 30, 31, 31, 31, 31, 31, 31, 31, 31, 31, 31, 31, 31, 31, 31, 31};

__device__ __forceinline__ float compute_lambda(const Frame& F) {
    float s1 = 0.f, s2 = 0.f;
    for (int i = 0; i < 64; ++i) { s1 += F.in[I_LQ1][i] * F.in[I_LK1][i]; s2 += F.in[I_LQ2][i] * F.in[I_LK2][i]; }
    return __expf(s1) - __expf(s2) + LAM_INIT;
}

namespace attn_body {
using bf16=unsigned short;
using bf16x8=__attribute__((ext_vector_type(8)))short;
using s16x4=__attribute__((ext_vector_type(4)))short;
using f32x16=__attribute__((ext_vector_type(16)))float;
using u32x4=__attribute__((ext_vector_type(4)))unsigned;
constexpr int SEQ=4096,D=64,DM=512,OP=1024;
constexpr int NW=8,QBLK=32,QB=QBLK*NW,KVBLK=64,NQB=SEQ/QB;
__device__ __forceinline__ int crow(int r,int hi){return (r&3)+8*(r>>2)+4*hi;}
#define SBAR() __builtin_amdgcn_sched_barrier(0)
__device__ __forceinline__ void cmask(f32x16&p0,f32x16&p1,int jb,int qrel,int hi){
  const float NEG=-INFINITY; int kb=64*jb+4*hi;
  #pragma unroll
  for(int r=0;r<16;++r){int kv=kb+(r&3)+8*(r>>2); if(kv>qrel)p0[r]=NEG; if(kv+32>qrel)p1[r]=NEG;}
}

typedef __attribute__((address_space(3))) const float* lds_cfptr;
__device__ __forceinline__ void bcorr(f32x16&p0,f32x16&p1,int jb,int qrel,int hi,lds_cfptr dtab){
  lds_cfptr tp=dtab+(qrel+256-64*jb-4*hi-59);
  #pragma unroll
  for(int r=0;r<16;++r){const int c=(r&3)+8*(r>>2); p0[r]+=tp[59-c]; p1[r]+=tp[27-c];}
}
constexpr int NSLOT=3, SLOTB=8192;
constexpr int LDS_K=0, LDS_V=NSLOT*SLOTB, LDS_WS=2*NSLOT*SLOTB, LDS_OST=LDS_WS+NW*64*4, LDS_BYTES=LDS_OST+NW*4096;
__device__ __forceinline__ void glds16(const void*gsrc,unsigned lds_dst){unsigned keep;
  asm volatile("s_mov_b32 %0, m0\n\ts_mov_b32 m0, %2\n\ts_nop 0\n\tglobal_load_lds_dwordx4 %1, off\n\ts_mov_b32 m0, %0":"=&s"(keep):"v"(gsrc),"s"(lds_dst):"memory");}
__device__ __forceinline__ float max3f(float a,float b,float c){float r;asm("v_max3_f32 %0, %1, %2, %3":"=v"(r):"v"(a),"v"(b),"v"(c));return r;}
__device__ __forceinline__ float max2f(float a,float b){float r;asm("v_max_f32_e32 %0, %1, %2":"=v"(r):"v"(a),"v"(b));return r;}
__device__ __forceinline__ float fadd_s(float a,float b){float r;asm("v_add_f32_e32 %0, %1, %2":"=v"(r):"v"(a),"v"(b));return r;}
__device__ __forceinline__ float fsub_s(float a,float b){float r;asm("v_sub_f32_e32 %0, %1, %2":"=v"(r):"v"(a),"v"(b));return r;}
typedef float f32x2_t __attribute__((ext_vector_type(2))); typedef __bf16 bf16x2_t __attribute__((ext_vector_type(2)));
__device__ __forceinline__ unsigned cvtpk_s(float lo,float hi){f32x2_t v={lo,hi};bf16x2_t b=__builtin_convertvector(v,bf16x2_t);return __builtin_bit_cast(unsigned,b);}
#define WAIT_BAR(N) asm volatile("s_waitcnt vmcnt(" #N ") lgkmcnt(0)\n\ts_barrier":::"memory")

__device__ __forceinline__ void qkt(f32x16&p0,f32x16&p1,const char*Kslot,const bf16x8*qr,const f32x16&negm,int r32,int hi){
  const char*kb=Kslot+hi*1024+r32*16;
  #pragma unroll
  for(int d0=0;d0<4;++d0){
    const bf16x8 b0=*reinterpret_cast<const bf16x8*>(kb+d0*2048);
    const bf16x8 b1=*reinterpret_cast<const bf16x8*>(kb+d0*2048+512);
    if(d0==0){p0=__builtin_amdgcn_mfma_f32_32x32x16_bf16(b0,qr[0],negm,0,0,0);p1=__builtin_amdgcn_mfma_f32_32x32x16_bf16(b1,qr[0],negm,0,0,0);}
    else{p0=__builtin_amdgcn_mfma_f32_32x32x16_bf16(b0,qr[d0],p0,0,0,0);p1=__builtin_amdgcn_mfma_f32_32x32x16_bf16(b1,qr[d0],p1,0,0,0);}}
}
typedef __attribute__((address_space(3))) const char* lds_cptr;
typedef short v4i16_t __attribute__((ext_vector_type(4)));
__device__ __forceinline__ void kload8(bf16x8*kf,lds_cptr kp){
  kf[0]=*(const __attribute__((address_space(3))) bf16x8*)(kp);      kf[1]=*(const __attribute__((address_space(3))) bf16x8*)(kp+512);
  kf[2]=*(const __attribute__((address_space(3))) bf16x8*)(kp+2048); kf[3]=*(const __attribute__((address_space(3))) bf16x8*)(kp+2560);
  kf[4]=*(const __attribute__((address_space(3))) bf16x8*)(kp+4096); kf[5]=*(const __attribute__((address_space(3))) bf16x8*)(kp+4608);
  kf[6]=*(const __attribute__((address_space(3))) bf16x8*)(kp+6144); kf[7]=*(const __attribute__((address_space(3))) bf16x8*)(kp+6656);
}
__device__ __forceinline__ void kload2(bf16x8*kf,lds_cptr kp,int j){ kf[2*j]=*(const __attribute__((address_space(3))) bf16x8*)(kp+j*2048); kf[2*j+1]=*(const __attribute__((address_space(3))) bf16x8*)(kp+j*2048+512); }
__device__ __forceinline__ s16x4 vtr(lds_cptr p){ return __builtin_bit_cast(s16x4,__builtin_amdgcn_ds_read_tr16_b64_v4i16((__attribute__((address_space(3))) v4i16_t*)p)); }
__device__ __forceinline__ float rowmax(const f32x16&p0,const f32x16&p1){
  float a=max3f(p0[0],p0[1],p1[0]),b=max3f(p0[2],p0[3],p1[1]);a=max3f(a,p1[2],p1[3]);
  #pragma unroll
  for(int r=4;r<16;r+=4){a=max3f(a,p0[r],p0[r+1]);b=max3f(b,p0[r+2],p0[r+3]);a=max3f(a,p1[r],p1[r+1]);b=max3f(b,p1[r+2],p1[r+3]);}
  const float m=max2f(a,b);
  auto rr=__builtin_amdgcn_permlane32_swap(__float_as_uint(m),__float_as_uint(m),false,false);
  return max2f(__uint_as_float(rr[0]),__uint_as_float(rr[1]));
}
__device__ __forceinline__ void pv(f32x16*o,int vb,bf16x8 pa0,bf16x8 pa1,bf16x8 pa2,bf16x8 pa3){
  #pragma unroll
  for(int d0=0;d0<2;++d0){s16x4 lo[4],hi[4];
    #pragma unroll
    for(int ks=0;ks<4;++ks){
      asm volatile("ds_read_b64_tr_b16 %0,%1 offset:%c2":"=&v"(lo[ks]):"v"(vb),"i"(d0*4096+ks*1024):"memory");
      asm volatile("ds_read_b64_tr_b16 %0,%1 offset:%c2":"=&v"(hi[ks]):"v"(vb),"i"(d0*4096+ks*1024+512):"memory");}
    asm volatile("s_waitcnt lgkmcnt(0)":::"memory");SBAR();
    #define PK(k) (bf16x8){lo[k][0],lo[k][1],lo[k][2],lo[k][3],hi[k][0],hi[k][1],hi[k][2],hi[k][3]}
    o[d0]=__builtin_amdgcn_mfma_f32_32x32x16_bf16(pa0,PK(0),o[d0],0,0,0);
    o[d0]=__builtin_amdgcn_mfma_f32_32x32x16_bf16(pa1,PK(1),o[d0],0,0,0);
    o[d0]=__builtin_amdgcn_mfma_f32_32x32x16_bf16(pa2,PK(2),o[d0],0,0,0);
    o[d0]=__builtin_amdgcn_mfma_f32_32x32x16_bf16(pa3,PK(3),o[d0],0,0,0);
    #undef PK
  }
}

#ifndef ATTN_STORE16
#define ATTN_STORE16(p,v) (*(u32x4*)(p)=(v))
#endif
constexpr int L2_K=0, L2_V=3*8192, L2_WS=L2_V+4*16384, L2_OST=L2_V, L2_BYTES=L2_WS+NW*64*4;
__device__ __forceinline__ float rowmax_c(const f32x16&p0,const f32x16&p1){
  float a=__builtin_fmaxf(__builtin_fmaxf(p0[0],p0[1]),p1[0]),b=__builtin_fmaxf(__builtin_fmaxf(p0[2],p0[3]),p1[1]); a=__builtin_fmaxf(__builtin_fmaxf(a,p1[2]),p1[3]);
  #pragma unroll
  for(int r=4;r<16;r+=4){a=__builtin_fmaxf(__builtin_fmaxf(a,p0[r]),p0[r+1]);b=__builtin_fmaxf(__builtin_fmaxf(b,p0[r+2]),p0[r+3]);a=__builtin_fmaxf(__builtin_fmaxf(a,p1[r]),p1[r+1]);b=__builtin_fmaxf(__builtin_fmaxf(b,p1[r+2]),p1[r+3]);}
  float m=__builtin_fmaxf(a,b);
  auto rr=__builtin_amdgcn_permlane32_swap(__float_as_uint(m),__float_as_uint(m),false,false);
  return __builtin_fmaxf(__uint_as_float(rr[0]),__uint_as_float(rr[1]));
}
__device__ __forceinline__ void pv128(f32x16 (&o)[4],const bf16x8 (&pa)[4],lds_cptr vp_){
  s16x4 vl[2][4],vh_[2][4];
  #pragma unroll
  for(int ks=0;ks<4;++ks){vl[0][ks]=vtr(vp_+ks*1024);vh_[0][ks]=vtr(vp_+ks*1024+512);}
  #pragma unroll
  for(int d0=0;d0<4;++d0){
    if(d0<3){
      #pragma unroll
      for(int ks=0;ks<4;++ks){vl[(d0+1)&1][ks]=vtr(vp_+(d0+1)*4096+ks*1024);vh_[(d0+1)&1][ks]=vtr(vp_+(d0+1)*4096+ks*1024+512);} }
    #pragma unroll
    for(int ks=0;ks<4;++ks){ const s16x4 a_=vl[d0&1][ks],b_=vh_[d0&1][ks];
      o[d0]=__builtin_amdgcn_mfma_f32_32x32x16_bf16(pa[ks],(bf16x8){a_[0],a_[1],a_[2],a_[3],b_[0],b_[1],b_[2],b_[3]},o[d0],0,0,0); }
  }
}
template<int THRL,bool KEEP> __device__ __forceinline__ void attn_unit128(int b,int qb,const bf16*Q,const bf16*__restrict__ K,const bf16*__restrict__ V,bf16*O,char*shm,const float cfar,lds_cfptr dtab){
  int tid=threadIdx.x; asm volatile("":"+v"(tid));
  const int lane=tid&63,r32=lane&31,hi=lane>>5; const int wid=__builtin_amdgcn_readfirstlane(tid>>6);
  constexpr bool grpB=true;
  const long rowbase=(long)b*SEQ; const int q0=qb*QB;
  const bf16*Qw=Q+(rowbase+q0+wid*QBLK)*DM;
  const bf16*Kh=K+rowbase*DM,*Vh=V+rowbase*DM;
  const unsigned lds0=(unsigned)(uintptr_t)shm;
  float*wsf=(float*)(shm+L2_WS)+wid*64;
  const bf16*ksrc=Kh+(long)lane*DM+wid*8;
  const bf16*vsrc=Vh+(long)(16*(wid&3)+(lane>>2))*DM+(wid>>2)*32+(lane&3)*8;
  const unsigned kdst=lds0+L2_K+wid*1024, vdst=lds0+L2_V+wid*1024;
  #define DMA2_K(t,slot) glds16(ksrc+(long)(t)*KVBLK*DM,(unsigned)__builtin_amdgcn_readfirstlane(kdst+(slot)*8192))
  #define DMA2_V(t,slot) do{ glds16(vsrc+(long)(t)*KVBLK*DM,(unsigned)__builtin_amdgcn_readfirstlane(vdst+(slot)*16384)); glds16(vsrc+64+(long)(t)*KVBLK*DM,(unsigned)__builtin_amdgcn_readfirstlane(vdst+8192+(slot)*16384)); }while(0)
  const int NT=(q0+QB)/KVBLK;
  const int NTw=NT-3+(wid>>1);
  DMA2_K(0,0);DMA2_V(0,0);DMA2_K(1,1);DMA2_V(1,1);
  bf16x8 qr[4];
  #pragma unroll
  for(int d0=0;d0<4;++d0)qr[d0]=*reinterpret_cast<const bf16x8*>(&Qw[(long)r32*DM+d0*16+hi*8]);
  __builtin_amdgcn_s_waitcnt(0x0F70);
  float mhat=0.f,l_reg=0.f; f32x16 o[4];
  #pragma unroll
  for(int d=0;d<4;++d)o[d]=f32x16{};
  f32x16 negm;
  #pragma unroll
  for(int r=0;r<16;++r)negm[r]=cfar;
  const int qrel=wid*QBLK+r32;
  const lds_cptr shm3=(lds_cptr)shm; const lds_cptr vp0=shm3+L2_V+((lane>>4)&1)*32+(lane&3)*8+(4*hi+((lane&15)>>2))*64; const lds_cptr kp0=shm3+L2_K+hi*1024+r32*16;
  int kslot=0,vslot=0;
  bf16x8 pa[4];
  #pragma unroll
  for(int i=0;i<4;++i)pa[i]=bf16x8{};
  #define PIN8(A,B) asm volatile("":"+v"(A[0]),"+v"(A[1]),"+v"(A[2]),"+v"(A[3]),"+v"(B[0]),"+v"(B[1]),"+v"(B[2]),"+v"(B[3]))
  #define VLD(buf,blk) do{ _Pragma("unroll") for(int ks=0;ks<4;++ks){vl[buf][ks]=vtr(vp_+(blk)*4096+ks*1024);vh_[buf][ks]=vtr(vp_+(blk)*4096+ks*1024+512);} }while(0)
  #define VFRAG(buf,ks) (bf16x8){vl[buf][ks][0],vl[buf][ks][1],vl[buf][ks][2],vl[buf][ks][3],vh_[buf][ks][0],vh_[buf][ks][1],vh_[buf][ks][2],vh_[buf][ks][3]}
  #pragma unroll 1
  for(int t=0;t<NT;++t){
    if(t+1<NT){WAIT_BAR(3);}else{WAIT_BAR(0);}
    if(t+2<NT){int k2=kslot+2; if(k2>=3)k2-=3; const int v2=(vslot+2)&3; DMA2_K(t+2,k2); DMA2_V(t+2,v2);}
    if(t>=NTw){ kslot=(kslot==2)?0:kslot+1; vslot=(vslot+1)&3; continue; }
    f32x16 p0,p1;
    { bf16x8 kf[8]; kload8(kf,kp0+kslot*8192);
      asm volatile("":"+v"(kf[0]),"+v"(kf[1]),"+v"(kf[2]),"+v"(kf[3]),"+v"(kf[4]),"+v"(kf[5]),"+v"(kf[6]),"+v"(kf[7]));
      p0=__builtin_amdgcn_mfma_f32_32x32x16_bf16(kf[0],qr[0],negm,0,0,0); SBAR(); p1=__builtin_amdgcn_mfma_f32_32x32x16_bf16(kf[1],qr[0],negm,0,0,0); SBAR();
      p0=__builtin_amdgcn_mfma_f32_32x32x16_bf16(kf[2],qr[1],p0,0,0,0);   SBAR(); p1=__builtin_amdgcn_mfma_f32_32x32x16_bf16(kf[3],qr[1],p1,0,0,0);   SBAR();
      p0=__builtin_amdgcn_mfma_f32_32x32x16_bf16(kf[4],qr[2],p0,0,0,0);   SBAR(); p1=__builtin_amdgcn_mfma_f32_32x32x16_bf16(kf[5],qr[2],p1,0,0,0);   SBAR();
      p0=__builtin_amdgcn_mfma_f32_32x32x16_bf16(kf[6],qr[3],p0,0,0,0);   SBAR(); p1=__builtin_amdgcn_mfma_f32_32x32x16_bf16(kf[7],qr[3],p1,0,0,0);   SBAR(); }
    { const int jb_=t-(NT-4); if(jb_>=-3)bcorr(p0,p1,jb_,qrel,hi,dtab); if(jb_>=0)cmask(p0,p1,jb_,qrel,hi); }
    const float rm=rowmax_c(p0,p1);
    const bool resc=(t==0)||__any(rm>(float)THRL);
    if(resc){
      const float dl=(t==0)?rm:__builtin_fmaxf(rm,0.f); mhat+=dl;
      #pragma unroll
      for(int r=0;r<16;++r){p0[r]-=dl;p1[r]-=dl;negm[r]=cfar-mhat;}
      const float f=__builtin_amdgcn_exp2f(-dl); l_reg*=f; if(hi==0)wsf[r32]=f; }
    { const lds_cptr vp_=vp0+((t>0)?((vslot+3)&3):vslot)*16384;
      s16x4 vl[2][4],vh_[2][4]; f32x2_t sacc2={0.f,0.f}; unsigned q0w[8],q1w[8];
      #define GAPX(d0,ks,i) do{ o[d0]=__builtin_amdgcn_mfma_f32_32x32x16_bf16(pa[ks],VFRAG((d0)&1,ks),o[d0],0,0,0); \
          p0[i]=__builtin_amdgcn_exp2f(p0[i]); p1[i]=__builtin_amdgcn_exp2f(p1[i]); sacc2=sacc2+(f32x2_t){p0[i],p1[i]}; \
          if((i)&1){ q0w[(i)>>1]=cvtpk_s(p0[(i)-1],p0[i]); q1w[(i)>>1]=cvtpk_s(p1[(i)-1],p1[i]); asm volatile("":"+v"(q0w[(i)>>1]),"+v"(q1w[(i)>>1])); } \
          asm volatile("":"+v"(sacc2)); SBAR(); }while(0)
      VLD(0,0); VLD(1,1); PIN8(vl[0],vh_[0]); PIN8(vl[1],vh_[1]);
      GAPX(0,0,0); GAPX(1,0,1); GAPX(0,1,2); GAPX(1,1,3); GAPX(0,2,4); GAPX(1,2,5); GAPX(0,3,6); GAPX(1,3,7);
      VLD(0,2); VLD(1,3); PIN8(vl[0],vh_[0]); PIN8(vl[1],vh_[1]);
      GAPX(2,0,8); GAPX(3,0,9); GAPX(2,1,10); GAPX(3,1,11); GAPX(2,2,12); GAPX(3,2,13); GAPX(2,3,14); GAPX(3,3,15);
      #undef GAPX
      l_reg+=sacc2.x+sacc2.y;
      pa[0]=__builtin_bit_cast(bf16x8,(u32x4){q0w[0],q0w[1],q0w[2],q0w[3]}); pa[1]=__builtin_bit_cast(bf16x8,(u32x4){q0w[4],q0w[5],q0w[6],q0w[7]});
      pa[2]=__builtin_bit_cast(bf16x8,(u32x4){q1w[0],q1w[1],q1w[2],q1w[3]}); pa[3]=__builtin_bit_cast(bf16x8,(u32x4){q1w[4],q1w[5],q1w[6],q1w[7]}); }
    if(resc&&t>0){ asm volatile("s_waitcnt lgkmcnt(0)":::"memory");
      #pragma unroll
      for(int r=0;r<16;++r){const float fr_=wsf[crow(r,hi)]; o[0][r]*=fr_;o[1][r]*=fr_;o[2][r]*=fr_;o[3][r]*=fr_;} }
    kslot=(kslot==2)?0:kslot+1; vslot=(vslot+1)&3;
  }
  { const lds_cptr vp_=vp0+((NTw-1)&3)*16384; s16x4 vl[2][4],vh_[2][4];
    VLD(0,0);
    #pragma unroll
    for(int d0=0;d0<4;++d0){ if(d0<3)VLD((d0+1)&1,d0+1);
      #pragma unroll
      for(int ks=0;ks<4;++ks)o[d0]=__builtin_amdgcn_mfma_f32_32x32x16_bf16(pa[ks],VFRAG(d0&1,ks),o[d0],0,0,0);
      SBAR(); } }
  #undef PIN8
  #undef VLD
  #undef VFRAG
  asm volatile("s_waitcnt lgkmcnt(0)\n\ts_barrier":::"memory");
  {auto rr=__builtin_amdgcn_permlane32_swap(__float_as_uint(l_reg),__float_as_uint(l_reg),false,false);l_reg=__uint_as_float(rr[0])+__uint_as_float(rr[1]);}
  if(hi==0)wsf[32+r32]=l_reg;asm volatile("s_waitcnt lgkmcnt(0)":::"memory");
  float rli[16];
  #pragma unroll
  for(int r=0;r<16;++r)rli[r]=__builtin_amdgcn_rcpf(wsf[32+crow(r,hi)]);
  bf16*Ow=O+(rowbase+q0+wid*QBLK)*OP;
  if constexpr(KEEP){
    bf16*stg=(bf16*)(shm+L2_OST)+wid*4096;
    #pragma unroll
    for(int r=0;r<16;++r){const int orow=crow(r,hi);
      #pragma unroll
      for(int d0=0;d0<4;++d0)stg[orow*128+d0*32+r32]=(bf16)f2bf(o[d0][r]*rli[r]);}
  } else {
  bf16*stg=(bf16*)(shm+L2_OST)+wid*2048;
  #pragma unroll
  for(int hf=0;hf<2;++hf){
    #pragma unroll
    for(int r=0;r<16;++r){const int orow=crow(r,hi);
      #pragma unroll
      for(int d0=0;d0<2;++d0)stg[orow*64+d0*32+r32]=(bf16)f2bf(o[2*hf+d0][r]*rli[r]);}
    asm volatile("s_waitcnt lgkmcnt(0)":::"memory");
    #pragma unroll
    for(int i=0;i<4;++i){const int row=i*8+(lane>>3),ch=lane&7; const u32x4 v=*(const u32x4*)(stg+row*64+ch*8); ATTN_STORE16(Ow+(long)row*OP+hf*64+ch*8,v);}
    asm volatile("s_waitcnt lgkmcnt(0)":::"memory");
  }
  }
  asm volatile("s_waitcnt lgkmcnt(0)\n\ts_barrier":::"memory");
  #undef DMA2_K
  #undef DMA2_V
}
static_assert(L2_BYTES<=110592,"attention LDS map vs DTAB_OFF");
constexpr int ATTN_LDS_BYTES=LDS_BYTES;
#undef SBAR
#undef WAIT_BAR
}

constexpr int PREP_GU = NE * 8 * 64, PREP_DN = NE * 8 * 32, PREP_ITEMS = PREP_GU + PREP_DN, PREP_WAVES = 192 * 8, PREP_PER_WAVE = PREP_ITEMS / PREP_WAVES;
static_assert(PREP_PER_WAVE * PREP_WAVES == PREP_ITEMS, "prep items must deal evenly over the 192 attention-only units");
struct PrepIt { const float* src; unsigned char* dst; const float* gk; int ldw, K; bool gu; };
__device__ __forceinline__ PrepIt prep_decode(const Frame& F, int id, int lane) {
    PrepIt it; int k0, n0, r0; const float* W; unsigned char* WT;
    if (id < PREP_GU) { const int e = id >> 9, q = id & 511; k0 = 128 * (q >> 6); n0 = 32 * (q & 63);
        const int bj = n0 >> 10, j = n0 & 1023; r0 = 256 * (j >> 7) + 128 * bj + (j & 127);
        W = F.in[I_WGU] + (size_t)e * D * 2 * DFF; WT = F.ws + WS_WGU + (size_t)e * 2 * DFF * D; it.ldw = 2 * DFF; it.K = D; it.gu = true;
    } else { id -= PREP_GU; const int e = id >> 8, q = id & 255; k0 = 128 * (q >> 5); n0 = 32 * (q & 31); r0 = n0;
        W = F.in[I_WDN] + (size_t)e * DFF * D; WT = F.ws + WS_WDOWN + (size_t)e * D * DFF; it.ldw = D; it.K = DFF; it.gu = false; }
    const int kq = k0 + 16 * (lane >> 3), nq = 4 * (lane & 7);
    it.src = W + (size_t)kq * it.ldw + n0 + nq; it.dst = WT + (size_t)(r0 + nq) * it.K + kq; it.gk = F.in[I_G2] + kq;
    return it;
}
__device__ __forceinline__ void prep_load(const PrepIt& it, f32x4 (&g)[4], f32x4 (&v)[16]) {
#pragma unroll
    for (int i = 0; i < 4; ++i) g[i] = *(const f32x4*)(it.gk + 4 * i);
#pragma unroll
    for (int i = 0; i < 16; ++i) v[i] = __builtin_nontemporal_load((const f32x4*)(it.src + (size_t)i * it.ldw));
}
__device__ __forceinline__ void prep_store(const PrepIt& it, const f32x4 (&g)[4], const f32x4 (&v)[16]) {
    float gv[16];
#pragma unroll
    for (int i = 0; i < 16; ++i) gv[i] = it.gu ? g[i >> 2][i & 3] * 64.f : 64.f;
#pragma unroll
    for (int c = 0; c < 4; ++c) {
        v4u o;
        o.x = pk4_fp8(v[0][c] * gv[0], v[1][c] * gv[1], v[2][c] * gv[2], v[3][c] * gv[3]);
        o.y = pk4_fp8(v[4][c] * gv[4], v[5][c] * gv[5], v[6][c] * gv[6], v[7][c] * gv[7]);
        o.z = pk4_fp8(v[8][c] * gv[8], v[9][c] * gv[9], v[10][c] * gv[10], v[11][c] * gv[11]);
        o.w = pk4_fp8(v[12][c] * gv[12], v[13][c] * gv[13], v[14][c] * gv[14], v[15][c] * gv[15]);
        __builtin_nontemporal_store(o, (v4u*)(it.dst + (size_t)c * it.K));
    }
}
__device__ __forceinline__ void p2_prep(const Frame& F, int pa, int i0, int i1) {
    if (i0 >= i1) return;
    int ln = F.lane; asm volatile("" : "+v"(ln));
    const int base = pa * 8 + F.wave;
    f32x4 ga[4], gb[4], va[16], vb[16];
    PrepIt ia = prep_decode(F, base + PREP_WAVES * i0, ln), ib;
    prep_load(ia, ga, va);
    int i = i0;
#pragma unroll 1
    while (i + 2 < i1) {
        ib = prep_decode(F, base + PREP_WAVES * (i + 1), ln); prep_load(ib, gb, vb); prep_store(ia, ga, va);
        ia = prep_decode(F, base + PREP_WAVES * (i + 2), ln); prep_load(ia, ga, va); prep_store(ib, gb, vb);
        i += 2;
    }
    if (i + 1 < i1) { ib = prep_decode(F, base + PREP_WAVES * (i + 1), ln); prep_load(ib, gb, vb); prep_store(ia, ga, va); prep_store(ib, gb, vb); }
    else prep_store(ia, ga, va);
}
constexpr int DTAB_OFF = 110592, DTAB_N = 704;
__device__ __forceinline__ void p2_attn_setup(Frame& F_) {
    Frame F = F_; { int t_ = F.tid; asm volatile("" : "+v"(t_)); F.tid = t_; F.lane = t_ & 63; }
    LAS float* dt = (LAS float*)(F.lds + DTAB_OFF);
    for (int i = F.tid; i < 4 * DTAB_N; i += NTHR) { const int h = i / DTAB_N, rel = i % DTAB_N - 256;
        dt[i] = (rel >= 0 && rel < 128) ? (F.in[I_REL][T5_BUCKET[rel] * 4 + h] - F.in[I_REL][31 * 4 + h]) * LOG2E : 0.f; }
    __syncthreads();
}
__device__ __forceinline__ void p2_attn_unit(Frame& F, unsigned char* lds_generic, int bh, int qb, float lam, int pa, int slot, int nslot) {
    const int b = bh >> 2, h = bh & 3;
    const bf16* QA = proj_buf(F, 0); const bf16* KA = proj_buf(F, 1); const bf16* VA = proj_buf(F, 2);
    bf16* OT = (bf16*)(F.dout + DO_OTMP); bf16* MIX = (bf16*)(F.ws + WS_XN);
    const float cfar = F.in[I_REL][31 * 4 + h] * LOG2E;
    attn_body::lds_cfptr dtab = (attn_body::lds_cfptr)(F.lds + DTAB_OFF) + h * DTAB_N;
    attn_body::attn_unit128<8, false>(b, qb, QA + h * 128, KA + h * 128, VA + h * 128, OT + h * 256, (char*)lds_generic, cfar, dtab);
    attn_body::attn_unit128<8, true>(b, qb, QA + h * 128 + 64, KA + h * 128 + 64, VA + h * 128, OT + h * 256 + 128, (char*)lds_generic, cfar, dtab);
    int ln = F.lane; asm volatile("" : "+v"(ln));
    const size_t R = (size_t)b * SEQ + qb * 256 + F.wave * 32 + (ln >> 1); const int half = ln & 1;
    const v4u* o0 = (const v4u*)(OT + R * 1024 + h * 256 + half * 64);
    const LAS v4u* o1 = (const LAS v4u*)(F.lds + attn_body::L2_OST + F.wave * 8192 + (ln >> 1) * 256 + half * 128);
    float d[64]; float ss = 0.f;
#pragma unroll
    for (int c = 0; c < 8; ++c) { const v4u a = o0[c], bb = o1[c];
        d[8 * c] = bflo(a.x) - lam * bflo(bb.x); d[8 * c + 1] = bfhi(a.x) - lam * bfhi(bb.x); d[8 * c + 2] = bflo(a.y) - lam * bflo(bb.y); d[8 * c + 3] = bfhi(a.y) - lam * bfhi(bb.y);
        d[8 * c + 4] = bflo(a.z) - lam * bflo(bb.z); d[8 * c + 5] = bfhi(a.z) - lam * bfhi(bb.z); d[8 * c + 6] = bflo(a.w) - lam * bflo(bb.w); d[8 * c + 7] = bfhi(a.w) - lam * bfhi(bb.w); }
#pragma unroll
    for (int i = 0; i < 64; ++i) ss += d[i] * d[i];
    ss += __shfl_xor(ss, 1);
    const float rs = rsqrtf(ss * (1.f / 128.f) + EPS) * (1.f - LAM_INIT);
    const float* g = F.in[I_DNG] + h * 128 + half * 64; v4u* mp = (v4u*)(MIX + R * 1024 + h * 128 + half * 64);
    f32x4 gg[16];
#pragma unroll
    for (int c = 0; c < 16; ++c) gg[c] = *(const f32x4*)(g + 4 * c);
#pragma unroll
    for (int c = 0; c < 8; ++c) { const f32x4 g0 = gg[2 * c], g1 = gg[2 * c + 1];
        v4u w; w.x = pk2(d[8 * c] * rs * g0.x, d[8 * c + 1] * rs * g0.y); w.y = pk2(d[8 * c + 2] * rs * g0.z, d[8 * c + 3] * rs * g0.w);
        w.z = pk2(d[8 * c + 4] * rs * g1.x, d[8 * c + 5] * rs * g1.y); w.w = pk2(d[8 * c + 6] * rs * g1.z, d[8 * c + 7] * rs * g1.w); mp[c] = w; }
    if (pa >= 0) p2_prep(F, pa, PREP_PER_WAVE * slot / nslot, PREP_PER_WAVE * (slot + 1) / nslot);
    asm volatile("s_waitcnt lgkmcnt(0)\n\ts_barrier" ::: "memory");
}
namespace ml {
constexpr int STR = 72;
constexpr int QS = 0, KS = 9216, KTS = 18432, VTS = 27648, PS = 46080, CWL = 55296, GSL = 57856, WV = 58368, HS = 74752, HSTR = 132, END = HS + 64 * HSTR * 4;
static_assert(END <= 131072, "mLSTM LDS map");
__device__ __forceinline__ f32x4 mfma16(bf16x8 a, bf16x8 b, f32x4 c) { return __builtin_amdgcn_mfma_f32_16x16x32_bf16(a, b, c, 0, 0, 0); }
__device__ __forceinline__ float red_q(float v) { v += __shfl_xor(v, 16); v += __shfl_xor(v, 32); return v; }
__device__ __forceinline__ float bfe(const bf16x8& v, int i) { return __uint_as_float(((unsigned)(unsigned short)v[i]) << 16); }
}
__device__ __forceinline__ void p2_mlstm_fast(Frame& F, int bh) {
    using namespace ml;
#define ML_BAR() asm volatile("s_waitcnt lgkmcnt(0)\n\ts_barrier" ::: "memory")
    int tid = F.tid; asm volatile("" : "+v"(tid));
    const int lane = tid & 63, w = __builtin_amdgcn_readfirstlane(tid >> 6), c = lane & 15, q = lane >> 4;
    const int b = bh >> 2, h = bh & 3; const size_t R0 = (size_t)b * SEQ;
    LAS unsigned char* L = F.lds;
    LAS bf16* Qs = (LAS bf16*)(L + QS); LAS bf16* Ks = (LAS bf16*)(L + KS); LAS bf16* KTs = (LAS bf16*)(L + KTS); LAS bf16* VTs = (LAS bf16*)(L + VTS); LAS bf16* Ps = (LAS bf16*)(L + PS);
    LAS float* cwl = (LAS float*)(L + CWL); LAS float* gs = (LAS float*)(L + GSL); LAS float* wv = (LAS float*)(L + WV) + w * 512; LAS float* Hs = (LAS float*)(L + HS);
    LAS float* Aw = wv, *Mw = wv + 64, *WIw = wv + 128, *EMw = wv + 192, *WKw = wv + 256, *Nw = wv + 320, *DNw = wv + 384;
    const bf16* MQK = proj_buf(F, 3); const bf16* MV = proj_buf(F, 4); const bf16* MO = proj_buf(F, 5); const float* GT = (const float*)(F.ws + WS_GATES);
    bf16* MIX = (bf16*)(F.ws + WS_XN);
    __syncthreads();
    for (int i = tid; i < 5 * 128; i += NTHR) { const int tap = i >> 7, cc = i & 127; const int chn = cc < 64 ? h * 64 + cc : 256 + h * 64 + (cc - 64); cwl[i] = tap < 4 ? F.in[I_CONVW][tap * 512 + chn] : F.in[I_CONVB][chn]; }
    f32x4 accC[4], nacc[4];
#pragma unroll
    for (int i = 0; i < 4; ++i) { accC[i] = (f32x4){0.f, 0.f, 0.f, 0.f}; nacc[i] = (f32x4){0.f, 0.f, 0.f, 0.f}; }
    float m_prev = 0.f;
    const int sc = tid & 31, jg = tid >> 5, cc = 4 * sc;
    const int chq = (cc < 64) ? h * 64 + cc : 256 + h * 64 + (cc - 64);
    const bool isk = cc >= 64; const float kscale = isk ? 0.125f : 1.f;
    f32x4 cw4[5];
#pragma unroll
    for (int tap = 0; tap < 5; ++tap) cw4[tap] = (f32x4){0.f, 0.f, 0.f, 0.f};
    const float mg0 = F.in[I_MLG][h * 128 + 2 * lane], mg1 = F.in[I_MLG][h * 128 + 2 * lane + 1], ob0 = F.in[I_OB][h * 128 + 2 * lane], ob1 = F.in[I_OB][h * 128 + 2 * lane + 1];
    v2u raw[7], vr[4]; float gli = 0.f, glf = 0.f;
#define ML_LOAD(ch_) do { const int ch__ = (ch_); \
        _Pragma("unroll") for (int i = 0; i < 7; ++i) { const int rr = 64 * ch__ + 4 * jg - 3 + i; \
            if (rr >= 0) raw[i] = *(const v2u*)(MQK + (R0 + rr) * 512 + chq); else raw[i] = (v2u){0u, 0u}; } \
        _Pragma("unroll") for (int i = 0; i < 4; ++i) vr[i] = *(const v2u*)(MV + (R0 + 64 * ch__ + 4 * jg + i) * 512 + h * 128 + cc); \
        gli = GT[(R0 + 64 * ch__ + lane) * 8 + h]; glf = GT[(R0 + 64 * ch__ + lane) * 8 + 4 + h]; } while (0)
    ML_LOAD(0);
    __syncthreads();
#pragma unroll
    for (int tap = 0; tap < 5; ++tap) cw4[tap] = *(const LAS f32x4*)(cwl + 128 * tap + cc);
#pragma unroll 1
    for (int ch = 0; ch < SEQ / 64; ++ch) {
        unsigned moc[8];
#pragma unroll
        for (int i = 0; i < 8; ++i) moc[i] = *(const unsigned*)(MO + (R0 + 64 * ch + 8 * w + i) * 512 + h * 128 + 2 * lane);
        ML_BAR();
        {
            float x[7][4];
#pragma unroll
            for (int i = 0; i < 7; ++i) { x[i][0] = bflo(raw[i].x); x[i][1] = bfhi(raw[i].x); x[i][2] = bflo(raw[i].y); x[i][3] = bfhi(raw[i].y); }
            float y[4][4];
#pragma unroll
            for (int r = 0; r < 4; ++r)
#pragma unroll
                for (int k = 0; k < 4; ++k) { const float t_ = cw4[4][k] + cw4[0][k] * x[r][k] + cw4[1][k] * x[r + 1][k] + cw4[2][k] * x[r + 2][k] + cw4[3][k] * x[r + 3][k]; y[r][k] = t_ * __builtin_amdgcn_rcpf(1.f + __expf(-t_)) * kscale; }
            LAS bf16* dst = isk ? Ks + (cc - 64) : Qs + cc;
#pragma unroll
            for (int r = 0; r < 4; ++r) { v2u o; o.x = pkh(y[r][0], y[r][1]); o.y = pkh(y[r][2], y[r][3]); *(LAS v2u*)(dst + (4 * jg + r) * STR) = o; }
            if (isk) {
#pragma unroll
                for (int k = 0; k < 4; ++k) { v2u o; o.x = pkh(y[0][k], y[1][k]); o.y = pkh(y[2][k], y[3][k]); *(LAS v2u*)(KTs + (cc - 64 + k) * STR + 4 * jg) = o; } }
            { v2u o;
              o.x = (vr[0].x & 0xffffu) | (vr[1].x << 16); o.y = (vr[2].x & 0xffffu) | (vr[3].x << 16); *(LAS v2u*)(VTs + (cc + 0) * STR + 4 * jg) = o;
              o.x = (vr[0].x >> 16) | (vr[1].x & 0xffff0000u); o.y = (vr[2].x >> 16) | (vr[3].x & 0xffff0000u); *(LAS v2u*)(VTs + (cc + 1) * STR + 4 * jg) = o;
              o.x = (vr[0].y & 0xffffu) | (vr[1].y << 16); o.y = (vr[2].y & 0xffffu) | (vr[3].y << 16); *(LAS v2u*)(VTs + (cc + 2) * STR + 4 * jg) = o;
              o.x = (vr[0].y >> 16) | (vr[1].y & 0xffff0000u); o.y = (vr[2].y >> 16) | (vr[3].y & 0xffff0000u); *(LAS v2u*)(VTs + (cc + 3) * STR + 4 * jg) = o; }
        }
        float decay, m_next;
        {   const float li = gli, lf = glf;
            float bsum = lf;
#pragma unroll
            for (int o = 1; o < 64; o <<= 1) { const float v_ = __shfl_up(bsum, o); if (lane >= o) bsum += v_; }
            const float a = li - bsum; float am = a;
#pragma unroll
            for (int o = 1; o < 64; o <<= 1) { const float v_ = __shfl_up(am, o); if (lane >= o) am = fmaxf(am, v_); }
            const float M = fmaxf(am, m_prev);
            const float g = __shfl(bsum, 63), M63 = __shfl(M, 63);
            Aw[lane] = a; Mw[lane] = M; WIw[lane] = __expf(m_prev - M); EMw[lane] = __expf(-(bsum + M)); WKw[lane] = __expf(a - M63);
            decay = __expf(m_prev - M63); m_next = g + M63;
        }
        if (ch + 1 < SEQ / 64) ML_LOAD(ch + 1);
        ML_BAR();
        {   const int tt = w >> 1; const bf16x8 qb0 = *(const LAS bf16x8*)(Qs + (16 * tt + c) * STR + 8 * q), qb1 = *(const LAS bf16x8*)(Qs + (16 * tt + c) * STR + 32 + 8 * q);
            const float Mt = Mw[16 * tt + c];
#pragma unroll
            for (int jj = 0; jj < 2; ++jj) { const int jt = 2 * (w & 1) + jj;
                const bf16x8 ka0 = *(const LAS bf16x8*)(Ks + (16 * jt + c) * STR + 8 * q), ka1 = *(const LAS bf16x8*)(Ks + (16 * jt + c) * STR + 32 + 8 * q);
                f32x4 sacc = mfma16(ka0, qb0, (f32x4){0.f, 0.f, 0.f, 0.f}); sacc = mfma16(ka1, qb1, sacc);
                const f32x4 a4 = *(const LAS f32x4*)(Aw + 16 * jt + 4 * q);
                float p[4];
#pragma unroll
                for (int r = 0; r < 4; ++r) p[r] = (16 * jt + 4 * q + r <= 16 * tt + c) ? sacc[r] * __expf(a4[r] - Mt) : 0.f;
                v2u pw; pw.x = pkh(p[0], p[1]); pw.y = pkh(p[2], p[3]);
                *(LAS v2u*)(Ps + (16 * tt + c) * STR + 16 * jt + 4 * q) = pw; }
        }
        ML_BAR();
        {   bf16x8 vb[2]; vb[0] = *(const LAS bf16x8*)(VTs + (16 * w + c) * STR + 8 * q); vb[1] = *(const LAS bf16x8*)(VTs + (16 * w + c) * STR + 32 + 8 * q);
            bf16x8 cbf[2];
#pragma unroll
            for (int ks = 0; ks < 2; ++ks) { v4u t_; t_.x = pkh(accC[2 * ks][0], accC[2 * ks][1]); t_.y = pkh(accC[2 * ks][2], accC[2 * ks][3]); t_.z = pkh(accC[2 * ks + 1][0], accC[2 * ks + 1][1]); t_.w = pkh(accC[2 * ks + 1][2], accC[2 * ks + 1][3]); cbf[ks] = __builtin_bit_cast(bf16x8, t_); }
            bf16x8 nb[2];
#pragma unroll
            for (int ks = 0; ks < 2; ++ks) { v4u t_; t_.x = pkh(nacc[2 * ks][0], nacc[2 * ks][1]); t_.y = pkh(nacc[2 * ks][2], nacc[2 * ks][3]); t_.z = pkh(nacc[2 * ks + 1][0], nacc[2 * ks + 1][1]); t_.w = pkh(nacc[2 * ks + 1][2], nacc[2 * ks + 1][3]); nb[ks] = __builtin_bit_cast(bf16x8, t_); }
            const bf16x8 ones8 = {(short)0x3f80, (short)0x3f80, (short)0x3f80, (short)0x3f80, (short)0x3f80, (short)0x3f80, (short)0x3f80, (short)0x3f80};
#pragma unroll
            for (int m = 0; m < 4; ++m) {
                f32x4 ia = (f32x4){0.f, 0.f, 0.f, 0.f}, ie = (f32x4){0.f, 0.f, 0.f, 0.f}, rs4 = (f32x4){0.f, 0.f, 0.f, 0.f}, qn4 = (f32x4){0.f, 0.f, 0.f, 0.f};
#pragma unroll
                for (int ks = 0; ks < 2; ++ks) {
                    const bf16x8 pa = *(const LAS bf16x8*)(Ps + (16 * m + c) * STR + 32 * ks + 8 * q);
                    ia = mfma16(pa, vb[ks], ia); rs4 = mfma16(pa, ones8, rs4);
                    const v2u qlo = *(const LAS v2u*)(Qs + (16 * m + c) * STR + 32 * ks + 4 * q), qhi = *(const LAS v2u*)(Qs + (16 * m + c) * STR + 32 * ks + 16 + 4 * q);
                    v4u qq; qq.x = qlo.x; qq.y = qlo.y; qq.z = qhi.x; qq.w = qhi.y; const bf16x8 qa = __builtin_bit_cast(bf16x8, qq);
                    ie = mfma16(qa, cbf[ks], ie); qn4 = mfma16(qa, nb[ks], qn4);
                }
                const f32x4 wi4 = *(const LAS f32x4*)(WIw + 16 * m + 4 * q), em4 = *(const LAS f32x4*)(EMw + 16 * m + 4 * q);
#pragma unroll
                for (int r = 0; r < 4; ++r) { const float den = rs4[r] + wi4[r] * qn4[r]; const float rden = __builtin_amdgcn_rcpf(fmaxf(fabsf(den), em4[r]));
                    Hs[(16 * m + 4 * q + r) * HSTR + 16 * w + c] = (ia[r] + wi4[r] * ie[r]) * rden; }
            }
            f32x4 wk8[2][2];
#pragma unroll
            for (int ks = 0; ks < 2; ++ks) { wk8[ks][0] = *(const LAS f32x4*)(WKw + 32 * ks + 8 * q); wk8[ks][1] = *(const LAS f32x4*)(WKw + 32 * ks + 8 * q + 4); }
            bf16x8 vs[2], wkb[2];
#pragma unroll
            for (int ks = 0; ks < 2; ++ks) { v4u t_; t_.x = pkh(bfe(vb[ks], 0) * wk8[ks][0][0], bfe(vb[ks], 1) * wk8[ks][0][1]); t_.y = pkh(bfe(vb[ks], 2) * wk8[ks][0][2], bfe(vb[ks], 3) * wk8[ks][0][3]);
                t_.z = pkh(bfe(vb[ks], 4) * wk8[ks][1][0], bfe(vb[ks], 5) * wk8[ks][1][1]); t_.w = pkh(bfe(vb[ks], 6) * wk8[ks][1][2], bfe(vb[ks], 7) * wk8[ks][1][3]); vs[ks] = __builtin_bit_cast(bf16x8, t_);
                v4u u_; u_.x = pkh(wk8[ks][0][0], wk8[ks][0][1]); u_.y = pkh(wk8[ks][0][2], wk8[ks][0][3]); u_.z = pkh(wk8[ks][1][0], wk8[ks][1][1]); u_.w = pkh(wk8[ks][1][2], wk8[ks][1][3]); wkb[ks] = __builtin_bit_cast(bf16x8, u_); }
#pragma unroll
            for (int dt = 0; dt < 4; ++dt) { f32x4 ca = accC[dt] * decay, na = nacc[dt] * decay;
#pragma unroll
                for (int ks = 0; ks < 2; ++ks) { const bf16x8 ka = *(const LAS bf16x8*)(KTs + (16 * dt + c) * STR + 32 * ks + 8 * q); ca = mfma16(ka, vs[ks], ca); na = mfma16(ka, wkb[ks], na); }
                accC[dt] = ca; nacc[dt] = na; }
            m_prev = m_next;
        }
        ML_BAR();
#pragma unroll
        for (int i = 0; i < 8; ++i) { const int t = 8 * w + i; const float h0 = Hs[t * HSTR + 2 * lane], h1 = Hs[t * HSTR + 2 * lane + 1];
            const float rsn = rsqrtf(wave_sum(h0 * h0 + h1 * h1) * (1.f / 128.f) + EPS);
            const float o0 = h0 * rsn * mg0 * sigmoidf_(bflo(moc[i]) + ob0), o1 = h1 * rsn * mg1 * sigmoidf_(bfhi(moc[i]) + ob1);
            *(unsigned*)(MIX + (R0 + 64 * ch + t) * 1024 + 512 + h * 128 + 2 * lane) = pkh(o0, o1); }
    }
#undef ML_LOAD
#undef ML_BAR
    __syncthreads();
}

__device__ __forceinline__ void p4_route(Frame& F_) {
    Frame F = F_; { int t_ = F.tid; asm volatile("" : "+v"(t_)); F.tid = t_; F.lane = t_ & 63; }
    LAS v4u* wf = (LAS v4u*)F.lds;
    LAS unsigned* hist = (LAS unsigned*)(F.lds + L_HIST);
    for (int i = F.tid; i < 32 * 2 * 64; i += NTHR) { const int ln = i & 63, nt = (i >> 6) & 1, s_ = i >> 7, e = 16 * nt + (ln & 15), k0 = 32 * s_ + 8 * (ln >> 4);
        float w[8]; unsigned hi16[8], lo16[8];
#pragma unroll
        for (int j = 0; j < 8; ++j) { w[j] = F.in[I_RW][(k0 + j) * NE + e] * F.in[I_G2][k0 + j]; hi16[j] = f2bf(w[j]); lo16[j] = f2bf(w[j] - __uint_as_float(hi16[j] << 16)); }
        v4u h4, l4; h4.x = hi16[0] | (hi16[1] << 16); h4.y = hi16[2] | (hi16[3] << 16); h4.z = hi16[4] | (hi16[5] << 16); h4.w = hi16[6] | (hi16[7] << 16);
        l4.x = lo16[0] | (lo16[1] << 16); l4.y = lo16[2] | (lo16[3] << 16); l4.z = lo16[4] | (lo16[5] << 16); l4.w = lo16[6] | (lo16[7] << 16);
        wf[((s_ * 2 + nt) * 2 + 0) * 64 + ln] = h4; wf[((s_ * 2 + nt) * 2 + 1) * 64 + ln] = l4; }
    const bf16* X1 = (const bf16*)(F.ws + WS_X1B);
    float* RS = (float*)(F.ws + WS_RSTD2); unsigned* TI = (unsigned*)(F.ws + WS_TOKINFO); float* GA = (float*)(F.ws + WS_GATE); unsigned* HIST = (unsigned*)(F.ws + WS_HIST);
    const int c = F.lane & 15, q = F.lane >> 4;
    const float rb0 = F.in[I_RB][c], rb1 = F.in[I_RB][16 + c];
    for (int blk = F.vcu; blk < T / 256; blk += F.G) {
        if (F.tid < 32) hist[F.tid] = 0u;
        __syncthreads();
#pragma unroll 1
        for (int grp = 0; grp < 2; ++grp) {
            const int t0 = blk * 256 + F.wave * 32 + grp * 16;
            const bf16x8* xr = (const bf16x8*)(X1 + (size_t)(t0 + c) * D + 8 * q);
            bf16x8 xa[32];
#pragma unroll
            for (int s_ = 0; s_ < 32; ++s_) xa[s_] = xr[4 * s_];
            f32x4 l0 = (f32x4){0.f, 0.f, 0.f, 0.f}, l1 = (f32x4){0.f, 0.f, 0.f, 0.f}; float ss = 0.f;
#pragma unroll
            for (int s_ = 0; s_ < 32; ++s_) {
                const bf16x8 b0h = __builtin_bit_cast(bf16x8, wf[((s_ * 2 + 0) * 2 + 0) * 64 + F.lane]), b0l = __builtin_bit_cast(bf16x8, wf[((s_ * 2 + 0) * 2 + 1) * 64 + F.lane]);
                const bf16x8 b1h = __builtin_bit_cast(bf16x8, wf[((s_ * 2 + 1) * 2 + 0) * 64 + F.lane]), b1l = __builtin_bit_cast(bf16x8, wf[((s_ * 2 + 1) * 2 + 1) * 64 + F.lane]);
                l0 = __builtin_amdgcn_mfma_f32_16x16x32_bf16(xa[s_], b0h, l0, 0, 0, 0); l0 = __builtin_amdgcn_mfma_f32_16x16x32_bf16(xa[s_], b0l, l0, 0, 0, 0);
                l1 = __builtin_amdgcn_mfma_f32_16x16x32_bf16(xa[s_], b1h, l1, 0, 0, 0); l1 = __builtin_amdgcn_mfma_f32_16x16x32_bf16(xa[s_], b1l, l1, 0, 0, 0);
#pragma unroll
                for (int j = 0; j < 8; ++j) { const float xv = __uint_as_float(((unsigned)(unsigned short)xa[s_][j]) << 16); ss += xv * xv; }
            }
            ss += __shfl_xor(ss, 16); ss += __shfl_xor(ss, 32);
            const float rstd_c = rsqrtf(ss * (1.f / D) + EPS);
#pragma unroll
            for (int r = 0; r < 4; ++r) {
                const float rstd = __shfl(rstd_c, 4 * q + r);
                const float g0 = l0[r] * rstd + rb0, g1 = l1[r] * rstd + rb1;
                int k0, k1; { const int b_ = __float_as_int(g0); k0 = b_ ^ ((b_ >> 31) & 0x7fffffff); k0 = (k0 & ~31) | (31 - c); }
                { const int b_ = __float_as_int(g1); k1 = b_ ^ ((b_ >> 31) & 0x7fffffff); k1 = (k1 & ~31) | (15 - c); }
                float tv[4]; int te[4];
#pragma unroll
                for (int k = 0; k < 4; ++k) { int mx = k0 > k1 ? k0 : k1;
#pragma unroll
                    for (int o = 1; o < 16; o <<= 1) { const int other = __shfl_xor(mx, o); mx = other > mx ? other : mx; }
                    te[k] = 31 - (mx & 31); { const int kk = mx & ~31; tv[k] = __int_as_float(kk ^ ((kk >> 31) & 0x7fffffff)); }
                    if (te[k] == c) k0 = (int)0x80000000; if (te[k] == 16 + c) k1 = (int)0x80000000; }
                const float e1 = __expf(tv[1] - tv[0]), e2 = __expf(tv[2] - tv[0]), e3 = __expf(tv[3] - tv[0]); const float inv = 1.f / (1.f + e1 + e2 + e3);
                if (c == 0) { const int t = t0 + 4 * q + r;
                    RS[t] = rstd;
                    f32x4 g; g.x = inv; g.y = e1 * inv; g.z = e2 * inv; g.w = e3 * inv; *(f32x4*)(GA + (size_t)t * 4) = g;
                    v4u ti;
                    ti.x = ((unsigned)te[0] << 20) | atomicAdd((unsigned*)&hist[te[0]], 1u); ti.y = ((unsigned)te[1] << 20) | atomicAdd((unsigned*)&hist[te[1]], 1u);
                    ti.z = ((unsigned)te[2] << 20) | atomicAdd((unsigned*)&hist[te[2]], 1u); ti.w = ((unsigned)te[3] << 20) | atomicAdd((unsigned*)&hist[te[3]], 1u);
                    *(v4u*)(TI + (size_t)t * 4) = ti; }
            }
        }
        __syncthreads();
        if (F.tid < 32) HIST[blk * 32 + F.tid] = hist[F.tid];
        __syncthreads();
    }
}

__device__ __forceinline__ void p4b_lists(Frame& F_) {
    Frame F = F_; { int t_ = F.tid; asm volatile("" : "+v"(t_)); F.tid = t_; F.lane = t_ & 63; }
    LAS int* pb = (LAS int*)F.lds; LAS int* pa = pb + 512; LAS unsigned* basew = (LAS unsigned*)(F.lds + L_BASE);
    LAS int* tb = (LAS int*)(F.lds + L_ETAB); LAS int* cn = tb + 40;
    const unsigned* HIST = (const unsigned*)(F.ws + WS_HIST); const float* RS = (const float*)(F.ws + WS_RSTD2);
    unsigned* TI = (unsigned*)(F.ws + WS_TOKINFO); int* LIST = (int*)(F.ws + WS_LIST); float* LRS = (float*)(F.ws + WS_LISTRS);
    { const int e = F.tid & 31, p = F.tid >> 5; int sa = 0;
#pragma unroll
      for (int i = 0; i < 16; ++i) sa += (int)HIST[(16 * p + i) * 32 + e];
      pa[F.tid] = sa; }
    __syncthreads();
    if (F.tid < 32) { int sa = 0;
#pragma unroll
        for (int p = 0; p < 16; ++p) sa += pa[32 * p + F.tid];
        cn[F.tid] = sa; }
    __syncthreads();
    if (F.tid == 0) { int acc = 0; for (int e = 0; e < NE; ++e) { tb[e] = acc; acc += (cn[e] + 255) >> 8; } tb[NE] = acc; }
    for (int blk = F.vcu; blk < T / 256; blk += F.G) {
        { const int e = F.tid & 31, p = F.tid >> 5; int sb = 0;
#pragma unroll
          for (int i = 0; i < 16; ++i) { const int bb = 16 * p + i; const int hv = (int)HIST[bb * 32 + e]; sb += bb < blk ? hv : 0; }
          pb[F.tid] = sb; }
        __syncthreads();
        if (F.tid < 32) { int sb = 0;
#pragma unroll
            for (int p = 0; p < 16; ++p) sb += pb[32 * p + F.tid];
            basew[F.tid] = (unsigned)sb; }
        __syncthreads();
        for (int i = F.tid; i < 1024; i += NTHR) {
            const int t = blk * 256 + (i >> 2); const unsigned ti = TI[(size_t)t * 4 + (i & 3)]; const unsigned e = ti >> 20, pos = basew[e] + (ti & 0xfffffu);
            TI[(size_t)t * 4 + (i & 3)] = (e << 20) | pos; LIST[(size_t)e * T + pos] = t; LRS[(size_t)e * T + pos] = RS[t];
        }
        __syncthreads();
    }
}

__device__ __forceinline__ int find_expert(const LAS int* tb, int tile256) { int e = 0;
#pragma unroll 1
    for (int i = 1; i < NE; ++i) e = (tile256 >= tb[i]) ? i : e;
    return e; }

struct DenseSched {
    pg8::TileOrder ord; const char* A; const char* Bt; int K;
    __device__ __forceinline__ bool next(int i, pg8::Unit& u) const { u.e = 0; return ord.next_tile(i, u.pm, u.pn); }
    __device__ __forceinline__ void a_view(const pg8::Unit& u, const int (&R)[2], const int (&C)[2], const char*& base, unsigned (&off)[2][2]) const {
        base = A + (size_t)u.pm * 256 * K * 2;
#pragma unroll
        for (int h = 0; h < 2; ++h)
#pragma unroll
            for (int i = 0; i < 2; ++i) off[h][i] = (unsigned)((h * 128 + R[i]) * K + C[i]) * 2u;
    }
    __device__ __forceinline__ void a_pre(const pg8::Unit&, const int (&)[2], unsigned (&)[2][2]) const {}
    __device__ __forceinline__ void a_post(const pg8::Unit& u, unsigned (&)[2][2], const int (&R)[2], const int (&C)[2], const char*& base, unsigned (&off)[2][2]) const { a_view(u, R, C, base, off); }
    __device__ __forceinline__ const char* b_base(const pg8::Unit& u) const { return Bt + (size_t)u.pn * 256 * K * 2; }
};
struct EpiProj {
    unsigned char* ws;
    __device__ __forceinline__ void operator()(const f32x4 (&acc)[2][2][4][2], const pg8::Unit& u, int wr, int wc, int fr, int fq) const {
        asm volatile("" : "+v"(fr));
        const int buf = u.pn >> 1; bf16* base = (bf16*)(ws + proj_off(buf)); const float sc = buf == 0 ? C2 : 1.f;
        const int row0 = u.pm * 256 + wr * 64 + fr, col0 = (u.pn & 1) * 256 + wc * 32 + 8 * fq;
#pragma unroll
        for (int ai = 0; ai < 2; ++ai)
#pragma unroll
            for (int m = 0; m < 4; ++m) { bf16* rowp = base + (size_t)(row0 + ai * 128 + m * 16) * 512 + col0;
#pragma unroll
                for (int bj = 0; bj < 2; ++bj) { const f32x4 v0 = acc[ai][bj][m][0] * sc, v1 = acc[ai][bj][m][1] * sc;
                    v4u w; w.x = pg8::cvt_pk_bf16(v0[0], v0[1]); w.y = pg8::cvt_pk_bf16(v0[2], v0[3]); w.z = pg8::cvt_pk_bf16(v1[0], v1[1]); w.w = pg8::cvt_pk_bf16(v1[2], v1[3]);
                    *(v4u*)(rowp + bj * 128) = w; } }
    }
};
struct EpiOutProj {
    const float* x; bf16* X1; unsigned char* X8;
    __device__ __forceinline__ void operator()(const f32x4 (&acc)[2][2][4][2], const pg8::Unit& u, int wr, int wc, int fr, int fq) const {
        asm volatile("" : "+v"(fr));
        const int row0 = u.pm * 256 + wr * 64 + fr, col0 = u.pn * 256 + wc * 32 + 8 * fq;
#pragma unroll
        for (int ai = 0; ai < 2; ++ai)
#pragma unroll
            for (int m = 0; m < 4; ++m) { const size_t ro = (size_t)(row0 + ai * 128 + m * 16) * D + col0;
#pragma unroll
                for (int bj = 0; bj < 2; ++bj) { const f32x4 v0 = acc[ai][bj][m][0] + *(const f32x4*)(x + ro + bj * 128), v1 = acc[ai][bj][m][1] + *(const f32x4*)(x + ro + bj * 128 + 4);
                    v4u w; w.x = pg8::cvt_pk_bf16(v0[0], v0[1]); w.y = pg8::cvt_pk_bf16(v0[2], v0[3]); w.z = pg8::cvt_pk_bf16(v1[0], v1[1]); w.w = pg8::cvt_pk_bf16(v1[2], v1[3]);
                    *(v4u*)(X1 + ro + bj * 128) = w;
                    v2u w8; w8.x = pk4_fp8(v0[0], v0[1], v0[2], v0[3]); w8.y = pk4_fp8(v1[0], v1[1], v1[2], v1[3]); *(v2u*)(X8 + ro + bj * 128) = w8; } }
    }
};
template <bool GATHER> struct MoeSched8 {
    pg8::TileOrder ord; const LAS int* tb; const LAS int* cn; const char* A; const char* W; const int* LIST; int wrows;
    __device__ __forceinline__ bool next(int i, pg8::Unit& u) const { if (!ord.next_tile(i, u.pm, u.pn)) return false; u.e = find_expert(tb, u.pm); return true; }
    __device__ __forceinline__ void a_view(const pg8::Unit& u, const int (&R)[2], const int (&C)[2], const char*& base, unsigned (&off)[2][2]) const {
        if constexpr (GATHER) {
            base = A; const int pos0 = (u.pm - tb[u.e]) * 256, cnt = cn[u.e]; const int* lst = LIST + (size_t)u.e * T;
#pragma unroll
            for (int h = 0; h < 2; ++h)
#pragma unroll
                for (int i = 0; i < 2; ++i) { int p = pos0 + h * 128 + R[i]; p = p < cnt ? p : cnt - 1; off[h][i] = (unsigned)(lst[p] * D + C[i] * 2); }
        } else {
            base = A + (size_t)u.pm * 256 * DFF;
#pragma unroll
            for (int h = 0; h < 2; ++h)
#pragma unroll
                for (int i = 0; i < 2; ++i) off[h][i] = (unsigned)((h * 128 + R[i]) * DFF + C[i] * 2);
        }
    }
    __device__ __forceinline__ void a_pre(const pg8::Unit& u, const int (&R)[2], unsigned (&pre)[2][2]) const {
        if constexpr (GATHER) { const int pos0 = (u.pm - tb[u.e]) * 256, cnt = cn[u.e]; const int* lst = LIST + (size_t)u.e * T;
#pragma unroll
            for (int h = 0; h < 2; ++h)
#pragma unroll
                for (int i = 0; i < 2; ++i) { int p = pos0 + h * 128 + R[i]; p = p < cnt ? p : cnt - 1; const int* ptr = lst + p;
                    asm volatile("global_load_dword %0, %1, off" : "=v"(pre[h][i]) : "v"(ptr)); }
        }
    }
    __device__ __forceinline__ void a_post(const pg8::Unit& u, unsigned (&pre)[2][2], const int (&R)[2], const int (&C)[2], const char*& base, unsigned (&off)[2][2]) const {
        if constexpr (GATHER) { base = A;
#pragma unroll
            for (int h = 0; h < 2; ++h)
#pragma unroll
                for (int i = 0; i < 2; ++i) { asm volatile("" : "+v"(pre[h][i])); off[h][i] = pre[h][i] * (unsigned)D + (unsigned)(C[i] * 2); }
        } else a_view(u, R, C, base, off);
    }
    __device__ __forceinline__ const char* b_base(const pg8::Unit& u) const { return W + ((size_t)u.e * wrows + (size_t)u.pn * 256) * D; }
};
typedef float f32x2v __attribute__((ext_vector_type(2)));
__device__ __forceinline__ f32x2v swiglu_pk(f32x2v accg, f32x2v accl, f32x2v rs2, f32x2v bgv, f32x2v blv) {
    f32x2v g = __builtin_elementwise_fma(accg, rs2, bgv), l = __builtin_elementwise_fma(accl, rs2, blv);
    g.x = fminf(g.x, 7.f); g.y = fminf(g.y, 7.f); l.x = __builtin_amdgcn_fmed3f(l.x, -7.f, 7.f); l.y = __builtin_amdgcn_fmed3f(l.y, -7.f, 7.f);
    f32x2v z = g * -2.45546696f;
    f32x2v e; e.x = __builtin_amdgcn_exp2f(z.x); e.y = __builtin_amdgcn_exp2f(z.y);
    e = e + 1.0f; f32x2v r; r.x = __builtin_amdgcn_rcpf(e.x); r.y = __builtin_amdgcn_rcpf(e.y);
    return (g * r) * (l + 1.0f);
}
struct EpiGateUp8 {
    const LAS int* tb; const LAS int* cn; const float* LRS; const float* bgu; unsigned char* ACT8;
    __device__ __forceinline__ void operator()(const f32x4 (&acc)[2][2][4][2], const pg8::Unit& u, int wr, int wc, int fr, int fq) const {
        asm volatile("" : "+v"(fr));
        const int pos0 = (u.pm - tb[u.e]) * 256, cnt = cn[u.e]; const float* lrs = LRS + (size_t)u.e * T; const float* bg = bgu + (size_t)u.e * 2 * DFF;
        const int j0 = u.pn * 128 + wc * 32 + 8 * fq;
        const f32x4 bg0 = *(const f32x4*)(bg + j0), bg1 = *(const f32x4*)(bg + j0 + 4), bl0 = *(const f32x4*)(bg + DFF + j0), bl1 = *(const f32x4*)(bg + DFF + j0 + 4);
        unsigned char* abase = ACT8 + (size_t)u.pm * 256 * DFF;
#pragma unroll
        for (int ai = 0; ai < 2; ++ai)
#pragma unroll
            for (int m = 0; m < 4; ++m) { const int rl = ai * 128 + wr * 64 + m * 16 + fr; int p = pos0 + rl; p = p < cnt ? p : cnt - 1; const float rs = lrs[p]; const f32x2v rs2 = {rs, rs};
                const f32x4 ag0 = acc[ai][0][m][0], ag1 = acc[ai][0][m][1], al0 = acc[ai][1][m][0], al1 = acc[ai][1][m][1];
                const f32x2v o0 = swiglu_pk((f32x2v){ag0[0], ag0[1]}, (f32x2v){al0[0], al0[1]}, rs2, (f32x2v){bg0[0], bg0[1]}, (f32x2v){bl0[0], bl0[1]});
                const f32x2v o1 = swiglu_pk((f32x2v){ag0[2], ag0[3]}, (f32x2v){al0[2], al0[3]}, rs2, (f32x2v){bg0[2], bg0[3]}, (f32x2v){bl0[2], bl0[3]});
                const f32x2v o2 = swiglu_pk((f32x2v){ag1[0], ag1[1]}, (f32x2v){al1[0], al1[1]}, rs2, (f32x2v){bg1[0], bg1[1]}, (f32x2v){bl1[0], bl1[1]});
                const f32x2v o3 = swiglu_pk((f32x2v){ag1[2], ag1[3]}, (f32x2v){al1[2], al1[3]}, rs2, (f32x2v){bg1[2], bg1[3]}, (f32x2v){bl1[2], bl1[3]});
                v2u w; w.x = pk4_fp8(o0.x, o0.y, o1.x, o1.y); w.y = pk4_fp8(o2.x, o2.y, o3.x, o3.y);
                *(v2u*)(abase + (size_t)rl * DFF + j0) = w; }
    }
};
struct EpiDown {
    const float* bdn; unsigned char* YK8;
    __device__ __forceinline__ void operator()(const f32x4 (&acc)[2][2][4][2], const pg8::Unit& u, int wr, int wc, int fr, int fq) const {
        asm volatile("" : "+v"(fr));
        const float* bd = bdn + (size_t)u.e * D; const int row0 = u.pm * 256 + wr * 64 + fr, col0 = u.pn * 256 + wc * 32 + 8 * fq;
        f32x4 bv[2][2];
#pragma unroll
        for (int bj = 0; bj < 2; ++bj)
#pragma unroll
            for (int n = 0; n < 2; ++n) bv[bj][n] = *(const f32x4*)(bd + col0 + bj * 128 + 4 * n);
#pragma unroll
        for (int ai = 0; ai < 2; ++ai)
#pragma unroll
            for (int m = 0; m < 4; ++m) { unsigned char* rowp = YK8 + (size_t)(row0 + ai * 128 + m * 16) * D + col0;
#pragma unroll
                for (int bj = 0; bj < 2; ++bj) { const f32x4 v0 = acc[ai][bj][m][0] + bv[bj][0], v1 = acc[ai][bj][m][1] + bv[bj][1];
                    v2u w; w.x = pk4_fp8(v0[0], v0[1], v0[2], v0[3]); w.y = pk4_fp8(v1[0], v1[1], v1[2], v1[3]);
                    *(v2u*)(rowp + bj * 128) = w; } }
    }
};

__device__ __forceinline__ void p7_final(Frame& F_) {
    Frame F = F_; { int t_ = F.tid; asm volatile("" : "+v"(t_)); F.tid = t_; F.lane = t_ & 63; }
    const LAS int* tb = (const LAS int*)(F.lds + L_ETAB);
    const bf16* X1 = (const bf16*)(F.ws + WS_X1B); const unsigned char* YK = F.ws + WS_YK; const unsigned* TI = (const unsigned*)(F.ws + WS_TOKINFO); const float* GA = (const float*)(F.ws + WS_GATE);
    const float* gf = F.in[I_GF]; float* out = (float*)F.dout;
    const int gw = F.vcu * NWAVES + F.wave, NGW = F.G * NWAVES;
    v4u ti_n[2]; f32x4 ga_n[2];
#pragma unroll
    for (int r = 0; r < 2; ++r) { const int tt = gw + r * NGW; const int tc = tt < T ? tt : 0; ti_n[r] = *(const v4u*)(TI + (size_t)tc * 4); ga_n[r] = *(const f32x4*)(GA + (size_t)tc * 4); }
    for (int t0 = gw; t0 < T; t0 += 2 * NGW) {
        v4u ti[2]; f32x4 ga[2];
#pragma unroll
        for (int r = 0; r < 2; ++r) { ti[r] = ti_n[r]; ga[r] = ga_n[r]; }
#pragma unroll
        for (int r = 0; r < 2; ++r) { const int tt = t0 + (2 + r) * NGW; const int tc = tt < T ? tt : 0; ti_n[r] = *(const v4u*)(TI + (size_t)tc * 4); ga_n[r] = *(const f32x4*)(GA + (size_t)tc * 4); }
        v2u xw[2][4]; int yw[2][4][4];
#pragma unroll
        for (int r = 0; r < 2; ++r) { const int tt = t0 + r * NGW; const int t = tt < T ? tt : t0;
            const unsigned tw[4] = {ti[r].x, ti[r].y, ti[r].z, ti[r].w};
#pragma unroll
            for (int j = 0; j < 4; ++j) xw[r][j] = *((const v2u*)(X1 + (size_t)t * D) + F.lane + 64 * j);
#pragma unroll
            for (int k = 0; k < 4; ++k) { const unsigned char* yr = YK + (size_t)(256 * tb[tw[k] >> 20] + (int)(tw[k] & 0xfffffu)) * D;
#pragma unroll
                for (int j = 0; j < 4; ++j) yw[r][k][j] = *((const int*)yr + F.lane + 64 * j); } }
#pragma unroll
        for (int r = 0; r < 2; ++r) { const int t = t0 + r * NGW; if (t >= T) break;
            f32x4 v[4]; float ss = 0.f;
#pragma unroll
            for (int j = 0; j < 4; ++j) { const v2u w = xw[r][j];
                f32x4 a; a.x = bflo(w.x); a.y = bfhi(w.x); a.z = bflo(w.y); a.w = bfhi(w.y);
#pragma unroll
                for (int k = 0; k < 4; ++k) { const int y = yw[r][k][j]; const float gk = ga[r][k];
                    a.x += gk * __builtin_amdgcn_cvt_f32_fp8(y, 0); a.y += gk * __builtin_amdgcn_cvt_f32_fp8(y, 1); a.z += gk * __builtin_amdgcn_cvt_f32_fp8(y, 2); a.w += gk * __builtin_amdgcn_cvt_f32_fp8(y, 3); }
                v[j] = a; ss += a.x * a.x + a.y * a.y + a.z * a.z + a.w * a.w; }
            const float rs = rsqrtf(wave_sum(ss) * (1.f / D) + EPS);
#pragma unroll
            for (int j = 0; j < 4; ++j) { const f32x4 g = *((const f32x4*)gf + F.lane + 64 * j); *((f32x4*)(out + (size_t)t * D) + F.lane + 64 * j) = v[j] * rs * g; }
        }
    }
}

__global__ void __launch_bounds__(NTHR, 2) hymba_fwd(Args args) {
    extern __shared__ __attribute__((aligned(16))) unsigned char lds[];
    Frame F;
    F.lds = (LAS unsigned char*)lds;
    F.tid = threadIdx.x; F.lane = F.tid & 63; F.wave = __builtin_amdgcn_readfirstlane(F.tid >> 6);
    F.G = gridDim.x; { const int bx = blockIdx.x; F.vcu = (F.G % 8 == 0) ? (bx % 8) * (F.G / 8) + bx / 8 : bx; }
    F.ws = args.ws; F.dout = (unsigned char*)args.out; F.ctl = (unsigned*)(args.ws + WS_CTL);
#pragma unroll
    for (int i = 0; i < 23; ++i) F.in[i] = args.in[i];
    for (int u = F.tid; u < (LDS_BYTES - LDSCTL_OFF) / 4; u += NTHR) ((LAS unsigned*)(F.lds + LDSCTL_OFF))[u] = 0u;
    __syncthreads();
    XcdBarrier bar = xcd_barrier_post(F.ctl + CW_BAR, (volatile LAS unsigned*)(F.lds + MISC_OFF) + 8);

#ifndef PROBE_DUP
#define PROBE_DUP (-1)
#endif
#define RUN_PHASE(n, ...) do { __VA_ARGS__; if (PROBE_DUP == (n)) { xcd_barrier(bar); __VA_ARGS__; } } while (0)
    const LAS int* etb = (const LAS int*)(F.lds + L_ETAB);
    RUN_PHASE(0, p0_prologue(F));
    xcd_barrier(bar);
    RUN_PHASE(1, { DenseSched S; S.ord.init(T / 256, 12, F.G, (int)blockIdx.x); S.A = (const char*)(F.ws + WS_XN); S.Bt = (const char*)(F.ws + WS_WIN); S.K = D;
        EpiProj E{F.ws}; pg8::gemm_phase<EpiProj, DenseSched, true, true>(F.lds, D / 64, D * 2, S, E); });
    xcd_barrier(bar);
    { const float lam = compute_lambda(F);
      p2_attn_setup(F);
#pragma unroll 1
      for (int rep = 0; rep < (PROBE_DUP == 2 ? 2 : 1); ++rep) {
          if (rep) xcd_barrier(bar);
          for (int v = F.vcu; v < 256; v += F.G) { const int bh = v >> 2, ty = v & 3;
              if (ty == 0) p2_mlstm_fast(F, bh);
              const unsigned long long sched = ty == 0 ? 0x012ull : ty == 1 ? 0xDEFull : ty == 2 ? 0x8ABCull : 0x345679ull;
              const int nq = ty == 0 ? 3 : ty == 1 ? 3 : ty == 2 ? 4 : 6;
              const int pa = ty == 0 ? -1 : (v >> 2) * 3 + (ty - 1);
              const int nslot = ty == 2 ? 4 : 3; int slot = 0;
#pragma unroll 1
              for (int i = nq - 1, j = 0; i >= 0; --i, ++j) { const bool has = pa >= 0 && (ty != 3 || (j & 1));
                  p2_attn_unit(F, lds, bh, (int)((sched >> (4 * i)) & 15ull), lam, has ? pa : -1, slot, nslot); if (has) ++slot; }
          }
      }
    }
    xcd_barrier(bar);
    RUN_PHASE(3, { DenseSched S; S.ord.init(T / 256, 4, F.G, (int)blockIdx.x); S.A = (const char*)(F.ws + WS_XN); S.Bt = (const char*)(F.ws + WS_WOUT); S.K = D;
        EpiOutProj E{F.in[I_X], (bf16*)(F.ws + WS_X1B), F.ws + WS_X1F8}; pg8::gemm_phase<EpiOutProj, DenseSched, true, true>(F.lds, D / 64, D * 2, S, E); });
    xcd_barrier(bar);
    p4_route(F);
    xcd_barrier(bar);
    p4b_lists(F);
    xcd_barrier(bar);
    RUN_PHASE(5, { MoeSched8<true> S; S.ord.init(etb[NE], 8, F.G, (int)blockIdx.x); S.tb = etb; S.cn = etb + 40; S.A = (const char*)(F.ws + WS_X1F8); S.W = (const char*)(F.ws + WS_WGU); S.LIST = (const int*)(F.ws + WS_LIST); S.wrows = 2 * DFF;
        EpiGateUp8 E{etb, etb + 40, (const float*)(F.ws + WS_LISTRS), F.in[I_BGU], F.ws + WS_ACT};
        pg8::gemm_phase<EpiGateUp8, MoeSched8<true>, true, true, true, 0x79797979, 0x7f7f7f7f>(F.lds, D / 128, D, S, E); });
    xcd_barrier(bar);
    RUN_PHASE(6, { MoeSched8<false> S; S.ord.init(etb[NE], 4, F.G, (int)blockIdx.x); S.tb = etb; S.cn = etb + 40; S.A = (const char*)(F.ws + WS_ACT); S.W = (const char*)(F.ws + WS_WDOWN); S.LIST = nullptr; S.wrows = D;
        EpiDown E{F.in[I_BDN], F.ws + WS_YK};
        pg8::gemm_phase<EpiDown, MoeSched8<false>, true, true, true, 0x79797979, 0x7f7f7f7f>(F.lds, DFF / 128, DFF, S, E); });
    xcd_barrier(bar);
    RUN_PHASE(7, p7_final(F));
}

extern "C" void kernel_launch(void* const* d_in, const int* in_sizes, int n_in, void* d_out, int out_size, void* d_ws, size_t ws_size, hipStream_t stream) {
    static int grid = 0;
    if (grid == 0) {
        if (n_in != 23 || in_sizes[0] != T * D || out_size != T * D || ws_size < WS_END) { fprintf(stderr, "kernel_launch: unexpected shapes (n_in %d, in0 %d, out %d, ws %zu); nothing launched\n", n_in, n_in > 0 ? in_sizes[0] : -1, out_size, ws_size); grid = -1; return; }
        int dev = 0, cus = 0, per_cu = 0;
        if (hipGetDevice(&dev) != hipSuccess || hipDeviceGetAttribute(&cus, hipDeviceAttributeMultiprocessorCount, dev) != hipSuccess) { grid = -1; return; }
        if (hipFuncSetAttribute((const void*)hymba_fwd, hipFuncAttributeMaxDynamicSharedMemorySize, LDS_BYTES) != hipSuccess) { fprintf(stderr, "kernel_launch: hipFuncSetAttribute failed\n"); grid = -1; return; }
        if (hipOccupancyMaxActiveBlocksPerMultiprocessor(&per_cu, (const void*)hymba_fwd, NTHR, LDS_BYTES) != hipSuccess || per_cu < 1) fprintf(stderr, "kernel_launch: occupancy query reports %d\n", per_cu);
        (void)hipGetLastError();
        grid = cus;
    }
    if (grid < 0) return;
    if (hipMemsetAsync((char*)d_ws + WS_CTL, 0, CTL_ZERO_BYTES, stream) != hipSuccess) return;
    Args a{};
    for (int i = 0; i < 23; ++i) a.in[i] = (const float*)d_in[i];
    a.out = (float*)d_out; a.ws = (unsigned char*)d_ws;
    hipLaunchKernelGGL(hymba_fwd, dim3(grid), dim3(NTHR), LDS_BYTES, stream, a);
}
```

```cpp
#include <hip/hip_runtime.h>
#include <cstdio>
#include <cstdint>

#define GAS __attribute__((address_space(1)))
#define LAS __attribute__((address_space(3)))
typedef unsigned short bf16;
typedef unsigned v4u __attribute__((ext_vector_type(4)));
typedef unsigned v2u __attribute__((ext_vector_type(2)));
typedef float f32x4 __attribute__((ext_vector_type(4)));
typedef short bf16x8 __attribute__((ext_vector_type(8)));
#define RLX_AGENT __ATOMIC_RELAXED, __HIP_MEMORY_SCOPE_AGENT
#define LDS_WAIT() asm volatile("s_waitcnt lgkmcnt(0)" ::: "memory")
#define VM_WAIT() asm volatile("s_waitcnt vmcnt(0)" ::: "memory")

constexpr int NWAVES = 8, NTHR = 512;
constexpr int NB = 16, SEQ = 4096, T = NB * SEQ, D = 1024, INC = 3080;
constexpr int NE = 32, DFF = 1024;
constexpr float EPS = 1e-5f, LOG2E = 1.4426950408889634f, C2 = 0.125f * LOG2E;
constexpr float LAM_INIT = 0.2f;
constexpr int NR_MAX = 270336;

constexpr size_t MiB = 1u << 20;
constexpr size_t WS_CTL = 0, CTL_ZERO_BYTES = 1 * MiB;
constexpr size_t WS_GATES = 1 * MiB;
constexpr size_t WS_RSTD2 = 3 * MiB;
constexpr size_t WS_HIST = 3 * MiB + 512 * 1024;
constexpr size_t WS_TOKINFO = 4 * MiB;
constexpr size_t WS_GATE = 5 * MiB;
constexpr size_t WS_LIST = 6 * MiB;
constexpr size_t WS_WDOWN = 16 * MiB;
constexpr size_t WS_X1B = 80 * MiB;
constexpr size_t WS_ACT = 208 * MiB;
constexpr size_t WS_YK = 480 * MiB;
constexpr size_t WS_WGU = 480 * MiB;
constexpr size_t WS_X1F8 = 744 * MiB;
constexpr size_t WS_WIN = 608 * MiB;
constexpr size_t WS_WOUT = 614 * MiB;
constexpr size_t WS_XN = 616 * MiB;
constexpr size_t WS_LISTRS = 1008 * MiB;
constexpr size_t WS_END = 1024 * MiB;
__host__ __device__ constexpr size_t proj_off(int buf) { return buf < 2 ? (208 + 64 * (size_t)buf) * MiB : (744 + 64 * (size_t)(buf - 2)) * MiB; }
constexpr size_t DO_OTMP = 128 * MiB;

constexpr int CW_TMO = 0;
constexpr int CW_BAR = 4096;
constexpr int CW_Q = 12288;
constexpr int CW_CNT = 8192;

constexpr int RING_BYTES = 131072;
constexpr int LDSCTL_OFF = RING_BYTES;
constexpr int L_HIST = LDSCTL_OFF, L_BASE = LDSCTL_OFF + 128, MISC_OFF = LDSCTL_OFF + 320, L_ETAB = LDSCTL_OFF + 512;
constexpr int LDS_BYTES = 147456;

__device__ __forceinline__ unsigned f2bf(float f) { unsigned u = __builtin_bit_cast(unsigned, f); return (u + 0x7fffu + ((u >> 16) & 1u)) >> 16; }
__device__ __forceinline__ unsigned pk2(float lo, float hi) { return f2bf(lo) | (f2bf(hi) << 16); }
typedef float f32x2_t __attribute__((ext_vector_type(2))); typedef __bf16 bf16x2_t __attribute__((ext_vector_type(2)));
__device__ __forceinline__ unsigned pkh(float lo, float hi) { f32x2_t v = {lo, hi}; bf16x2_t b = __builtin_convertvector(v, bf16x2_t); return __builtin_bit_cast(unsigned, b); }
__device__ __forceinline__ unsigned pk4_fp8(float a, float b, float c, float d) { int r = __builtin_amdgcn_cvt_pk_fp8_f32(a, b, 0, false); r = __builtin_amdgcn_cvt_pk_fp8_f32(c, d, r, true); return (unsigned)r; }
__device__ __forceinline__ float bflo(unsigned u) { return __uint_as_float(u << 16); }
__device__ __forceinline__ float bfhi(unsigned u) { return __uint_as_float(u & 0xffff0000u); }
__device__ __forceinline__ float bf2f(bf16 b) { return __uint_as_float((unsigned)b << 16); }
__device__ __forceinline__ float wave_sum(float v) {
#pragma unroll
    for (int o = 1; o < 64; o <<= 1) v += __shfl_xor(v, o);
    return v;
}
__device__ __forceinline__ float sigmoidf_(float x) { return 1.f / (1.f + __expf(-x)); }

#define XB_TMO      128
#define XB_XCNT(j)  (256  + 64 * (j))
#define XB_XSUB(j)  (1280 + 64 * (j))
#define XB_XGEN(j)  (2304 + 64 * (j))
#define XB_TOP      3328
#define XB_TOPGEN   3392
#define XCD_BAR_WORDS 3456
#define XB_SPIN_CAP (1u << 18)
__device__ __forceinline__ unsigned xb_ld(unsigned* p)              { return __hip_atomic_load(p, __ATOMIC_RELAXED, __HIP_MEMORY_SCOPE_AGENT); }
__device__ __forceinline__ unsigned xb_add(unsigned* p, unsigned v) { return __hip_atomic_fetch_add(p, v, __ATOMIC_RELAXED, __HIP_MEMORY_SCOPE_AGENT); }
__device__ __forceinline__ unsigned xb_xcc_id() { return (unsigned)__builtin_amdgcn_s_getreg((3 << 11) | 20) & 0xFu; }
#define XB_SPIN(cond, bar) do { unsigned _sp = 0; while (cond) { __builtin_amdgcn_s_sleep(1); \
    if ((++_sp & 255u) == 0u) { if (xb_ld(&(bar)[XB_TMO])) break; if (_sp > XB_SPIN_CAP) { atomicAdd(&(bar)[XB_TMO], 1u); break; } } } } while (0)
struct XcdBarrier { unsigned* bar; unsigned x; volatile LAS unsigned* st; };
__device__ __forceinline__ XcdBarrier xcd_barrier_post(unsigned* bar, volatile LAS unsigned* st) {
    XcdBarrier b; b.bar = bar; b.x = xb_xcc_id(); b.st = st;
    if (threadIdx.x == 0) (void)xb_add(&bar[XB_XCNT(b.x)], 1u);
    return b;
}
__device__ __forceinline__ void xcd_barrier_complete(unsigned* bar, unsigned x, unsigned& nloc, unsigned& nx) {
    const unsigned G = gridDim.x * gridDim.y * gridDim.z;
    unsigned sum, cnt, mine, sp = 0u;
    for (;;) {
        sum = 0u; cnt = 0u; mine = 0u;
#pragma unroll
        for (unsigned j = 0; j < 16; ++j) { const unsigned c = xb_ld(&bar[XB_XCNT(j)]); sum += c; cnt += (c > 0u) ? 1u : 0u; mine = (j == x) ? c : mine; }
        if (sum == G) break;
        __builtin_amdgcn_s_sleep(1);
        if ((++sp & 255u) == 0u) { if (xb_ld(&bar[XB_TMO])) break; if (sp > XB_SPIN_CAP) { atomicAdd(&bar[XB_TMO], 1u); break; } }
    }
    nloc = mine > 0u ? mine : 1u; nx = cnt > 0u ? cnt : 1u;
}
__device__ __forceinline__ void xcd_barrier(const XcdBarrier& b) {
    asm volatile("s_waitcnt vmcnt(0)" ::: "memory");
    __syncthreads();
    if (threadIdx.x == 0) {
        unsigned* bar = b.bar;
        __builtin_amdgcn_s_waitcnt(0);
        unsigned nloc = b.st[0], nx = b.st[1];
        if (nloc == 0u) { xcd_barrier_complete(bar, b.x, nloc, nx); b.st[0] = nloc; b.st[1] = nx; }
        const unsigned old = xb_add(&bar[XB_XSUB(b.x)], 1u);
        const unsigned gen = old / nloc;
        if (old + 1u == (gen + 1u) * nloc) {
            __builtin_amdgcn_fence(__ATOMIC_RELEASE, "agent");
            asm volatile("s_waitcnt vmcnt(0)" ::: "memory");
            const unsigned og = xb_add(&bar[XB_TOP], 1u);
            const unsigned tg = og / nx;
            if (og + 1u == (tg + 1u) * nx) xb_add(&bar[XB_TOPGEN], 1u);
            else XB_SPIN(xb_ld(&bar[XB_TOPGEN]) == tg, bar);
            __builtin_amdgcn_fence(__ATOMIC_ACQUIRE, "agent");
            xb_add(&bar[XB_XGEN(b.x)], 1u);
            asm volatile("s_waitcnt vmcnt(0)" ::: "memory");
        } else {
            XB_SPIN(xb_ld(&bar[XB_XGEN(b.x)]) == gen, bar);
            __builtin_amdgcn_fence(__ATOMIC_ACQUIRE, "agent");
            asm volatile("s_waitcnt vmcnt(0)" ::: "memory");
        }
    }
    __syncthreads();
}

struct Args { const float* in[23]; float* out; unsigned char* ws; };
struct Frame {
    LAS unsigned char* lds;
    unsigned* ctl;
    int tid, lane, wave, G, vcu;
    const float* in[23];
    unsigned char* ws; unsigned char* dout;
};
enum { I_X = 0, I_G1, I_WIN, I_REL, I_LQ1, I_LK1, I_LQ2, I_LK2, I_DNG, I_CONVW, I_CONVB, I_GATEB, I_OB, I_MLG, I_WOUT, I_G2, I_RW, I_RB, I_WGU, I_BGU, I_WDN, I_BDN, I_GF };

__device__ __forceinline__ bf16* proj_buf(const Frame& F, int b) { return (bf16*)(F.ws + proj_off(b)); }

__device__ __forceinline__ void tr_item(const float* W, int ldw, int k0, int n0, bf16* WT, int K, int r0, const float* gk, LAS float* scr, int lane) {
#pragma unroll 8
    for (int i = 0; i < 32; ++i) { const int kk = 2 * i + (lane >> 5); scr[kk * 33 + (lane & 31)] = W[(size_t)(k0 + kk) * ldw + n0 + (lane & 31)]; }
    LDS_WAIT(); asm volatile("" ::: "memory");
    const int c = lane & 7;
    float gv[8];
#pragma unroll
    for (int i = 0; i < 8; ++i) gv[i] = gk ? gk[k0 + 8 * c + i] : 1.f;
#pragma unroll
    for (int j = 0; j < 4; ++j) { const int n = (lane >> 3) + 8 * j; const LAS float* s = scr + (8 * c) * 33 + n;
        v4u o; o.x = pk2(s[0 * 33] * gv[0], s[1 * 33] * gv[1]); o.y = pk2(s[2 * 33] * gv[2], s[3 * 33] * gv[3]); o.z = pk2(s[4 * 33] * gv[4], s[5 * 33] * gv[5]); o.w = pk2(s[6 * 33] * gv[6], s[7 * 33] * gv[7]);
        *(v4u*)(WT + (size_t)(r0 + n) * K + k0 + 8 * c) = o; }
    LDS_WAIT(); asm volatile("" ::: "memory");
}

__device__ __forceinline__ void tr_item8(const float* W, int ldw, int k0, int n0, unsigned char* WT, int K, int r0, const float* gk, float wscale, LAS float* scr, int lane) {
#pragma unroll 8
    for (int i = 0; i < 32; ++i) { const int kk = 2 * i + (lane >> 5); scr[kk * 33 + (lane & 31)] = W[(size_t)(k0 + kk) * ldw + n0 + (lane & 31)]; }
    LDS_WAIT(); asm volatile("" ::: "memory");
    const int c = lane & 7;
    float gv[8];
#pragma unroll
    for (int i = 0; i < 8; ++i) gv[i] = (gk ? gk[k0 + 8 * c + i] : 1.f) * wscale;
#pragma unroll
    for (int j = 0; j < 4; ++j) { const int n = (lane >> 3) + 8 * j; const LAS float* sp = scr + (8 * c) * 33 + n;
        v2u o; o.x = pk4_fp8(sp[0 * 33] * gv[0], sp[1 * 33] * gv[1], sp[2 * 33] * gv[2], sp[3 * 33] * gv[3]); o.y = pk4_fp8(sp[4 * 33] * gv[4], sp[5 * 33] * gv[5], sp[6 * 33] * gv[6], sp[7 * 33] * gv[7]);
        *(v2u*)(WT + (size_t)(r0 + n) * K + k0 + 8 * c) = o; }
    LDS_WAIT(); asm volatile("" ::: "memory");
}

__device__ __forceinline__ float log_sigmoid(float x) { return fminf(x, 0.f) - log1pf(__expf(-fabsf(x))); }

__device__ __forceinline__ void p0_prologue(Frame& F_) {
    Frame F = F_; { int t_ = F.tid; asm volatile("" : "+v"(t_)); F.tid = t_; F.lane = t_ & 63; }
    LAS float* scr = (LAS float*)(F.lds + F.wave * 8704);
    const int gw = F.vcu * NWAVES + F.wave, NGW = F.G * NWAVES;
    constexpr int I_IN = 16 * 96, I_OUT = 16 * 32;
    constexpr int NITEMS = I_IN + I_OUT;
    for (int it = gw; it < NITEMS; it += NGW) {
        int r = it;
        if (r < I_IN) { const int kb = r / 96, nb = r % 96; tr_item(F.in[I_WIN], INC, 64 * kb, 32 * nb, (bf16*)(F.ws + WS_WIN), D, 32 * nb, nullptr, scr, F.lane); continue; } r -= I_IN;
        { const int kb = r / 32, nb = r % 32; tr_item(F.in[I_WOUT], D, 64 * kb, 32 * nb, (bf16*)(F.ws + WS_WOUT), D, 32 * nb, nullptr, scr, F.lane); }
    }
    __syncthreads();
    LAS float* wg = (LAS float*)F.lds;
    for (int i = F.tid; i < D * 8; i += NTHR) wg[(i & 7) * D + (i >> 3)] = F.in[I_WIN][(size_t)(i >> 3) * INC + 3072 + (i & 7)];
    __syncthreads();
    const float* x = F.in[I_X]; const float* g1 = F.in[I_G1]; const float* gb = F.in[I_GATEB];
    bf16* XN = (bf16*)(F.ws + WS_XN); float* GT = (float*)(F.ws + WS_GATES);
    f32x4 gn[4];
#pragma unroll
    for (int j = 0; j < 4; ++j) gn[j] = *((const f32x4*)g1 + F.lane + 64 * j);
    constexpr int RPS = 4;
    for (int m0 = gw; m0 < T; m0 += RPS * NGW) {
        f32x4 v[RPS][4]; float s[RPS];
#pragma unroll
        for (int r = 0; r < RPS; ++r) { const int mm = m0 + r * NGW; const int m = mm < T ? mm : m0; const f32x4* xr = (const f32x4*)(x + (size_t)m * D) + F.lane;
#pragma unroll
            for (int j = 0; j < 4; ++j) v[r][j] = xr[64 * j]; }
#pragma unroll
        for (int r = 0; r < RPS; ++r) { s[r] = 0.f;
#pragma unroll
            for (int j = 0; j < 4; ++j) s[r] += (v[r][j].x * v[r][j].x + v[r][j].y * v[r][j].y) + (v[r][j].z * v[r][j].z + v[r][j].w * v[r][j].w); }
#pragma unroll
        for (int r = 0; r < RPS; ++r) s[r] = wave_sum(s[r]);
#pragma unroll
        for (int r = 0; r < RPS; ++r) { const int m = m0 + r * NGW; if (m >= T) break;
            const float rstd = rsqrtf(s[r] * (1.f / D) + EPS);
            float ga[8];
#pragma unroll
            for (int i = 0; i < 8; ++i) ga[i] = 0.f;
            unsigned long long* o8 = (unsigned long long*)(XN + (size_t)m * D) + F.lane;
#pragma unroll
            for (int j = 0; j < 4; ++j) {
                const f32x4 h = v[r][j] * rstd * gn[j];
                o8[64 * j] = (unsigned long long)pkh(h.x, h.y) | ((unsigned long long)pkh(h.z, h.w) << 32);
#pragma unroll
                for (int gi = 0; gi < 8; ++gi) { const f32x4 w = *(const LAS f32x4*)(wg + gi * D + 256 * j + 4 * F.lane); ga[gi] += (h.x * w.x + h.y * w.y) + (h.z * w.z + h.w * w.w); }
            }
#pragma unroll
            for (int i = 0; i < 4; ++i) { const bool up = (F.lane & 32) != 0; const float send = up ? ga[i] : ga[4 + i], keep = up ? ga[4 + i] : ga[i]; ga[i] = keep + __shfl_xor(send, 32); }
#pragma unroll
            for (int i = 0; i < 2; ++i) { const bool up = (F.lane & 16) != 0; const float send = up ? ga[i] : ga[2 + i], keep = up ? ga[2 + i] : ga[i]; ga[i] = keep + __shfl_xor(send, 16); }
            { const bool up = (F.lane & 8) != 0; const float send = up ? ga[0] : ga[1], keep = up ? ga[1] : ga[0]; ga[0] = keep + __shfl_xor(send, 8); }
            ga[0] += __shfl_xor(ga[0], 4); ga[0] += __shfl_xor(ga[0], 2); ga[0] += __shfl_xor(ga[0], 1);
            { const int gi = (F.lane >> 3) & 7; const float vv = ga[0] + gb[gi];
              if ((F.lane & 7) == 0) GT[(size_t)m * 8 + gi] = gi < 4 ? vv : log_sigmoid(vv); }
        }
    }
}


namespace pg8 {
#define PG8_LAS __attribute__((address_space(3)))
constexpr int BM = 256, BK = 64, HALF = 128, HTB = HALF * BK * 2, STAGE_BYTES = 8 * HTB, NXCD = 8, WGM = 8;
__host__ __device__ __forceinline__ int lds_byte(int r, int c) { const int st = (r >> 4) * 2 + (c >> 5), rr = r & 15, cc = c & 31, ob = rr * 64 + cc * 2; return st * 1024 + (ob ^ (((ob >> 9) & 1) << 5)); }
__host__ __device__ __forceinline__ void stage_rc(int b, int& R, int& C) { const int st = b / 1024, sb = b % 1024, swz = sb ^ (((sb >> 9) & 1) << 5); R = (st >> 1) * 16 + swz / 64; C = (st & 1) * 32 + (swz % 64) / 2; }
__host__ __device__ __forceinline__ int perm32(int rho) { const int n = rho >> 4, i = rho & 15; return 8 * (i >> 2) + 4 * n + (i & 3); }
struct Unit { int pm, pn, e; };
struct TileOrder {
    int nM, nN, nwg, G, c;
    __device__ void init(int nM_, int nN_, int G_, int c_) { nM = nM_; nN = nN_; nwg = nM * nN; G = G_; c = c_; }
    __device__ bool next_tile(int i, int& pm, int& pn) const {
        const long L = (long)i * G + c; if (L >= nwg) return false;
        int wgid = (int)L; { const int q = nwg / NXCD, r = nwg % NXCD, xcd = wgid % NXCD, off = wgid / NXCD; wgid = (xcd < r ? xcd * (q + 1) : r * (q + 1) + (xcd - r) * q) + off; }
        const int nig = WGM * nN, gid = wgid / nig, fm = gid * WGM, gsz = (nM - fm) < WGM ? (nM - fm) : WGM;
        pm = fm + ((wgid % nig) % gsz); pn = (wgid % nig) / gsz; return true;
    }
};
__device__ __forceinline__ unsigned cvt_pk_bf16(float lo, float hi) { unsigned r; asm volatile("v_cvt_pk_bf16_f32 %0, %1, %2" : "=v"(r) : "v"(lo), "v"(hi)); return r; }

typedef int v8i_t __attribute__((ext_vector_type(8))); typedef int v4i_t __attribute__((ext_vector_type(4)));
template <class Epi, class Sched, bool ALIGN_EPI, bool SP2, bool F8 = false, int SCA = 0x7f7f7f7f, int SCB = 0x7f7f7f7f>
__device__ __forceinline__ void gemm_phase(PG8_LAS unsigned char* lds, const int nt, const int pitchB, const Sched& S, const Epi& E) {
    static_assert(SP2, "only the SP2 loop is carried here");
    int tid = threadIdx.x; asm volatile("" : "+v"(tid));
    const int wid = __builtin_amdgcn_readfirstlane(tid >> 6), lane = tid & 63, wr = wid >> 2, wc = wid & 3, fr = lane & 15, fq = lane >> 4;
    int RA[2], CA[2]; unsigned voffB[2];
#pragma unroll
    for (int i = 0; i < 2; ++i) { int R, C; stage_rc(tid * 16 + i * 8192, R, C); RA[i] = R; CA[i] = C; const int Rb = (R & ~31) + perm32(R & 31); voffB[i] = (unsigned)(Rb * pitchB + C * 2); }
    const size_t kstep = (size_t)(BK * 2);
    const size_t hstep = (size_t)HALF * pitchB;
    const unsigned ldsw = (unsigned)wid * 1024u;
    const int aoff = lds_byte(wr * 64 + fr, fq * 8), boff = lds_byte(wc * 32 + fr, fq * 8);
#define PG8_SA(b, h) (((b) * 2 + (h)) * HTB)
#define PG8_SB(b, h) ((4 + (b) * 2 + (h)) * HTB)
#define PG8_STAGE(bufoff, gbase, voff) do { _Pragma("unroll") for (int _i = 0; _i < 2; ++_i) \
        __builtin_amdgcn_global_load_lds((const unsigned*)((const char*)(gbase) + (voff)[_i]), (PG8_LAS unsigned*)(lds + (bufoff) + ldsw + _i * 8192), 16, 0, 0); } while (0)
#define PG8_LDA(dst, b, h) do { if constexpr (F8) { _Pragma("unroll") for (int m = 0; m < 4; ++m) { dst##8[m].lo = *(const PG8_LAS v4i_t*)(lds + PG8_SA(b, h) + aoff + m * 2048); dst##8[m].hi = *(const PG8_LAS v4i_t*)(lds + PG8_SA(b, h) + aoff + m * 2048 + 1024); } } \
        else { _Pragma("unroll") for (int m = 0; m < 4; ++m) _Pragma("unroll") for (int k = 0; k < 2; ++k) dst[m][k] = *(const PG8_LAS bf16x8*)(lds + PG8_SA(b, h) + aoff + m * 2048 + k * 1024); } } while (0)
#define PG8_LDB(dst, b, h) do { if constexpr (F8) { _Pragma("unroll") for (int n = 0; n < 2; ++n) { dst##8[n].lo = *(const PG8_LAS v4i_t*)(lds + PG8_SB(b, h) + boff + n * 2048); dst##8[n].hi = *(const PG8_LAS v4i_t*)(lds + PG8_SB(b, h) + boff + n * 2048 + 1024); } } \
        else { _Pragma("unroll") for (int n = 0; n < 2; ++n) _Pragma("unroll") for (int k = 0; k < 2; ++k) dst[n][k] = *(const PG8_LAS bf16x8*)(lds + PG8_SB(b, h) + boff + n * 2048 + k * 1024); } } while (0)
#define PG8_MMA(ai, bj, At, Bt) do { __builtin_amdgcn_s_setprio(1); _Pragma("unroll") for (int m = 0; m < 4; ++m) _Pragma("unroll") for (int n = 0; n < 2; ++n) { \
        if constexpr (F8) asm volatile("v_mfma_scale_f32_16x16x128_f8f6f4 %0, %1, %2, %0, %3, %4 op_sel_hi:[0,0,0]" : "+v"(acc[ai][bj][m][n]) : "v"(Bt##8[n]), "v"(At##8[m]), "v"(sca_), "v"(scb_));   \
        else { _Pragma("unroll") for (int k = 0; k < 2; ++k) acc[ai][bj][m][n] = __builtin_amdgcn_mfma_f32_16x16x32_bf16(Bt[n][k], At[m][k], acc[ai][bj][m][n], 0, 0, 0); } } \
        __builtin_amdgcn_s_setprio(0); } while (0)
#define PG8_WAIT_V(n) asm volatile("s_waitcnt vmcnt(" #n ")" ::: "memory")
#define PG8_WAIT_L(n) asm volatile("s_waitcnt lgkmcnt(" #n ")" ::: "memory")
#define PG8_BAR __builtin_amdgcn_s_barrier()
#define PG8_SCHED __builtin_amdgcn_sched_barrier(0)
    Unit cur, nxt; int ui = 0;
    if (!S.next(0, cur)) return;
    f32x4 acc[2][2][4][2];
#pragma unroll
    for (int a = 0; a < 2; ++a)
#pragma unroll
        for (int b = 0; b < 2; ++b)
#pragma unroll
            for (int m = 0; m < 4; ++m)
#pragma unroll
                for (int n = 0; n < 2; ++n) acc[a][b][m][n] = (f32x4){0.f, 0.f, 0.f, 0.f};
    const int sca_ = SCA, scb_ = SCB;
    bf16x8 At[4][2], B0[2][2], B1[2][2];
    v8i_t At8[4], B08[2], B18[2];
    const char* cA; unsigned cAo[2][2]; S.a_view(cur, RA, CA, cA, cAo);
    const char* cB = S.b_base(cur);
    PG8_STAGE(PG8_SB(0, 0), cB, voffB); PG8_STAGE(PG8_SB(0, 1), cB + hstep, voffB); PG8_STAGE(PG8_SA(0, 0), cA, cAo[0]); PG8_STAGE(PG8_SA(0, 1), cA, cAo[1]);
    if (wr == 1) PG8_BAR;
    PG8_WAIT_V(2); PG8_BAR;
    PG8_STAGE(PG8_SB(1, 0), cB + kstep, voffB); PG8_STAGE(PG8_SA(1, 0), cA + kstep, cAo[0]); PG8_STAGE(PG8_SB(1, 1), cB + hstep + kstep, voffB);
    PG8_WAIT_V(6); PG8_BAR;
    for (;;) {
        const bool has_next = S.next(ui + 1, nxt);
        const char* nA = cA; const char* nB = cB; unsigned nAo[2][2];
#pragma unroll
        for (int h = 0; h < 2; ++h)
#pragma unroll
            for (int i = 0; i < 2; ++i) nAo[h][i] = cAo[h][i];
        unsigned pre[2][2] = {{0u, 0u}, {0u, 0u}};
        if (has_next) { S.a_pre(nxt, RA, pre); nB = S.b_base(nxt); }
        for (int t = 0; t < nt; t += 2) {
            const bool last = (t == nt - 2);
            if (last && has_next) S.a_post(nxt, pre, RA, CA, nA, nAo);
            const char* a1 = cA + (size_t)(t + 1) * kstep;
            const char* a2 = last ? nA : cA + (size_t)(t + 2) * kstep; const char* b2 = last ? nB : cB + (size_t)(t + 2) * kstep;
            const char* a3 = a2 + kstep; const char* b3 = b2 + kstep;
            unsigned o2[2][2];
#pragma unroll
            for (int h = 0; h < 2; ++h)
#pragma unroll
                for (int i = 0; i < 2; ++i) o2[h][i] = last ? nAo[h][i] : cAo[h][i];
            PG8_LDB(B0, 0, 0); PG8_LDB(B1, 0, 1); PG8_SCHED; PG8_LDA(At, 0, 0); PG8_STAGE(PG8_SA(1, 1), a1, cAo[1]);
            PG8_WAIT_V(8); PG8_WAIT_L(0); PG8_BAR; PG8_MMA(0, 0, At, B0); PG8_MMA(0, 1, At, B1); PG8_BAR; PG8_SCHED;
            PG8_LDA(At, 0, 1); PG8_STAGE(PG8_SB(0, 0), b2, voffB); PG8_STAGE(PG8_SB(0, 1), b2 + hstep, voffB); PG8_STAGE(PG8_SA(0, 0), a2, o2[0]);
            PG8_WAIT_V(8); PG8_WAIT_L(0); PG8_BAR; PG8_MMA(1, 0, At, B0); PG8_MMA(1, 1, At, B1); PG8_BAR; PG8_SCHED;
            PG8_LDB(B0, 1, 0); PG8_LDB(B1, 1, 1); PG8_SCHED; PG8_LDA(At, 1, 0); PG8_STAGE(PG8_SA(0, 1), a2, o2[1]);
            PG8_WAIT_V(8); PG8_WAIT_L(0); PG8_BAR; PG8_MMA(0, 0, At, B0); PG8_MMA(0, 1, At, B1); PG8_BAR; PG8_SCHED;
            PG8_LDA(At, 1, 1); PG8_STAGE(PG8_SB(1, 0), b3, voffB); PG8_STAGE(PG8_SB(1, 1), b3 + hstep, voffB); PG8_STAGE(PG8_SA(1, 0), a3, o2[0]);
            PG8_WAIT_V(8); PG8_WAIT_L(0); PG8_BAR; PG8_MMA(1, 0, At, B0); PG8_MMA(1, 1, At, B1); PG8_BAR; PG8_SCHED;
        }
        if constexpr (ALIGN_EPI) { if (wr == 0) PG8_BAR; }
        if constexpr (F8) asm volatile("s_nop 15\n\ts_nop 7" ::: "memory");
        E(acc, cur, wr, wc, fr, fq);
        if (!has_next) break;
#pragma unroll
        for (int a = 0; a < 2; ++a)
#pragma unroll
            for (int b = 0; b < 2; ++b)
#pragma unroll
                for (int m = 0; m < 4; ++m)
#pragma unroll
                    for (int n = 0; n < 2; ++n) acc[a][b][m][n] = (f32x4){0.f, 0.f, 0.f, 0.f};
        cur = nxt; cA = nA; cB = nB; ++ui;
#pragma unroll
        for (int h = 0; h < 2; ++h)
#pragma unroll
            for (int i = 0; i < 2; ++i) cAo[h][i] = nAo[h][i];
        if constexpr (ALIGN_EPI) { if (wr == 1) PG8_BAR; }
    }
    PG8_WAIT_V(0);
    if constexpr (!ALIGN_EPI) { if (wr == 0) PG8_BAR; }
    PG8_BAR;
#undef PG8_SA
#undef PG8_SB
#undef PG8_STAGE
#undef PG8_LDA
#undef PG8_LDB
#undef PG8_MMA
#undef PG8_WAIT_V
#undef PG8_WAIT_L
#undef PG8_BAR
#undef PG8_SCHED
}
}

__device__ const unsigned char T5_BUCKET[128] = {0, 1, 2, 3, 4, 5, 6, 7, 8, 9, 10, 11, 12, 13, 14, 15, 16, 16, 16, 17, 17, 18, 18, 18, 19, 19, 19, 20, 20, 20, 20, 21, 21, 21, 21, 22, 22, 22, 22, 22, 23, 23, 23, 23, 23, 23, 24, 24, 24, 24, 24, 24, 25, 25, 25, 25, 25, 25, 25, 26, 26, 26, 26, 26, 26, 26, 26, 27, 27, 27, 27, 27, 27, 27, 27, 27, 27, 28, 28, 28, 28, 28, 28, 28, 28, 28, 28, 29, 29, 29, 29, 29, 29, 29, 29, 29, 29, 29, 29, 30, 30, 30, 30, 30, 30, 30, 30, 30, 30, 30, 30, 30, 30, 31, 31, 31, 31, 31, 31, 31, 31, 31, 31, 31, 31, 31, 31, 31};

__device__ __forceinline__ float compute_lambda(const Frame& F) {
    float s1 = 0.f, s2 = 0.f;
    for (int i = 0; i < 64; ++i) { s1 += F.in[I_LQ1][i] * F.in[I_LK1][i]; s2 += F.in[I_LQ2][i] * F.in[I_LK2][i]; }
    return __expf(s1) - __expf(s2) + LAM_INIT;
}

namespace attn_body {
using bf16=unsigned short;
using bf16x8=__attribute__((ext_vector_type(8)))short;
using s16x4=__attribute__((ext_vector_type(4)))short;
using f32x16=__attribute__((ext_vector_type(16)))float;
using u32x4=__attribute__((ext_vector_type(4)))unsigned;
constexpr int SEQ=4096,D=64,DM=512,OP=1024;
constexpr int NW=8,QBLK=32,QB=QBLK*NW,KVBLK=64,NQB=SEQ/QB;
__device__ __forceinline__ int crow(int r,int hi){return (r&3)+8*(r>>2)+4*hi;}
#define SBAR() __builtin_amdgcn_sched_barrier(0)
__device__ __forceinline__ void cmask(f32x16&p0,f32x16&p1,int jb,int qrel,int hi){
  const float NEG=-INFINITY; int kb=64*jb+4*hi;
  #pragma unroll
  for(int r=0;r<16;++r){int kv=kb+(r&3)+8*(r>>2); if(kv>qrel)p0[r]=NEG; if(kv+32>qrel)p1[r]=NEG;}
}

typedef __attribute__((address_space(3))) const float* lds_cfptr;
__device__ __forceinline__ void bcorr(f32x16&p0,f32x16&p1,int jb,int qrel,int hi,lds_cfptr dtab){
  lds_cfptr tp=dtab+(qrel+256-64*jb-4*hi-59);
  #pragma unroll
  for(int r=0;r<16;++r){const int c=(r&3)+8*(r>>2); p0[r]+=tp[59-c]; p1[r]+=tp[27-c];}
}
constexpr int NSLOT=3, SLOTB=8192;
constexpr int LDS_K=0, LDS_V=NSLOT*SLOTB, LDS_WS=2*NSLOT*SLOTB, LDS_OST=LDS_WS+NW*64*4, LDS_BYTES=LDS_OST+NW*4096;
__device__ __forceinline__ void glds16(const void*gsrc,unsigned lds_dst){unsigned keep;
  asm volatile("s_mov_b32 %0, m0\n\ts_mov_b32 m0, %2\n\ts_nop 0\n\tglobal_load_lds_dwordx4 %1, off\n\ts_mov_b32 m0, %0":"=&s"(keep):"v"(gsrc),"s"(lds_dst):"memory");}
__device__ __forceinline__ float max3f(float a,float b,float c){float r;asm("v_max3_f32 %0, %1, %2, %3":"=v"(r):"v"(a),"v"(b),"v"(c));return r;}
__device__ __forceinline__ float max2f(float a,float b){float r;asm("v_max_f32_e32 %0, %1, %2":"=v"(r):"v"(a),"v"(b));return r;}
__device__ __forceinline__ float fadd_s(float a,float b){float r;asm("v_add_f32_e32 %0, %1, %2":"=v"(r):"v"(a),"v"(b));return r;}
__device__ __forceinline__ float fsub_s(float a,float b){float r;asm("v_sub_f32_e32 %0, %1, %2":"=v"(r):"v"(a),"v"(b));return r;}
typedef float f32x2_t __attribute__((ext_vector_type(2))); typedef __bf16 bf16x2_t __attribute__((ext_vector_type(2)));
__device__ __forceinline__ unsigned cvtpk_s(float lo,float hi){f32x2_t v={lo,hi};bf16x2_t b=__builtin_convertvector(v,bf16x2_t);return __builtin_bit_cast(unsigned,b);}
#define WAIT_BAR(N) asm volatile("s_waitcnt vmcnt(" #N ") lgkmcnt(0)\n\ts_barrier":::"memory")

__device__ __forceinline__ void qkt(f32x16&p0,f32x16&p1,const char*Kslot,const bf16x8*qr,const f32x16&negm,int r32,int hi){
  const char*kb=Kslot+hi*1024+r32*16;
  #pragma unroll
  for(int d0=0;d0<4;++d0){
    const bf16x8 b0=*reinterpret_cast<const bf16x8*>(kb+d0*2048);
    const bf16x8 b1=*reinterpret_cast<const bf16x8*>(kb+d0*2048+512);
    if(d0==0){p0=__builtin_amdgcn_mfma_f32_32x32x16_bf16(b0,qr[0],negm,0,0,0);p1=__builtin_amdgcn_mfma_f32_32x32x16_bf16(b1,qr[0],negm,0,0,0);}
    else{p0=__builtin_amdgcn_mfma_f32_32x32x16_bf16(b0,qr[d0],p0,0,0,0);p1=__builtin_amdgcn_mfma_f32_32x32x16_bf16(b1,qr[d0],p1,0,0,0);}}
}
typedef __attribute__((address_space(3))) const char* lds_cptr;
typedef short v4i16_t __attribute__((ext_vector_type(4)));
__device__ __forceinline__ void kload8(bf16x8*kf,lds_cptr kp){
  kf[0]=*(const __attribute__((address_space(3))) bf16x8*)(kp);      kf[1]=*(const __attribute__((address_space(3))) bf16x8*)(kp+512);
  kf[2]=*(const __attribute__((address_space(3))) bf16x8*)(kp+2048); kf[3]=*(const __attribute__((address_space(3))) bf16x8*)(kp+2560);
  kf[4]=*(const __attribute__((address_space(3))) bf16x8*)(kp+4096); kf[5]=*(const __attribute__((address_space(3))) bf16x8*)(kp+4608);
  kf[6]=*(const __attribute__((address_space(3))) bf16x8*)(kp+6144); kf[7]=*(const __attribute__((address_space(3))) bf16x8*)(kp+6656);
}
__device__ __forceinline__ void kload2(bf16x8*kf,lds_cptr kp,int j){ kf[2*j]=*(const __attribute__((address_space(3))) bf16x8*)(kp+j*2048); kf[2*j+1]=*(const __attribute__((address_space(3))) bf16x8*)(kp+j*2048+512); }
__device__ __forceinline__ s16x4 vtr(lds_cptr p){ return __builtin_bit_cast(s16x4,__builtin_amdgcn_ds_read_tr16_b64_v4i16((__attribute__((address_space(3))) v4i16_t*)p)); }
__device__ __forceinline__ float rowmax(const f32x16&p0,const f32x16&p1){
  float a=max3f(p0[0],p0[1],p1[0]),b=max3f(p0[2],p0[3],p1[1]);a=max3f(a,p1[2],p1[3]);
  #pragma unroll
  for(int r=4;r<16;r+=4){a=max3f(a,p0[r],p0[r+1]);b=max3f(b,p0[r+2],p0[r+3]);a=max3f(a,p1[r],p1[r+1]);b=max3f(b,p1[r+2],p1[r+3]);}
  const float m=max2f(a,b);
  auto rr=__builtin_amdgcn_permlane32_swap(__float_as_uint(m),__float_as_uint(m),false,false);
  return max2f(__uint_as_float(rr[0]),__uint_as_float(rr[1]));
}
__device__ __forceinline__ void pv(f32x16*o,int vb,bf16x8 pa0,bf16x8 pa1,bf16x8 pa2,bf16x8 pa3){
  #pragma unroll
  for(int d0=0;d0<2;++d0){s16x4 lo[4],hi[4];
    #pragma unroll
    for(int ks=0;ks<4;++ks){
      asm volatile("ds_read_b64_tr_b16 %0,%1 offset:%c2":"=&v"(lo[ks]):"v"(vb),"i"(d0*4096+ks*1024):"memory");
      asm volatile("ds_read_b64_tr_b16 %0,%1 offset:%c2":"=&v"(hi[ks]):"v"(vb),"i"(d0*4096+ks*1024+512):"memory");}
    asm volatile("s_waitcnt lgkmcnt(0)":::"memory");SBAR();
    #define PK(k) (bf16x8){lo[k][0],lo[k][1],lo[k][2],lo[k][3],hi[k][0],hi[k][1],hi[k][2],hi[k][3]}
    o[d0]=__builtin_amdgcn_mfma_f32_32x32x16_bf16(pa0,PK(0),o[d0],0,0,0);
    o[d0]=__builtin_amdgcn_mfma_f32_32x32x16_bf16(pa1,PK(1),o[d0],0,0,0);
    o[d0]=__builtin_amdgcn_mfma_f32_32x32x16_bf16(pa2,PK(2),o[d0],0,0,0);
    o[d0]=__builtin_amdgcn_mfma_f32_32x32x16_bf16(pa3,PK(3),o[d0],0,0,0);
    #undef PK
  }
}

#ifndef ATTN_STORE16
#define ATTN_STORE16(p,v) (*(u32x4*)(p)=(v))
#endif
constexpr int L2_K=0, L2_V=3*8192, L2_WS=L2_V+4*16384, L2_OST=L2_V, L2_BYTES=L2_WS+NW*64*4;
__device__ __forceinline__ float rowmax_c(const f32x16&p0,const f32x16&p1){
  float a=__builtin_fmaxf(__builtin_fmaxf(p0[0],p0[1]),p1[0]),b=__builtin_fmaxf(__builtin_fmaxf(p0[2],p0[3]),p1[1]); a=__builtin_fmaxf(__builtin_fmaxf(a,p1[2]),p1[3]);
  #pragma unroll
  for(int r=4;r<16;r+=4){a=__builtin_fmaxf(__builtin_fmaxf(a,p0[r]),p0[r+1]);b=__builtin_fmaxf(__builtin_fmaxf(b,p0[r+2]),p0[r+3]);a=__builtin_fmaxf(__builtin_fmaxf(a,p1[r]),p1[r+1]);b=__builtin_fmaxf(__builtin_fmaxf(b,p1[r+2]),p1[r+3]);}
  float m=__builtin_fmaxf(a,b);
  auto rr=__builtin_amdgcn_permlane32_swap(__float_as_uint(m),__float_as_uint(m),false,false);
  return __builtin_fmaxf(__uint_as_float(rr[0]),__uint_as_float(rr[1]));
}
__device__ __forceinline__ void pv128(f32x16 (&o)[4],const bf16x8 (&pa)[4],lds_cptr vp_){
  s16x4 vl[2][4],vh_[2][4];
  #pragma unroll
  for(int ks=0;ks<4;++ks){vl[0][ks]=vtr(vp_+ks*1024);vh_[0][ks]=vtr(vp_+ks*1024+512);}
  #pragma unroll
  for(int d0=0;d0<4;++d0){
    if(d0<3){
      #pragma unroll
      for(int ks=0;ks<4;++ks){vl[(d0+1)&1][ks]=vtr(vp_+(d0+1)*4096+ks*1024);vh_[(d0+1)&1][ks]=vtr(vp_+(d0+1)*4096+ks*1024+512);} }
    #pragma unroll
    for(int ks=0;ks<4;++ks){ const s16x4 a_=vl[d0&1][ks],b_=vh_[d0&1][ks];
      o[d0]=__builtin_amdgcn_mfma_f32_32x32x16_bf16(pa[ks],(bf16x8){a_[0],a_[1],a_[2],a_[3],b_[0],b_[1],b_[2],b_[3]},o[d0],0,0,0); }
  }
}
template<int THRL,bool KEEP> __device__ __forceinline__ void attn_unit128(int b,int qb,const bf16*Q,const bf16*__restrict__ K,const bf16*__restrict__ V,bf16*O,char*shm,const float cfar,lds_cfptr dtab){
  int tid=threadIdx.x; asm volatile("":"+v"(tid));
  const int lane=tid&63,r32=lane&31,hi=lane>>5; const int wid=__builtin_amdgcn_readfirstlane(tid>>6);
  constexpr bool grpB=true;
  const long rowbase=(long)b*SEQ; const int q0=qb*QB;
  const bf16*Qw=Q+(rowbase+q0+wid*QBLK)*DM;
  const bf16*Kh=K+rowbase*DM,*Vh=V+rowbase*DM;
  const unsigned lds0=(unsigned)(uintptr_t)shm;
  float*wsf=(float*)(shm+L2_WS)+wid*64;
  const bf16*ksrc=Kh+(long)lane*DM+wid*8;
  const bf16*vsrc=Vh+(long)(16*(wid&3)+(lane>>2))*DM+(wid>>2)*32+(lane&3)*8;
  const unsigned kdst=lds0+L2_K+wid*1024, vdst=lds0+L2_V+wid*1024;
  #define DMA2_K(t,slot) glds16(ksrc+(long)(t)*KVBLK*DM,(unsigned)__builtin_amdgcn_readfirstlane(kdst+(slot)*8192))
  #define DMA2_V(t,slot) do{ glds16(vsrc+(long)(t)*KVBLK*DM,(unsigned)__builtin_amdgcn_readfirstlane(vdst+(slot)*16384)); glds16(vsrc+64+(long)(t)*KVBLK*DM,(unsigned)__builtin_amdgcn_readfirstlane(vdst+8192+(slot)*16384)); }while(0)
  const int NT=(q0+QB)/KVBLK;
  const int NTw=NT-3+(wid>>1);
  DMA2_K(0,0);DMA2_V(0,0);DMA2_K(1,1);DMA2_V(1,1);
  bf16x8 qr[4];
  #pragma unroll
  for(int d0=0;d0<4;++d0)qr[d0]=*reinterpret_cast<const bf16x8*>(&Qw[(long)r32*DM+d0*16+hi*8]);
  __builtin_amdgcn_s_waitcnt(0x0F70);
  float mhat=0.f,l_reg=0.f; f32x16 o[4];
  #pragma unroll
  for(int d=0;d<4;++d)o[d]=f32x16{};
  f32x16 negm;
  #pragma unroll
  for(int r=0;r<16;++r)negm[r]=cfar;
  const int qrel=wid*QBLK+r32;
  const lds_cptr shm3=(lds_cptr)shm; const lds_cptr vp0=shm3+L2_V+((lane>>4)&1)*32+(lane&3)*8+(4*hi+((lane&15)>>2))*64; const lds_cptr kp0=shm3+L2_K+hi*1024+r32*16;
  int kslot=0,vslot=0;
  bf16x8 pa[4];
  #pragma unroll
  for(int i=0;i<4;++i)pa[i]=bf16x8{};
  #define PIN8(A,B) asm volatile("":"+v"(A[0]),"+v"(A[1]),"+v"(A[2]),"+v"(A[3]),"+v"(B[0]),"+v"(B[1]),"+v"(B[2]),"+v"(B[3]))
  #define VLD(buf,blk) do{ _Pragma("unroll") for(int ks=0;ks<4;++ks){vl[buf][ks]=vtr(vp_+(blk)*4096+ks*1024);vh_[buf][ks]=vtr(vp_+(blk)*4096+ks*1024+512);} }while(0)
  #define VFRAG(buf,ks) (bf16x8){vl[buf][ks][0],vl[buf][ks][1],vl[buf][ks][2],vl[buf][ks][3],vh_[buf][ks][0],vh_[buf][ks][1],vh_[buf][ks][2],vh_[buf][ks][3]}
  #pragma unroll 1
  for(int t=0;t<NT;++t){
    if(t+1<NT){WAIT_BAR(3);}else{WAIT_BAR(0);}
    if(t+2<NT){int k2=kslot+2; if(k2>=3)k2-=3; const int v2=(vslot+2)&3; DMA2_K(t+2,k2); DMA2_V(t+2,v2);}
    if(t>=NTw){ kslot=(kslot==2)?0:kslot+1; vslot=(vslot+1)&3; continue; }
    f32x16 p0,p1;
    { bf16x8 kf[8]; kload8(kf,kp0+kslot*8192);
      asm volatile("":"+v"(kf[0]),"+v"(kf[1]),"+v"(kf[2]),"+v"(kf[3]),"+v"(kf[4]),"+v"(kf[5]),"+v"(kf[6]),"+v"(kf[7]));
      p0=__builtin_amdgcn_mfma_f32_32x32x16_bf16(kf[0],qr[0],negm,0,0,0); SBAR(); p1=__builtin_amdgcn_mfma_f32_32x32x16_bf16(kf[1],qr[0],negm,0,0,0); SBAR();
      p0=__builtin_amdgcn_mfma_f32_32x32x16_bf16(kf[2],qr[1],p0,0,0,0);   SBAR(); p1=__builtin_amdgcn_mfma_f32_32x32x16_bf16(kf[3],qr[1],p1,0,0,0);   SBAR();
      p0=__builtin_amdgcn_mfma_f32_32x32x16_bf16(kf[4],qr[2],p0,0,0,0);   SBAR(); p1=__builtin_amdgcn_mfma_f32_32x32x16_bf16(kf[5],qr[2],p1,0,0,0);   SBAR();
      p0=__builtin_amdgcn_mfma_f32_32x32x16_bf16(kf[6],qr[3],p0,0,0,0);   SBAR(); p1=__builtin_amdgcn_mfma_f32_32x32x16_bf16(kf[7],qr[3],p1,0,0,0);   SBAR(); }
    { const int jb_=t-(NT-4); if(jb_>=-3)bcorr(p0,p1,jb_,qrel,hi,dtab); if(jb_>=0)cmask(p0,p1,jb_,qrel,hi); }
    const float rm=rowmax_c(p0,p1);
    const bool resc=(t==0)||__any(rm>(float)THRL);
    if(resc){
      const float dl=(t==0)?rm:__builtin_fmaxf(rm,0.f); mhat+=dl;
      #pragma unroll
      for(int r=0;r<16;++r){p0[r]-=dl;p1[r]-=dl;negm[r]=cfar-mhat;}
      const float f=__builtin_amdgcn_exp2f(-dl); l_reg*=f; if(hi==0)wsf[r32]=f; }
    { const lds_cptr vp_=vp0+((t>0)?((vslot+3)&3):vslot)*16384;
      s16x4 vl[2][4],vh_[2][4]; f32x2_t sacc2={0.f,0.f}; unsigned q0w[8],q1w[8];
      #define GAPX(d0,ks,i) do{ o[d0]=__builtin_amdgcn_mfma_f32_32x32x16_bf16(pa[ks],VFRAG((d0)&1,ks),o[d0],0,0,0); \
          p0[i]=__builtin_amdgcn_exp2f(p0[i]); p1[i]=__builtin_amdgcn_exp2f(p1[i]); sacc2=sacc2+(f32x2_t){p0[i],p1[i]}; \
          if((i)&1){ q0w[(i)>>1]=cvtpk_s(p0[(i)-1],p0[i]); q1w[(i)>>1]=cvtpk_s(p1[(i)-1],p1[i]); asm volatile("":"+v"(q0w[(i)>>1]),"+v"(q1w[(i)>>1])); } \
          asm volatile("":"+v"(sacc2)); SBAR(); }while(0)
      VLD(0,0); VLD(1,1); PIN8(vl[0],vh_[0]); PIN8(vl[1],vh_[1]);
      GAPX(0,0,0); GAPX(1,0,1); GAPX(0,1,2); GAPX(1,1,3); GAPX(0,2,4); GAPX(1,2,5); GAPX(0,3,6); GAPX(1,3,7);
      VLD(0,2); VLD(1,3); PIN8(vl[0],vh_[0]); PIN8(vl[1],vh_[1]);
      GAPX(2,0,8); GAPX(3,0,9); GAPX(2,1,10); GAPX(3,1,11); GAPX(2,2,12); GAPX(3,2,13); GAPX(2,3,14); GAPX(3,3,15);
      #undef GAPX
      l_reg+=sacc2.x+sacc2.y;
      pa[0]=__builtin_bit_cast(bf16x8,(u32x4){q0w[0],q0w[1],q0w[2],q0w[3]}); pa[1]=__builtin_bit_cast(bf16x8,(u32x4){q0w[4],q0w[5],q0w[6],q0w[7]});
      pa[2]=__builtin_bit_cast(bf16x8,(u32x4){q1w[0],q1w[1],q1w[2],q1w[3]}); pa[3]=__builtin_bit_cast(bf16x8,(u32x4){q1w[4],q1w[5],q1w[6],q1w[7]}); }
    if(resc&&t>0){ asm volatile("s_waitcnt lgkmcnt(0)":::"memory");
      #pragma unroll
      for(int r=0;r<16;++r){const float fr_=wsf[crow(r,hi)]; o[0][r]*=fr_;o[1][r]*=fr_;o[2][r]*=fr_;o[3][r]*=fr_;} }
    kslot=(kslot==2)?0:kslot+1; vslot=(vslot+1)&3;
  }
  { const lds_cptr vp_=vp0+((NTw-1)&3)*16384; s16x4 vl[2][4],vh_[2][4];
    VLD(0,0);
    #pragma unroll
    for(int d0=0;d0<4;++d0){ if(d0<3)VLD((d0+1)&1,d0+1);
      #pragma unroll
      for(int ks=0;ks<4;++ks)o[d0]=__builtin_amdgcn_mfma_f32_32x32x16_bf16(pa[ks],VFRAG(d0&1,ks),o[d0],0,0,0);
      SBAR(); } }
  #undef PIN8
  #undef VLD
  #undef VFRAG
  asm volatile("s_waitcnt lgkmcnt(0)\n\ts_barrier":::"memory");
  {auto rr=__builtin_amdgcn_permlane32_swap(__float_as_uint(l_reg),__float_as_uint(l_reg),false,false);l_reg=__uint_as_float(rr[0])+__uint_as_float(rr[1]);}
  if(hi==0)wsf[32+r32]=l_reg;asm volatile("s_waitcnt lgkmcnt(0)":::"memory");
  float rli[16];
  #pragma unroll
  for(int r=0;r<16;++r)rli[r]=__builtin_amdgcn_rcpf(wsf[32+crow(r,hi)]);
  bf16*Ow=O+(rowbase+q0+wid*QBLK)*OP;
  if constexpr(KEEP){
    bf16*stg=(bf16*)(shm+L2_OST)+wid*4096;
    #pragma unroll
    for(int r=0;r<16;++r){const int orow=crow(r,hi);
      #pragma unroll
      for(int d0=0;d0<4;++d0)stg[orow*128+d0*32+r32]=(bf16)f2bf(o[d0][r]*rli[r]);}
  } else {
  bf16*stg=(bf16*)(shm+L2_OST)+wid*2048;
  #pragma unroll
  for(int hf=0;hf<2;++hf){
    #pragma unroll
    for(int r=0;r<16;++r){const int orow=crow(r,hi);
      #pragma unroll
      for(int d0=0;d0<2;++d0)stg[orow*64+d0*32+r32]=(bf16)f2bf(o[2*hf+d0][r]*rli[r]);}
    asm volatile("s_waitcnt lgkmcnt(0)":::"memory");
    #pragma unroll
    for(int i=0;i<4;++i){const int row=i*8+(lane>>3),ch=lane&7; const u32x4 v=*(const u32x4*)(stg+row*64+ch*8); ATTN_STORE16(Ow+(long)row*OP+hf*64+ch*8,v);}
    asm volatile("s_waitcnt lgkmcnt(0)":::"memory");
  }
  }
  asm volatile("s_waitcnt lgkmcnt(0)\n\ts_barrier":::"memory");
  #undef DMA2_K
  #undef DMA2_V
}
static_assert(L2_BYTES<=110592,"attention LDS map vs DTAB_OFF");
constexpr int ATTN_LDS_BYTES=LDS_BYTES;
#undef SBAR
#undef WAIT_BAR
}

constexpr int PREP_GU = NE * 8 * 64, PREP_DN = NE * 8 * 32, PREP_ITEMS = PREP_GU + PREP_DN, PREP_WAVES = 64 * 8, PREP_PER_BH = PREP_ITEMS / PREP_WAVES;
static_assert(PREP_PER_BH * PREP_WAVES == PREP_ITEMS, "prep items must deal evenly over the 64 (b,h) groups");
struct PrepIt { const float* src; unsigned char* dst; const float* gk; int ldw, K; bool gu; };
__device__ __forceinline__ PrepIt prep_decode(const Frame& F, int id, int lane) {
    PrepIt it; int k0, n0, r0; const float* W; unsigned char* WT;
    if (id < PREP_GU) { const int e = id >> 9, q = id & 511; k0 = 128 * (q >> 6); n0 = 32 * (q & 63);
        const int bj = n0 >> 10, j = n0 & 1023; r0 = 256 * (j >> 7) + 128 * bj + (j & 127);
        W = F.in[I_WGU] + (size_t)e * D * 2 * DFF; WT = F.ws + WS_WGU + (size_t)e * 2 * DFF * D; it.ldw = 2 * DFF; it.K = D; it.gu = true;
    } else { id -= PREP_GU; const int e = id >> 8, q = id & 255; k0 = 128 * (q >> 5); n0 = 32 * (q & 31); r0 = n0;
        W = F.in[I_WDN] + (size_t)e * DFF * D; WT = F.ws + WS_WDOWN + (size_t)e * D * DFF; it.ldw = D; it.K = DFF; it.gu = false; }
    const int kq = k0 + 16 * (lane >> 3), nq = 4 * (lane & 7);
    it.src = W + (size_t)kq * it.ldw + n0 + nq; it.dst = WT + (size_t)(r0 + nq) * it.K + kq; it.gk = F.in[I_G2] + kq;
    return it;
}
__device__ __forceinline__ void prep_load(const PrepIt& it, f32x4 (&g)[4], f32x4 (&v)[16]) {
#pragma unroll
    for (int i = 0; i < 4; ++i) g[i] = *(const f32x4*)(it.gk + 4 * i);
#pragma unroll
    for (int i = 0; i < 16; ++i) v[i] = __builtin_nontemporal_load((const f32x4*)(it.src + (size_t)i * it.ldw));
}
__device__ __forceinline__ void prep_store(const PrepIt& it, const f32x4 (&g)[4], const f32x4 (&v)[16]) {
    float gv[16];
#pragma unroll
    for (int i = 0; i < 16; ++i) gv[i] = it.gu ? g[i >> 2][i & 3] * 64.f : 64.f;
#pragma unroll
    for (int c = 0; c < 4; ++c) {
        v4u o;
        o.x = pk4_fp8(v[0][c] * gv[0], v[1][c] * gv[1], v[2][c] * gv[2], v[3][c] * gv[3]);
        o.y = pk4_fp8(v[4][c] * gv[4], v[5][c] * gv[5], v[6][c] * gv[6], v[7][c] * gv[7]);
        o.z = pk4_fp8(v[8][c] * gv[8], v[9][c] * gv[9], v[10][c] * gv[10], v[11][c] * gv[11]);
        o.w = pk4_fp8(v[12][c] * gv[12], v[13][c] * gv[13], v[14][c] * gv[14], v[15][c] * gv[15]);
        __builtin_nontemporal_store(o, (v4u*)(it.dst + (size_t)c * it.K));
    }
}
__device__ __forceinline__ void p2_prep(const Frame& F, int pa, int i0, int i1) {
    if (i0 >= i1) return;
    int ln = F.lane; asm volatile("" : "+v"(ln));
    const int base = pa * 8 + F.wave;
    f32x4 ga[4], gb[4], va[16], vb[16];
    PrepIt ia = prep_decode(F, base + PREP_WAVES * i0, ln), ib;
    prep_load(ia, ga, va);
    int i = i0;
#pragma unroll 1
    while (i + 2 < i1) {
        ib = prep_decode(F, base + PREP_WAVES * (i + 1), ln); prep_load(ib, gb, vb); prep_store(ia, ga, va);
        ia = prep_decode(F, base + PREP_WAVES * (i + 2), ln); prep_load(ia, ga, va); prep_store(ib, gb, vb);
        i += 2;
    }
    if (i + 1 < i1) { ib = prep_decode(F, base + PREP_WAVES * (i + 1), ln); prep_load(ib, gb, vb); prep_store(ia, ga, va); prep_store(ib, gb, vb); }
    else prep_store(ia, ga, va);
}
constexpr int DTAB_OFF = 110592, DTAB_N = 704;
__device__ __forceinline__ void p2_attn_setup(Frame& F_) {
    Frame F = F_; { int t_ = F.tid; asm volatile("" : "+v"(t_)); F.tid = t_; F.lane = t_ & 63; }
    LAS float* dt = (LAS float*)(F.lds + DTAB_OFF);
    for (int i = F.tid; i < 4 * DTAB_N; i += NTHR) { const int h = i / DTAB_N, rel = i % DTAB_N - 256;
        dt[i] = (rel >= 0 && rel < 128) ? (F.in[I_REL][T5_BUCKET[rel] * 4 + h] - F.in[I_REL][31 * 4 + h]) * LOG2E : 0.f; }
    __syncthreads();
}
__device__ __forceinline__ void p2_attn_unit(Frame& F, unsigned char* lds_generic, int bh, int qb, float lam, int pa, int slot, int nslot) {
    const int b = bh >> 2, h = bh & 3;
    const bf16* QA = proj_buf(F, 0); const bf16* KA = proj_buf(F, 1); const bf16* VA = proj_buf(F, 2);
    bf16* OT = (bf16*)(F.dout + DO_OTMP); bf16* MIX = (bf16*)(F.ws + WS_XN);
    const float cfar = F.in[I_REL][31 * 4 + h] * LOG2E;
    attn_body::lds_cfptr dtab = (attn_body::lds_cfptr)(F.lds + DTAB_OFF) + h * DTAB_N;
    attn_body::attn_unit128<8, false>(b, qb, QA + h * 128, KA + h * 128, VA + h * 128, OT + h * 256, (char*)lds_generic, cfar, dtab);
    attn_body::attn_unit128<8, true>(b, qb, QA + h * 128 + 64, KA + h * 128 + 64, VA + h * 128, OT + h * 256 + 128, (char*)lds_generic, cfar, dtab);
    int ln = F.lane; asm volatile("" : "+v"(ln));
    const size_t R = (size_t)b * SEQ + qb * 256 + F.wave * 32 + (ln >> 1); const int half = ln & 1;
    const v4u* o0 = (const v4u*)(OT + R * 1024 + h * 256 + half * 64);
    const LAS v4u* o1 = (const LAS v4u*)(F.lds + attn_body::L2_OST + F.wave * 8192 + (ln >> 1) * 256 + half * 128);
    float d[64]; float ss = 0.f;
#pragma unroll
    for (int c = 0; c < 8; ++c) { const v4u a = o0[c], bb = o1[c];
        d[8 * c] = bflo(a.x) - lam * bflo(bb.x); d[8 * c + 1] = bfhi(a.x) - lam * bfhi(bb.x); d[8 * c + 2] = bflo(a.y) - lam * bflo(bb.y); d[8 * c + 3] = bfhi(a.y) - lam * bfhi(bb.y);
        d[8 * c + 4] = bflo(a.z) - lam * bflo(bb.z); d[8 * c + 5] = bfhi(a.z) - lam * bfhi(bb.z); d[8 * c + 6] = bflo(a.w) - lam * bflo(bb.w); d[8 * c + 7] = bfhi(a.w) - lam * bfhi(bb.w); }
#pragma unroll
    for (int i = 0; i < 64; ++i) ss += d[i] * d[i];
    ss += __shfl_xor(ss, 1);
    const float rs = rsqrtf(ss * (1.f / 128.f) + EPS) * (1.f - LAM_INIT);
    const float* g = F.in[I_DNG] + h * 128 + half * 64; v4u* mp = (v4u*)(MIX + R * 1024 + h * 128 + half * 64);
    f32x4 gg[16];
#pragma unroll
    for (int c = 0; c < 16; ++c) gg[c] = *(const f32x4*)(g + 4 * c);
#pragma unroll
    for (int c = 0; c < 8; ++c) { const f32x4 g0 = gg[2 * c], g1 = gg[2 * c + 1];
        v4u w; w.x = pk2(d[8 * c] * rs * g0.x, d[8 * c + 1] * rs * g0.y); w.y = pk2(d[8 * c + 2] * rs * g0.z, d[8 * c + 3] * rs * g0.w);
        w.z = pk2(d[8 * c + 4] * rs * g1.x, d[8 * c + 5] * rs * g1.y); w.w = pk2(d[8 * c + 6] * rs * g1.z, d[8 * c + 7] * rs * g1.w); mp[c] = w; }
    if (pa >= 0) p2_prep(F, pa, slot, nslot);
    asm volatile("s_waitcnt lgkmcnt(0)\n\ts_barrier" ::: "memory");
}
namespace ml {
constexpr int STR = 72;
constexpr int QS = 0, KS = 9216, KTS = 18432, VTS = 27648, PS = 46080, CWL = 55296, GSL = 57856, WV = 58368, HS = 74752, HSTR = 132, END = HS + 64 * HSTR * 4;
static_assert(END <= 131072, "mLSTM LDS map");
__device__ __forceinline__ f32x4 mfma16(bf16x8 a, bf16x8 b, f32x4 c) { return __builtin_amdgcn_mfma_f32_16x16x32_bf16(a, b, c, 0, 0, 0); }
__device__ __forceinline__ float red_q(float v) { v += __shfl_xor(v, 16); v += __shfl_xor(v, 32); return v; }
__device__ __forceinline__ float bfe(const bf16x8& v, int i) { return __uint_as_float(((unsigned)(unsigned short)v[i]) << 16); }
}
__device__ __forceinline__ void p2_mlstm_fast(Frame& F, int bh) {
    using namespace ml;
#define ML_BAR() asm volatile("s_waitcnt lgkmcnt(0)\n\ts_barrier" ::: "memory")
    int tid = F.tid; asm volatile("" : "+v"(tid));
    const int lane = tid & 63, w = __builtin_amdgcn_readfirstlane(tid >> 6), c = lane & 15, q = lane >> 4;
    const int b = bh >> 2, h = bh & 3; const size_t R0 = (size_t)b * SEQ;
    LAS unsigned char* L = F.lds;
    LAS bf16* Qs = (LAS bf16*)(L + QS); LAS bf16* Ks = (LAS bf16*)(L + KS); LAS bf16* KTs = (LAS bf16*)(L + KTS); LAS bf16* VTs = (LAS bf16*)(L + VTS); LAS bf16* Ps = (LAS bf16*)(L + PS);
    LAS float* cwl = (LAS float*)(L + CWL); LAS float* gs = (LAS float*)(L + GSL); LAS float* wv = (LAS float*)(L + WV) + w * 512; LAS float* Hs = (LAS float*)(L + HS);
    LAS float* Aw = wv, *Mw = wv + 64, *WIw = wv + 128, *EMw = wv + 192, *WKw = wv + 256, *Nw = wv + 320, *DNw = wv + 384;
    const bf16* MQK = proj_buf(F, 3); const bf16* MV = proj_buf(F, 4); const bf16* MO = proj_buf(F, 5); const float* GT = (const float*)(F.ws + WS_GATES);
    bf16* MIX = (bf16*)(F.ws + WS_XN);
    __syncthreads();
    for (int i = tid; i < 5 * 128; i += NTHR) { const int tap = i >> 7, cc = i & 127; const int chn = cc < 64 ? h * 64 + cc : 256 + h * 64 + (cc - 64); cwl[i] = tap < 4 ? F.in[I_CONVW][tap * 512 + chn] : F.in[I_CONVB][chn]; }
    f32x4 accC[4], nacc[4];
#pragma unroll
    for (int i = 0; i < 4; ++i) { accC[i] = (f32x4){0.f, 0.f, 0.f, 0.f}; nacc[i] = (f32x4){0.f, 0.f, 0.f, 0.f}; }
    float m_prev = 0.f;
    const int sc = tid & 31, jg = tid >> 5, cc = 4 * sc;
    const int chq = (cc < 64) ? h * 64 + cc : 256 + h * 64 + (cc - 64);
    const bool isk = cc >= 64; const float kscale = isk ? 0.125f : 1.f;
    f32x4 cw4[5];
#pragma unroll
    for (int tap = 0; tap < 5; ++tap) cw4[tap] = (f32x4){0.f, 0.f, 0.f, 0.f};
    const float mg0 = F.in[I_MLG][h * 128 + 2 * lane], mg1 = F.in[I_MLG][h * 128 + 2 * lane + 1], ob0 = F.in[I_OB][h * 128 + 2 * lane], ob1 = F.in[I_OB][h * 128 + 2 * lane + 1];
    v2u raw[7], vr[4]; float gli = 0.f, glf = 0.f;
#define ML_LOAD(ch_) do { const int ch__ = (ch_); \
        _Pragma("unroll") for (int i = 0; i < 7; ++i) { const int rr = 64 * ch__ + 4 * jg - 3 + i; \
            if (rr >= 0) raw[i] = *(const v2u*)(MQK + (R0 + rr) * 512 + chq); else raw[i] = (v2u){0u, 0u}; } \
        _Pragma("unroll") for (int i = 0; i < 4; ++i) vr[i] = *(const v2u*)(MV + (R0 + 64 * ch__ + 4 * jg + i) * 512 + h * 128 + cc); \
        gli = GT[(R0 + 64 * ch__ + lane) * 8 + h]; glf = GT[(R0 + 64 * ch__ + lane) * 8 + 4 + h]; } while (0)
    ML_LOAD(0);
    __syncthreads();
#pragma unroll
    for (int tap = 0; tap < 5; ++tap) cw4[tap] = *(const LAS f32x4*)(cwl + 128 * tap + cc);
#pragma unroll 1
    for (int ch = 0; ch < SEQ / 64; ++ch) {
        unsigned moc[8];
#pragma unroll
        for (int i = 0; i < 8; ++i) moc[i] = *(const unsigned*)(MO + (R0 + 64 * ch + 8 * w + i) * 512 + h * 128 + 2 * lane);
        ML_BAR();
        {
            float x[7][4];
#pragma unroll
            for (int i = 0; i < 7; ++i) { x[i][0] = bflo(raw[i].x); x[i][1] = bfhi(raw[i].x); x[i][2] = bflo(raw[i].y); x[i][3] = bfhi(raw[i].y); }
            float y[4][4];
#pragma unroll
            for (int r = 0; r < 4; ++r)
#pragma unroll
                for (int k = 0; k < 4; ++k) { const float t_ = cw4[4][k] + cw4[0][k] * x[r][k] + cw4[1][k] * x[r + 1][k] + cw4[2][k] * x[r + 2][k] + cw4[3][k] * x[r + 3][k]; y[r][k] = t_ * __builtin_amdgcn_rcpf(1.f + __expf(-t_)) * kscale; }
            LAS bf16* dst = isk ? Ks + (cc - 64) : Qs + cc;
#pragma unroll
            for (int r = 0; r < 4; ++r) { v2u o; o.x = pkh(y[r][0], y[r][1]); o.y = pkh(y[r][2], y[r][3]); *(LAS v2u*)(dst + (4 * jg + r) * STR) = o; }
            if (isk) {
#pragma unroll
                for (int k = 0; k < 4; ++k) { v2u o; o.x = pkh(y[0][k], y[1][k]); o.y = pkh(y[2][k], y[3][k]); *(LAS v2u*)(KTs + (cc - 64 + k) * STR + 4 * jg) = o; } }
            { v2u o;
              o.x = (vr[0].x & 0xffffu) | (vr[1].x << 16); o.y = (vr[2].x & 0xffffu) | (vr[3].x << 16); *(LAS v2u*)(VTs + (cc + 0) * STR + 4 * jg) = o;
              o.x = (vr[0].x >> 16) | (vr[1].x & 0xffff0000u); o.y = (vr[2].x >> 16) | (vr[3].x & 0xffff0000u); *(LAS v2u*)(VTs + (cc + 1) * STR + 4 * jg) = o;
              o.x = (vr[0].y & 0xffffu) | (vr[1].y << 16); o.y = (vr[2].y & 0xffffu) | (vr[3].y << 16); *(LAS v2u*)(VTs + (cc + 2) * STR + 4 * jg) = o;
              o.x = (vr[0].y >> 16) | (vr[1].y & 0xffff0000u); o.y = (vr[2].y >> 16) | (vr[3].y & 0xffff0000u); *(LAS v2u*)(VTs + (cc + 3) * STR + 4 * jg) = o; }
        }
        float decay, m_next;
        {   const float li = gli, lf = glf;
            float bsum = lf;
#pragma unroll
            for (int o = 1; o < 64; o <<= 1) { const float v_ = __shfl_up(bsum, o); if (lane >= o) bsum += v_; }
            const float a = li - bsum; float am = a;
#pragma unroll
            for (int o = 1; o < 64; o <<= 1) { const float v_ = __shfl_up(am, o); if (lane >= o) am = fmaxf(am, v_); }
            const float M = fmaxf(am, m_prev);
            const float g = __shfl(bsum, 63), M63 = __shfl(M, 63);
            Aw[lane] = a; Mw[lane] = M; WIw[lane] = __expf(m_prev - M); EMw[lane] = __expf(-(bsum + M)); WKw[lane] = __expf(a - M63);
            decay = __expf(m_prev - M63); m_next = g + M63;
        }
        if (ch + 1 < SEQ / 64) ML_LOAD(ch + 1);
        ML_BAR();
        {   const int tt = w >> 1; const bf16x8 qb0 = *(const LAS bf16x8*)(Qs + (16 * tt + c) * STR + 8 * q), qb1 = *(const LAS bf16x8*)(Qs + (16 * tt + c) * STR + 32 + 8 * q);
            const float Mt = Mw[16 * tt + c];
#pragma unroll
            for (int jj = 0; jj < 2; ++jj) { const int jt = 2 * (w & 1) + jj;
                const bf16x8 ka0 = *(const LAS bf16x8*)(Ks + (16 * jt + c) * STR + 8 * q), ka1 = *(const LAS bf16x8*)(Ks + (16 * jt + c) * STR + 32 + 8 * q);
                f32x4 sacc = mfma16(ka0, qb0, (f32x4){0.f, 0.f, 0.f, 0.f}); sacc = mfma16(ka1, qb1, sacc);
                const f32x4 a4 = *(const LAS f32x4*)(Aw + 16 * jt + 4 * q);
                float p[4];
#pragma unroll
                for (int r = 0; r < 4; ++r) p[r] = (16 * jt + 4 * q + r <= 16 * tt + c) ? sacc[r] * __expf(a4[r] - Mt) : 0.f;
                v2u pw; pw.x = pkh(p[0], p[1]); pw.y = pkh(p[2], p[3]);
                *(LAS v2u*)(Ps + (16 * tt + c) * STR + 16 * jt + 4 * q) = pw; }
        }
        ML_BAR();
        {   bf16x8 vb[2]; vb[0] = *(const LAS bf16x8*)(VTs + (16 * w + c) * STR + 8 * q); vb[1] = *(const LAS bf16x8*)(VTs + (16 * w + c) * STR + 32 + 8 * q);
            bf16x8 cbf[2];
#pragma unroll
            for (int ks = 0; ks < 2; ++ks) { v4u t_; t_.x = pkh(accC[2 * ks][0], accC[2 * ks][1]); t_.y = pkh(accC[2 * ks][2], accC[2 * ks][3]); t_.z = pkh(accC[2 * ks + 1][0], accC[2 * ks + 1][1]); t_.w = pkh(accC[2 * ks + 1][2], accC[2 * ks + 1][3]); cbf[ks] = __builtin_bit_cast(bf16x8, t_); }
            bf16x8 nb[2];
#pragma unroll
            for (int ks = 0; ks < 2; ++ks) { v4u t_; t_.x = pkh(nacc[2 * ks][0], nacc[2 * ks][1]); t_.y = pkh(nacc[2 * ks][2], nacc[2 * ks][3]); t_.z = pkh(nacc[2 * ks + 1][0], nacc[2 * ks + 1][1]); t_.w = pkh(nacc[2 * ks + 1][2], nacc[2 * ks + 1][3]); nb[ks] = __builtin_bit_cast(bf16x8, t_); }
            const bf16x8 ones8 = {(short)0x3f80, (short)0x3f80, (short)0x3f80, (short)0x3f80, (short)0x3f80, (short)0x3f80, (short)0x3f80, (short)0x3f80};
#pragma unroll
            for (int m = 0; m < 4; ++m) {
                f32x4 ia = (f32x4){0.f, 0.f, 0.f, 0.f}, ie = (f32x4){0.f, 0.f, 0.f, 0.f}, rs4 = (f32x4){0.f, 0.f, 0.f, 0.f}, qn4 = (f32x4){0.f, 0.f, 0.f, 0.f};
#pragma unroll
                for (int ks = 0; ks < 2; ++ks) {
                    const bf16x8 pa = *(const LAS bf16x8*)(Ps + (16 * m + c) * STR + 32 * ks + 8 * q);
                    ia = mfma16(pa, vb[ks], ia); rs4 = mfma16(pa, ones8, rs4);
                    const v2u qlo = *(const LAS v2u*)(Qs + (16 * m + c) * STR + 32 * ks + 4 * q), qhi = *(const LAS v2u*)(Qs + (16 * m + c) * STR + 32 * ks + 16 + 4 * q);
                    v4u qq; qq.x = qlo.x; qq.y = qlo.y; qq.z = qhi.x; qq.w = qhi.y; const bf16x8 qa = __builtin_bit_cast(bf16x8, qq);
                    ie = mfma16(qa, cbf[ks], ie); qn4 = mfma16(qa, nb[ks], qn4);
                }
                const f32x4 wi4 = *(const LAS f32x4*)(WIw + 16 * m + 4 * q), em4 = *(const LAS f32x4*)(EMw + 16 * m + 4 * q);
#pragma unroll
                for (int r = 0; r < 4; ++r) { const float den = rs4[r] + wi4[r] * qn4[r]; const float rden = __builtin_amdgcn_rcpf(fmaxf(fabsf(den), em4[r]));
                    Hs[(16 * m + 4 * q + r) * HSTR + 16 * w + c] = (ia[r] + wi4[r] * ie[r]) * rden; }
            }
            f32x4 wk8[2][2];
#pragma unroll
            for (int ks = 0; ks < 2; ++ks) { wk8[ks][0] = *(const LAS f32x4*)(WKw + 32 * ks + 8 * q); wk8[ks][1] = *(const LAS f32x4*)(WKw + 32 * ks + 8 * q + 4); }
            bf16x8 vs[2], wkb[2];
#pragma unroll
            for (int ks = 0; ks < 2; ++ks) { v4u t_; t_.x = pkh(bfe(vb[ks], 0) * wk8[ks][0][0], bfe(vb[ks], 1) * wk8[ks][0][1]); t_.y = pkh(bfe(vb[ks], 2) * wk8[ks][0][2], bfe(vb[ks], 3) * wk8[ks][0][3]);
                t_.z = pkh(bfe(vb[ks], 4) * wk8[ks][1][0], bfe(vb[ks], 5) * wk8[ks][1][1]); t_.w = pkh(bfe(vb[ks], 6) * wk8[ks][1][2], bfe(vb[ks], 7) * wk8[ks][1][3]); vs[ks] = __builtin_bit_cast(bf16x8, t_);
                v4u u_; u_.x = pkh(wk8[ks][0][0], wk8[ks][0][1]); u_.y = pkh(wk8[ks][0][2], wk8[ks][0][3]); u_.z = pkh(wk8[ks][1][0], wk8[ks][1][1]); u_.w = pkh(wk8[ks][1][2], wk8[ks][1][3]); wkb[ks] = __builtin_bit_cast(bf16x8, u_); }
#pragma unroll
            for (int dt = 0; dt < 4; ++dt) { f32x4 ca = accC[dt] * decay, na = nacc[dt] * decay;
#pragma unroll
                for (int ks = 0; ks < 2; ++ks) { const bf16x8 ka = *(const LAS bf16x8*)(KTs + (16 * dt + c) * STR + 32 * ks + 8 * q); ca = mfma16(ka, vs[ks], ca); na = mfma16(ka, wkb[ks], na); }
                accC[dt] = ca; nacc[dt] = na; }
            m_prev = m_next;
        }
        ML_BAR();
#pragma unroll
        for (int i = 0; i < 8; ++i) { const int t = 8 * w + i; const float h0 = Hs[t * HSTR + 2 * lane], h1 = Hs[t * HSTR + 2 * lane + 1];
            const float rsn = rsqrtf(wave_sum(h0 * h0 + h1 * h1) * (1.f / 128.f) + EPS);
            const float o0 = h0 * rsn * mg0 * sigmoidf_(bflo(moc[i]) + ob0), o1 = h1 * rsn * mg1 * sigmoidf_(bfhi(moc[i]) + ob1);
            *(unsigned*)(MIX + (R0 + 64 * ch + t) * 1024 + 512 + h * 128 + 2 * lane) = pkh(o0, o1); }
    }
#undef ML_LOAD
#undef ML_BAR
    __syncthreads();
}

__device__ __forceinline__ void p4_route(Frame& F_) {
    Frame F = F_; { int t_ = F.tid; asm volatile("" : "+v"(t_)); F.tid = t_; F.lane = t_ & 63; }
    LAS v4u* wf = (LAS v4u*)F.lds;
    LAS unsigned* hist = (LAS unsigned*)(F.lds + L_HIST);
    for (int i = F.tid; i < 32 * 2 * 64; i += NTHR) { const int ln = i & 63, nt = (i >> 6) & 1, s_ = i >> 7, e = 16 * nt + (ln & 15), k0 = 32 * s_ + 8 * (ln >> 4);
        float w[8]; unsigned hi16[8], lo16[8];
#pragma unroll
        for (int j = 0; j < 8; ++j) { w[j] = F.in[I_RW][(k0 + j) * NE + e] * F.in[I_G2][k0 + j]; hi16[j] = f2bf(w[j]); lo16[j] = f2bf(w[j] - __uint_as_float(hi16[j] << 16)); }
        v4u h4, l4; h4.x = hi16[0] | (hi16[1] << 16); h4.y = hi16[2] | (hi16[3] << 16); h4.z = hi16[4] | (hi16[5] << 16); h4.w = hi16[6] | (hi16[7] << 16);
        l4.x = lo16[0] | (lo16[1] << 16); l4.y = lo16[2] | (lo16[3] << 16); l4.z = lo16[4] | (lo16[5] << 16); l4.w = lo16[6] | (lo16[7] << 16);
        wf[((s_ * 2 + nt) * 2 + 0) * 64 + ln] = h4; wf[((s_ * 2 + nt) * 2 + 1) * 64 + ln] = l4; }
    const bf16* X1 = (const bf16*)(F.ws + WS_X1B);
    float* RS = (float*)(F.ws + WS_RSTD2); unsigned* TI = (unsigned*)(F.ws + WS_TOKINFO); float* GA = (float*)(F.ws + WS_GATE); unsigned* HIST = (unsigned*)(F.ws + WS_HIST);
    const int c = F.lane & 15, q = F.lane >> 4;
    const float rb0 = F.in[I_RB][c], rb1 = F.in[I_RB][16 + c];
    for (int blk = F.vcu; blk < T / 256; blk += F.G) {
        if (F.tid < 32) hist[F.tid] = 0u;
        __syncthreads();
#pragma unroll 1
        for (int grp = 0; grp < 2; ++grp) {
            const int t0 = blk * 256 + F.wave * 32 + grp * 16;
            const bf16x8* xr = (const bf16x8*)(X1 + (size_t)(t0 + c) * D + 8 * q);
            bf16x8 xa[32];
#pragma unroll
            for (int s_ = 0; s_ < 32; ++s_) xa[s_] = xr[4 * s_];
            f32x4 l0 = (f32x4){0.f, 0.f, 0.f, 0.f}, l1 = (f32x4){0.f, 0.f, 0.f, 0.f}; float ss = 0.f;
#pragma unroll
            for (int s_ = 0; s_ < 32; ++s_) {
                const bf16x8 b0h = __builtin_bit_cast(bf16x8, wf[((s_ * 2 + 0) * 2 + 0) * 64 + F.lane]), b0l = __builtin_bit_cast(bf16x8, wf[((s_ * 2 + 0) * 2 + 1) * 64 + F.lane]);
                const bf16x8 b1h = __builtin_bit_cast(bf16x8, wf[((s_ * 2 + 1) * 2 + 0) * 64 + F.lane]), b1l = __builtin_bit_cast(bf16x8, wf[((s_ * 2 + 1) * 2 + 1) * 64 + F.lane]);
                l0 = __builtin_amdgcn_mfma_f32_16x16x32_bf16(xa[s_], b0h, l0, 0, 0, 0); l0 = __builtin_amdgcn_mfma_f32_16x16x32_bf16(xa[s_], b0l, l0, 0, 0, 0);
                l1 = __builtin_amdgcn_mfma_f32_16x16x32_bf16(xa[s_], b1h, l1, 0, 0, 0); l1 = __builtin_amdgcn_mfma_f32_16x16x32_bf16(xa[s_], b1l, l1, 0, 0, 0);
#pragma unroll
                for (int j = 0; j < 8; ++j) { const float xv = __uint_as_float(((unsigned)(unsigned short)xa[s_][j]) << 16); ss += xv * xv; }
            }
            ss += __shfl_xor(ss, 16); ss += __shfl_xor(ss, 32);
            const float rstd_c = rsqrtf(ss * (1.f / D) + EPS);
#pragma unroll
            for (int r = 0; r < 4; ++r) {
                const float rstd = __shfl(rstd_c, 4 * q + r);
                const float g0 = l0[r] * rstd + rb0, g1 = l1[r] * rstd + rb1;
                int k0, k1; { const int b_ = __float_as_int(g0); k0 = b_ ^ ((b_ >> 31) & 0x7fffffff); k0 = (k0 & ~31) | (31 - c); }
                { const int b_ = __float_as_int(g1); k1 = b_ ^ ((b_ >> 31) & 0x7fffffff); k1 = (k1 & ~31) | (15 - c); }
                float tv[4]; int te[4];
#pragma unroll
                for (int k = 0; k < 4; ++k) { int mx = k0 > k1 ? k0 : k1;
#pragma unroll
                    for (int o = 1; o < 16; o <<= 1) { const int other = __shfl_xor(mx, o); mx = other > mx ? other : mx; }
                    te[k] = 31 - (mx & 31); { const int kk = mx & ~31; tv[k] = __int_as_float(kk ^ ((kk >> 31) & 0x7fffffff)); }
                    if (te[k] == c) k0 = (int)0x80000000; if (te[k] == 16 + c) k1 = (int)0x80000000; }
                const float e1 = __expf(tv[1] - tv[0]), e2 = __expf(tv[2] - tv[0]), e3 = __expf(tv[3] - tv[0]); const float inv = 1.f / (1.f + e1 + e2 + e3);
                if (c == 0) { const int t = t0 + 4 * q + r;
                    RS[t] = rstd;
                    f32x4 g; g.x = inv; g.y = e1 * inv; g.z = e2 * inv; g.w = e3 * inv; *(f32x4*)(GA + (size_t)t * 4) = g;
                    v4u ti;
                    ti.x = ((unsigned)te[0] << 20) | atomicAdd((unsigned*)&hist[te[0]], 1u); ti.y = ((unsigned)te[1] << 20) | atomicAdd((unsigned*)&hist[te[1]], 1u);
                    ti.z = ((unsigned)te[2] << 20) | atomicAdd((unsigned*)&hist[te[2]], 1u); ti.w = ((unsigned)te[3] << 20) | atomicAdd((unsigned*)&hist[te[3]], 1u);
                    *(v4u*)(TI + (size_t)t * 4) = ti; }
            }
        }
        __syncthreads();
        if (F.tid < 32) HIST[blk * 32 + F.tid] = hist[F.tid];
        __syncthreads();
    }
}

__device__ __forceinline__ void p4b_lists(Frame& F_) {
    Frame F = F_; { int t_ = F.tid; asm volatile("" : "+v"(t_)); F.tid = t_; F.lane = t_ & 63; }
    LAS int* pb = (LAS int*)F.lds; LAS int* pa = pb + 512; LAS unsigned* basew = (LAS unsigned*)(F.lds + L_BASE);
    LAS int* tb = (LAS int*)(F.lds + L_ETAB); LAS int* cn = tb + 40;
    const unsigned* HIST = (const unsigned*)(F.ws + WS_HIST); const float* RS = (const float*)(F.ws + WS_RSTD2);
    unsigned* TI = (unsigned*)(F.ws + WS_TOKINFO); int* LIST = (int*)(F.ws + WS_LIST); float* LRS = (float*)(F.ws + WS_LISTRS);
    { const int e = F.tid & 31, p = F.tid >> 5; int sa = 0;
#pragma unroll
      for (int i = 0; i < 16; ++i) sa += (int)HIST[(16 * p + i) * 32 + e];
      pa[F.tid] = sa; }
    __syncthreads();
    if (F.tid < 32) { int sa = 0;
#pragma unroll
        for (int p = 0; p < 16; ++p) sa += pa[32 * p + F.tid];
        cn[F.tid] = sa; }
    __syncthreads();
    if (F.tid == 0) { int acc = 0; for (int e = 0; e < NE; ++e) { tb[e] = acc; acc += (cn[e] + 255) >> 8; } tb[NE] = acc; }
    for (int blk = F.vcu; blk < T / 256; blk += F.G) {
        { const int e = F.tid & 31, p = F.tid >> 5; int sb = 0;
#pragma unroll
          for (int i = 0; i < 16; ++i) { const int bb = 16 * p + i; const int hv = (int)HIST[bb * 32 + e]; sb += bb < blk ? hv : 0; }
          pb[F.tid] = sb; }
        __syncthreads();
        if (F.tid < 32) { int sb = 0;
#pragma unroll
            for (int p = 0; p < 16; ++p) sb += pb[32 * p + F.tid];
            basew[F.tid] = (unsigned)sb; }
        __syncthreads();
        for (int i = F.tid; i < 1024; i += NTHR) {
            const int t = blk * 256 + (i >> 2); const unsigned ti = TI[(size_t)t * 4 + (i & 3)]; const unsigned e = ti >> 20, pos = basew[e] + (ti & 0xfffffu);
            TI[(size_t)t * 4 + (i & 3)] = (e << 20) | pos; LIST[(size_t)e * T + pos] = t; LRS[(size_t)e * T + pos] = RS[t];
        }
        __syncthreads();
    }
}

__device__ __forceinline__ int find_expert(const LAS int* tb, int tile256) { int e = 0;
#pragma unroll 1
    for (int i = 1; i < NE; ++i) e = (tile256 >= tb[i]) ? i : e;
    return e; }

struct DenseSched {
    pg8::TileOrder ord; const char* A; const char* Bt; int K;
    __device__ __forceinline__ bool next(int i, pg8::Unit& u) const { u.e = 0; return ord.next_tile(i, u.pm, u.pn); }
    __device__ __forceinline__ void a_view(const pg8::Unit& u, const int (&R)[2], const int (&C)[2], const char*& base, unsigned (&off)[2][2]) const {
        base = A + (size_t)u.pm * 256 * K * 2;
#pragma unroll
        for (int h = 0; h < 2; ++h)
#pragma unroll
            for (int i = 0; i < 2; ++i) off[h][i] = (unsigned)((h * 128 + R[i]) * K + C[i]) * 2u;
    }
    __device__ __forceinline__ void a_pre(const pg8::Unit&, const int (&)[2], unsigned (&)[2][2]) const {}
    __device__ __forceinline__ void a_post(const pg8::Unit& u, unsigned (&)[2][2], const int (&R)[2], const int (&C)[2], const char*& base, unsigned (&off)[2][2]) const { a_view(u, R, C, base, off); }
    __device__ __forceinline__ const char* b_base(const pg8::Unit& u) const { return Bt + (size_t)u.pn * 256 * K * 2; }
};
struct EpiProj {
    unsigned char* ws;
    __device__ __forceinline__ void operator()(const f32x4 (&acc)[2][2][4][2], const pg8::Unit& u, int wr, int wc, int fr, int fq) const {
        asm volatile("" : "+v"(fr));
        const int buf = u.pn >> 1; bf16* base = (bf16*)(ws + proj_off(buf)); const float sc = buf == 0 ? C2 : 1.f;
        const int row0 = u.pm * 256 + wr * 64 + fr, col0 = (u.pn & 1) * 256 + wc * 32 + 8 * fq;
#pragma unroll
        for (int ai = 0; ai < 2; ++ai)
#pragma unroll
            for (int m = 0; m < 4; ++m) { bf16* rowp = base + (size_t)(row0 + ai * 128 + m * 16) * 512 + col0;
#pragma unroll
                for (int bj = 0; bj < 2; ++bj) { const f32x4 v0 = acc[ai][bj][m][0] * sc, v1 = acc[ai][bj][m][1] * sc;
                    v4u w; w.x = pg8::cvt_pk_bf16(v0[0], v0[1]); w.y = pg8::cvt_pk_bf16(v0[2], v0[3]); w.z = pg8::cvt_pk_bf16(v1[0], v1[1]); w.w = pg8::cvt_pk_bf16(v1[2], v1[3]);
                    *(v4u*)(rowp + bj * 128) = w; } }
    }
};
struct EpiOutProj {
    const float* x; bf16* X1; unsigned char* X8;
    __device__ __forceinline__ void operator()(const f32x4 (&acc)[2][2][4][2], const pg8::Unit& u, int wr, int wc, int fr, int fq) const {
        asm volatile("" : "+v"(fr));
        const int row0 = u.pm * 256 + wr * 64 + fr, col0 = u.pn * 256 + wc * 32 + 8 * fq;
#pragma unroll
        for (int ai = 0; ai < 2; ++ai)
#pragma unroll
            for (int m = 0; m < 4; ++m) { const size_t ro = (size_t)(row0 + ai * 128 + m * 16) * D + col0;
#pragma unroll
                for (int bj = 0; bj < 2; ++bj) { const f32x4 v0 = acc[ai][bj][m][0] + *(const f32x4*)(x + ro + bj * 128), v1 = acc[ai][bj][m][1] + *(const f32x4*)(x + ro + bj * 128 + 4);
                    v4u w; w.x = pg8::cvt_pk_bf16(v0[0], v0[1]); w.y = pg8::cvt_pk_bf16(v0[2], v0[3]); w.z = pg8::cvt_pk_bf16(v1[0], v1[1]); w.w = pg8::cvt_pk_bf16(v1[2], v1[3]);
                    *(v4u*)(X1 + ro + bj * 128) = w;
                    v2u w8; w8.x = pk4_fp8(v0[0], v0[1], v0[2], v0[3]); w8.y = pk4_fp8(v1[0], v1[1], v1[2], v1[3]); *(v2u*)(X8 + ro + bj * 128) = w8; } }
    }
};
template <bool GATHER> struct MoeSched8 {
    pg8::TileOrder ord; const LAS int* tb; const LAS int* cn; const char* A; const char* W; const int* LIST; int wrows;
    __device__ __forceinline__ bool next(int i, pg8::Unit& u) const { if (!ord.next_tile(i, u.pm, u.pn)) return false; u.e = find_expert(tb, u.pm); return true; }
    __device__ __forceinline__ void a_view(const pg8::Unit& u, const int (&R)[2], const int (&C)[2], const char*& base, unsigned (&off)[2][2]) const {
        if constexpr (GATHER) {
            base = A; const int pos0 = (u.pm - tb[u.e]) * 256, cnt = cn[u.e]; const int* lst = LIST + (size_t)u.e * T;
#pragma unroll
            for (int h = 0; h < 2; ++h)
#pragma unroll
                for (int i = 0; i < 2; ++i) { int p = pos0 + h * 128 + R[i]; p = p < cnt ? p : cnt - 1; off[h][i] = (unsigned)(lst[p] * D + C[i] * 2); }
        } else {
            base = A + (size_t)u.pm * 256 * DFF;
#pragma unroll
            for (int h = 0; h < 2; ++h)
#pragma unroll
                for (int i = 0; i < 2; ++i) off[h][i] = (unsigned)((h * 128 + R[i]) * DFF + C[i] * 2);
        }
    }
    __device__ __forceinline__ void a_pre(const pg8::Unit& u, const int (&R)[2], unsigned (&pre)[2][2]) const {
        if constexpr (GATHER) { const int pos0 = (u.pm - tb[u.e]) * 256, cnt = cn[u.e]; const int* lst = LIST + (size_t)u.e * T;
#pragma unroll
            for (int h = 0; h < 2; ++h)
#pragma unroll
                for (int i = 0; i < 2; ++i) { int p = pos0 + h * 128 + R[i]; p = p < cnt ? p : cnt - 1; const int* ptr = lst + p;
                    asm volatile("global_load_dword %0, %1, off" : "=v"(pre[h][i]) : "v"(ptr)); }
        }
    }
    __device__ __forceinline__ void a_post(const pg8::Unit& u, unsigned (&pre)[2][2], const int (&R)[2], const int (&C)[2], const char*& base, unsigned (&off)[2][2]) const {
        if constexpr (GATHER) { base = A;
#pragma unroll
            for (int h = 0; h < 2; ++h)
#pragma unroll
                for (int i = 0; i < 2; ++i) { asm volatile("" : "+v"(pre[h][i])); off[h][i] = pre[h][i] * (unsigned)D + (unsigned)(C[i] * 2); }
        } else a_view(u, R, C, base, off);
    }
    __device__ __forceinline__ const char* b_base(const pg8::Unit& u) const { return W + ((size_t)u.e * wrows + (size_t)u.pn * 256) * D; }
};
typedef float f32x2v __attribute__((ext_vector_type(2)));
__device__ __forceinline__ f32x2v swiglu_pk(f32x2v accg, f32x2v accl, f32x2v rs2, f32x2v bgv, f32x2v blv) {
    f32x2v g = __builtin_elementwise_fma(accg, rs2, bgv), l = __builtin_elementwise_fma(accl, rs2, blv);
    g.x = fminf(g.x, 7.f); g.y = fminf(g.y, 7.f); l.x = __builtin_amdgcn_fmed3f(l.x, -7.f, 7.f); l.y = __builtin_amdgcn_fmed3f(l.y, -7.f, 7.f);
    f32x2v z = g * -2.45546696f;
    f32x2v e; e.x = __builtin_amdgcn_exp2f(z.x); e.y = __builtin_amdgcn_exp2f(z.y);
    e = e + 1.0f; f32x2v r; r.x = __builtin_amdgcn_rcpf(e.x); r.y = __builtin_amdgcn_rcpf(e.y);
    return (g * r) * (l + 1.0f);
}
struct EpiGateUp8 {
    const LAS int* tb; const LAS int* cn; const float* LRS; const float* bgu; unsigned char* ACT8;
    __device__ __forceinline__ void operator()(const f32x4 (&acc)[2][2][4][2], const pg8::Unit& u, int wr, int wc, int fr, int fq) const {
        asm volatile("" : "+v"(fr));
        const int pos0 = (u.pm - tb[u.e]) * 256, cnt = cn[u.e]; const float* lrs = LRS + (size_t)u.e * T; const float* bg = bgu + (size_t)u.e * 2 * DFF;
        const int j0 = u.pn * 128 + wc * 32 + 8 * fq;
        const f32x4 bg0 = *(const f32x4*)(bg + j0), bg1 = *(const f32x4*)(bg + j0 + 4), bl0 = *(const f32x4*)(bg + DFF + j0), bl1 = *(const f32x4*)(bg + DFF + j0 + 4);
        unsigned char* abase = ACT8 + (size_t)u.pm * 256 * DFF;
#pragma unroll
        for (int ai = 0; ai < 2; ++ai)
#pragma unroll
            for (int m = 0; m < 4; ++m) { const int rl = ai * 128 + wr * 64 + m * 16 + fr; int p = pos0 + rl; p = p < cnt ? p : cnt - 1; const float rs = lrs[p]; const f32x2v rs2 = {rs, rs};
                const f32x4 ag0 = acc[ai][0][m][0], ag1 = acc[ai][0][m][1], al0 = acc[ai][1][m][0], al1 = acc[ai][1][m][1];
                const f32x2v o0 = swiglu_pk((f32x2v){ag0[0], ag0[1]}, (f32x2v){al0[0], al0[1]}, rs2, (f32x2v){bg0[0], bg0[1]}, (f32x2v){bl0[0], bl0[1]});
                const f32x2v o1 = swiglu_pk((f32x2v){ag0[2], ag0[3]}, (f32x2v){al0[2], al0[3]}, rs2, (f32x2v){bg0[2], bg0[3]}, (f32x2v){bl0[2], bl0[3]});
                const f32x2v o2 = swiglu_pk((f32x2v){ag1[0], ag1[1]}, (f32x2v){al1[0], al1[1]}, rs2, (f32x2v){bg1[0], bg1[1]}, (f32x2v){bl1[0], bl1[1]});
                const f32x2v o3 = swiglu_pk((f32x2v){ag1[2], ag1[3]}, (f32x2v){al1[2], al1[3]}, rs2, (f32x2v){bg1[2], bg1[3]}, (f32x2v){bl1[2], bl1[3]});
                v2u w; w.x = pk4_fp8(o0.x, o0.y, o1.x, o1.y); w.y = pk4_fp8(o2.x, o2.y, o3.x, o3.y);
                *(v2u*)(abase + (size_t)rl * DFF + j0) = w; }
    }
};
struct EpiDown {
    const float* bdn; unsigned char* YK8;
    __device__ __forceinline__ void operator()(const f32x4 (&acc)[2][2][4][2], const pg8::Unit& u, int wr, int wc, int fr, int fq) const {
        asm volatile("" : "+v"(fr));
        const float* bd = bdn + (size_t)u.e * D; const int row0 = u.pm * 256 + wr * 64 + fr, col0 = u.pn * 256 + wc * 32 + 8 * fq;
        f32x4 bv[2][2];
#pragma unroll
        for (int bj = 0; bj < 2; ++bj)
#pragma unroll
            for (int n = 0; n < 2; ++n) bv[bj][n] = *(const f32x4*)(bd + col0 + bj * 128 + 4 * n);
#pragma unroll
        for (int ai = 0; ai < 2; ++ai)
#pragma unroll
            for (int m = 0; m < 4; ++m) { unsigned char* rowp = YK8 + (size_t)(row0 + ai * 128 + m * 16) * D + col0;
#pragma unroll
                for (int bj = 0; bj < 2; ++bj) { const f32x4 v0 = acc[ai][bj][m][0] + bv[bj][0], v1 = acc[ai][bj][m][1] + bv[bj][1];
                    v2u w; w.x = pk4_fp8(v0[0], v0[1], v0[2], v0[3]); w.y = pk4_fp8(v1[0], v1[1], v1[2], v1[3]);
                    *(v2u*)(rowp + bj * 128) = w; } }
    }
};

__device__ __forceinline__ void p7_final(Frame& F_) {
    Frame F = F_; { int t_ = F.tid; asm volatile("" : "+v"(t_)); F.tid = t_; F.lane = t_ & 63; }
    const LAS int* tb = (const LAS int*)(F.lds + L_ETAB);
    const bf16* X1 = (const bf16*)(F.ws + WS_X1B); const unsigned char* YK = F.ws + WS_YK; const unsigned* TI = (const unsigned*)(F.ws + WS_TOKINFO); const float* GA = (const float*)(F.ws + WS_GATE);
    const float* gf = F.in[I_GF]; float* out = (float*)F.dout;
    const int gw = F.vcu * NWAVES + F.wave, NGW = F.G * NWAVES;
    v4u ti_n[2]; f32x4 ga_n[2];
#pragma unroll
    for (int r = 0; r < 2; ++r) { const int tt = gw + r * NGW; const int tc = tt < T ? tt : 0; ti_n[r] = *(const v4u*)(TI + (size_t)tc * 4); ga_n[r] = *(const f32x4*)(GA + (size_t)tc * 4); }
    for (int t0 = gw; t0 < T; t0 += 2 * NGW) {
        v4u ti[2]; f32x4 ga[2];
#pragma unroll
        for (int r = 0; r < 2; ++r) { ti[r] = ti_n[r]; ga[r] = ga_n[r]; }
#pragma unroll
        for (int r = 0; r < 2; ++r) { const int tt = t0 + (2 + r) * NGW; const int tc = tt < T ? tt : 0; ti_n[r] = *(const v4u*)(TI + (size_t)tc * 4); ga_n[r] = *(const f32x4*)(GA + (size_t)tc * 4); }
        v2u xw[2][4]; int yw[2][4][4];
#pragma unroll
        for (int r = 0; r < 2; ++r) { const int tt = t0 + r * NGW; const int t = tt < T ? tt : t0;
            const unsigned tw[4] = {ti[r].x, ti[r].y, ti[r].z, ti[r].w};
#pragma unroll
            for (int j = 0; j < 4; ++j) xw[r][j] = *((const v2u*)(X1 + (size_t)t * D) + F.lane + 64 * j);
#pragma unroll
            for (int k = 0; k < 4; ++k) { const unsigned char* yr = YK + (size_t)(256 * tb[tw[k] >> 20] + (int)(tw[k] & 0xfffffu)) * D;
#pragma unroll
                for (int j = 0; j < 4; ++j) yw[r][k][j] = *((const int*)yr + F.lane + 64 * j); } }
#pragma unroll
        for (int r = 0; r < 2; ++r) { const int t = t0 + r * NGW; if (t >= T) break;
            f32x4 v[4]; float ss = 0.f;
#pragma unroll
            for (int j = 0; j < 4; ++j) { const v2u w = xw[r][j];
                f32x4 a; a.x = bflo(w.x); a.y = bfhi(w.x); a.z = bflo(w.y); a.w = bfhi(w.y);
#pragma unroll
                for (int k = 0; k < 4; ++k) { const int y = yw[r][k][j]; const float gk = ga[r][k];
                    a.x += gk * __builtin_amdgcn_cvt_f32_fp8(y, 0); a.y += gk * __builtin_amdgcn_cvt_f32_fp8(y, 1); a.z += gk * __builtin_amdgcn_cvt_f32_fp8(y, 2); a.w += gk * __builtin_amdgcn_cvt_f32_fp8(y, 3); }
                v[j] = a; ss += a.x * a.x + a.y * a.y + a.z * a.z + a.w * a.w; }
            const float rs = rsqrtf(wave_sum(ss) * (1.f / D) + EPS);
#pragma unroll
            for (int j = 0; j < 4; ++j) { const f32x4 g = *((const f32x4*)gf + F.lane + 64 * j); *((f32x4*)(out + (size_t)t * D) + F.lane + 64 * j) = v[j] * rs * g; }
        }
    }
}

__global__ void __launch_bounds__(NTHR, 2) hymba_fwd(Args args) {
    extern __shared__ __attribute__((aligned(16))) unsigned char lds[];
    Frame F;
    F.lds = (LAS unsigned char*)lds;
    F.tid = threadIdx.x; F.lane = F.tid & 63; F.wave = __builtin_amdgcn_readfirstlane(F.tid >> 6);
    F.G = gridDim.x; { const int bx = blockIdx.x; F.vcu = (F.G % 8 == 0) ? (bx % 8) * (F.G / 8) + bx / 8 : bx; }
    F.ws = args.ws; F.dout = (unsigned char*)args.out; F.ctl = (unsigned*)(args.ws + WS_CTL);
#pragma unroll
    for (int i = 0; i < 23; ++i) F.in[i] = args.in[i];
    for (int u = F.tid; u < (LDS_BYTES - LDSCTL_OFF) / 4; u += NTHR) ((LAS unsigned*)(F.lds + LDSCTL_OFF))[u] = 0u;
    __syncthreads();
    XcdBarrier bar = xcd_barrier_post(F.ctl + CW_BAR, (volatile LAS unsigned*)(F.lds + MISC_OFF) + 8);

#ifndef PROBE_DUP
#define PROBE_DUP (-1)
#endif
#define RUN_PHASE(n, ...) do { __VA_ARGS__; if (PROBE_DUP == (n)) { xcd_barrier(bar); __VA_ARGS__; } } while (0)
    const LAS int* etb = (const LAS int*)(F.lds + L_ETAB);
    RUN_PHASE(0, p0_prologue(F));
    xcd_barrier(bar);
    RUN_PHASE(1, { DenseSched S; S.ord.init(T / 256, 12, F.G, (int)blockIdx.x); S.A = (const char*)(F.ws + WS_XN); S.Bt = (const char*)(F.ws + WS_WIN); S.K = D;
        EpiProj E{F.ws}; pg8::gemm_phase<EpiProj, DenseSched, true, true>(F.lds, D / 64, D * 2, S, E); });
    xcd_barrier(bar);
    { const float lam = compute_lambda(F);
      p2_attn_setup(F);
#pragma unroll 1
      for (int rep = 0; rep < (PROBE_DUP == 2 ? 2 : 1); ++rep) {
          if (rep) xcd_barrier(bar);
          for (int v = F.vcu; v < 256; v += F.G) { const int bh = v >> 2, ty = v & 3;
              if (ty == 0) p2_mlstm_fast(F, bh);
              const unsigned long long sched = ty == 0 ? 0x012ull : ty == 1 ? 0xDEFull : ty == 2 ? 0x8ABCull : 0x345679ull;
              const int nq = ty == 0 ? 3 : ty == 1 ? 3 : ty == 2 ? 4 : 6;
              const int pk0 = ty == 0 ? 0 : ty == 1 ? 6 : ty == 2 ? 22 : 33, pk1 = ty == 0 ? 6 : ty == 1 ? 22 : ty == 2 ? 33 : 48, nslot = ty == 2 ? 2 : 3; int slot = 0;
#pragma unroll 1
              for (int i = nq - 1, j = 0; i >= 0; --i, ++j) { const bool has = ty < 2 || (j & 1);
                  const int i0 = pk0 + (pk1 - pk0) * slot / nslot, i1 = pk0 + (pk1 - pk0) * (slot + 1) / nslot;
                  p2_attn_unit(F, lds, bh, (int)((sched >> (4 * i)) & 15ull), lam, has ? bh : -1, i0, i1); if (has) ++slot; }
          }
      }
    }
    xcd_barrier(bar);
    RUN_PHASE(3, { DenseSched S; S.ord.init(T / 256, 4, F.G, (int)blockIdx.x); S.A = (const char*)(F.ws + WS_XN); S.Bt = (const char*)(F.ws + WS_WOUT); S.K = D;
        EpiOutProj E{F.in[I_X], (bf16*)(F.ws + WS_X1B), F.ws + WS_X1F8}; pg8::gemm_phase<EpiOutProj, DenseSched, true, true>(F.lds, D / 64, D * 2, S, E); });
    xcd_barrier(bar);
    p4_route(F);
    xcd_barrier(bar);
    p4b_lists(F);
    xcd_barrier(bar);
    RUN_PHASE(5, { MoeSched8<true> S; S.ord.init(etb[NE], 8, F.G, (int)blockIdx.x); S.tb = etb; S.cn = etb + 40; S.A = (const char*)(F.ws + WS_X1F8); S.W = (const char*)(F.ws + WS_WGU); S.LIST = (const int*)(F.ws + WS_LIST); S.wrows = 2 * DFF;
        EpiGateUp8 E{etb, etb + 40, (const float*)(F.ws + WS_LISTRS), F.in[I_BGU], F.ws + WS_ACT};
        pg8::gemm_phase<EpiGateUp8, MoeSched8<true>, true, true, true, 0x79797979, 0x7f7f7f7f>(F.lds, D / 128, D, S, E); });
    xcd_barrier(bar);
    RUN_PHASE(6, { MoeSched8<false> S; S.ord.init(etb[NE], 4, F.G, (int)blockIdx.x); S.tb = etb; S.cn = etb + 40; S.A = (const char*)(F.ws + WS_ACT); S.W = (const char*)(F.ws + WS_WDOWN); S.LIST = nullptr; S.wrows = D;
        EpiDown E{F.in[I_BDN], F.ws + WS_YK};
        pg8::gemm_phase<EpiDown, MoeSched8<false>, true, true, true, 0x79797979, 0x7f7f7f7f>(F.lds, DFF / 128, DFF, S, E); });
    xcd_barrier(bar);
    RUN_PHASE(7, p7_final(F));
}

extern "C" void kernel_launch(void* const* d_in, const int* in_sizes, int n_in, void* d_out, int out_size, void* d_ws, size_t ws_size, hipStream_t stream) {
    static int grid = 0;
    if (grid == 0) {
        if (n_in != 23 || in_sizes[0] != T * D || out_size != T * D || ws_size < WS_END) { fprintf(stderr, "kernel_launch: unexpected shapes (n_in %d, in0 %d, out %d, ws %zu); nothing launched\n", n_in, n_in > 0 ? in_sizes[0] : -1, out_size, ws_size); grid = -1; return; }
        int dev = 0, cus = 0, per_cu = 0;
        if (hipGetDevice(&dev) != hipSuccess || hipDeviceGetAttribute(&cus, hipDeviceAttributeMultiprocessorCount, dev) != hipSuccess) { grid = -1; return; }
        if (hipFuncSetAttribute((const void*)hymba_fwd, hipFuncAttributeMaxDynamicSharedMemorySize, LDS_BYTES) != hipSuccess) { fprintf(stderr, "kernel_launch: hipFuncSetAttribute failed\n"); grid = -1; return; }
        if (hipOccupancyMaxActiveBlocksPerMultiprocessor(&per_cu, (const void*)hymba_fwd, NTHR, LDS_BYTES) != hipSuccess || per_cu < 1) fprintf(stderr, "kernel_launch: occupancy query reports %d\n", per_cu);
        (void)hipGetLastError();
        grid = cus;
    }
    if (grid < 0) return;
    if (hipMemsetAsync((char*)d_ws + WS_CTL, 0, CTL_ZERO_BYTES, stream) != hipSuccess) return;
    Args a{};
    for (int i = 0; i < 23; ++i) a.in[i] = (const float*)d_in[i];
    a.out = (float*)d_out; a.ws = (unsigned char*)d_ws;
    hipLaunchKernelGGL(hymba_fwd, dim3(grid), dim3(NTHR), LDS_BYTES, stream, a);
}
```

```cpp
#include <hip/hip_runtime.h>
#include <cstdio>
#include <cstdint>

#define GAS __attribute__((address_space(1)))
#define LAS __attribute__((address_space(3)))
typedef unsigned short bf16;
typedef unsigned v4u __attribute__((ext_vector_type(4)));
typedef unsigned v2u __attribute__((ext_vector_type(2)));
typedef float f32x4 __attribute__((ext_vector_type(4)));
typedef short bf16x8 __attribute__((ext_vector_type(8)));
#define RLX_AGENT __ATOMIC_RELAXED, __HIP_MEMORY_SCOPE_AGENT
#define LDS_WAIT() asm volatile("s_waitcnt lgkmcnt(0)" ::: "memory")
#define VM_WAIT() asm volatile("s_waitcnt vmcnt(0)" ::: "memory")

constexpr int NWAVES = 8, NTHR = 512;
constexpr int NB = 16, SEQ = 4096, T = NB * SEQ, D = 1024, INC = 3080;
constexpr int NE = 32, DFF = 1024;
constexpr float EPS = 1e-5f, LOG2E = 1.4426950408889634f, C2 = 0.125f * LOG2E;
constexpr float LAM_INIT = 0.2f;
constexpr int NR_MAX = 270336;

constexpr size_t MiB = 1u << 20;
constexpr size_t WS_CTL = 0, CTL_ZERO_BYTES = 1 * MiB;
constexpr size_t WS_GATES = 1 * MiB;
constexpr size_t WS_RSTD2 = 3 * MiB;
constexpr size_t WS_HIST = 3 * MiB + 512 * 1024;
constexpr size_t WS_TOKINFO = 4 * MiB;
constexpr size_t WS_GATE = 5 * MiB;
constexpr size_t WS_LIST = 6 * MiB;
constexpr size_t WS_WDOWN = 16 * MiB;
constexpr size_t WS_X1B = 80 * MiB;
constexpr size_t WS_ACT = 208 * MiB;
constexpr size_t WS_YK = 480 * MiB;
constexpr size_t WS_WGU = 480 * MiB;
constexpr size_t WS_X1F8 = 744 * MiB;
constexpr size_t WS_WIN = 608 * MiB;
constexpr size_t WS_WOUT = 614 * MiB;
constexpr size_t WS_XN = 616 * MiB;
constexpr size_t WS_MIX8 = 336 * MiB;
constexpr size_t WS_RSTD1 = 3 * MiB + 256 * 1024;
constexpr size_t WS_LISTRS = 1008 * MiB;
constexpr size_t WS_END = 1024 * MiB;
__host__ __device__ constexpr size_t proj_off(int buf) { return buf < 2 ? (208 + 64 * (size_t)buf) * MiB : (744 + 64 * (size_t)(buf - 2)) * MiB; }
constexpr size_t DO_OTMP = 128 * MiB;

constexpr int CW_TMO = 0;
constexpr int CW_BAR = 4096;
constexpr int CW_Q = 12288;
constexpr int CW_CNT = 8192;

constexpr int RING_BYTES = 131072;
constexpr int LDSCTL_OFF = RING_BYTES;
constexpr int L_HIST = LDSCTL_OFF, L_BASE = LDSCTL_OFF + 128, MISC_OFF = LDSCTL_OFF + 320, L_ETAB = LDSCTL_OFF + 512;
constexpr int LDS_BYTES = 147456;
constexpr int L_PEXP = LDSCTL_OFF + 1024;

__device__ __forceinline__ unsigned f2bf(float f) { unsigned u = __builtin_bit_cast(unsigned, f); return (u + 0x7fffu + ((u >> 16) & 1u)) >> 16; }
__device__ __forceinline__ unsigned pk2(float lo, float hi) { return f2bf(lo) | (f2bf(hi) << 16); }
typedef float f32x2_t __attribute__((ext_vector_type(2))); typedef __bf16 bf16x2_t __attribute__((ext_vector_type(2)));
__device__ __forceinline__ unsigned pkh(float lo, float hi) { f32x2_t v = {lo, hi}; bf16x2_t b = __builtin_convertvector(v, bf16x2_t); return __builtin_bit_cast(unsigned, b); }
__device__ __forceinline__ unsigned pk4_fp8(float a, float b, float c, float d) { int r = __builtin_amdgcn_cvt_pk_fp8_f32(a, b, 0, false); r = __builtin_amdgcn_cvt_pk_fp8_f32(c, d, r, true); return (unsigned)r; }
__device__ __forceinline__ float bflo(unsigned u) { return __uint_as_float(u << 16); }
__device__ __forceinline__ float bfhi(unsigned u) { return __uint_as_float(u & 0xffff0000u); }
__device__ __forceinline__ float bf2f(bf16 b) { return __uint_as_float((unsigned)b << 16); }
template <int CTRL, int ROWMASK> __device__ __forceinline__ float dpp_f(float oldv, float v) {
    return __int_as_float(__builtin_amdgcn_update_dpp(__float_as_int(oldv), __float_as_int(v), CTRL, ROWMASK, 0xF, false)); }
__device__ __forceinline__ float lane63(float v) { return __int_as_float(__builtin_amdgcn_readlane(__float_as_int(v), 63)); }
__device__ __forceinline__ float wave_sum(float v) {
    v += dpp_f<0xB1, 0xF>(0.f, v); v += dpp_f<0x4E, 0xF>(0.f, v); v += dpp_f<0x141, 0xF>(0.f, v); v += dpp_f<0x140, 0xF>(0.f, v);
    v += dpp_f<0x142, 0xA>(0.f, v); v += dpp_f<0x143, 0xC>(0.f, v);
    return lane63(v);
}
__device__ __forceinline__ float wave_scan_add(float v) {
    v += dpp_f<0x111, 0xF>(0.f, v); v += dpp_f<0x112, 0xF>(0.f, v); v += dpp_f<0x114, 0xF>(0.f, v); v += dpp_f<0x118, 0xF>(0.f, v);
    v += dpp_f<0x142, 0xA>(0.f, v); v += dpp_f<0x143, 0xC>(0.f, v);
    return v;
}
__device__ __forceinline__ float wave_scan_max(float v) {
    const float NI = -INFINITY;
    v = fmaxf(v, dpp_f<0x111, 0xF>(NI, v)); v = fmaxf(v, dpp_f<0x112, 0xF>(NI, v)); v = fmaxf(v, dpp_f<0x114, 0xF>(NI, v)); v = fmaxf(v, dpp_f<0x118, 0xF>(NI, v));
    v = fmaxf(v, dpp_f<0x142, 0xA>(NI, v)); v = fmaxf(v, dpp_f<0x143, 0xC>(NI, v));
    return v;
}
__device__ __forceinline__ float sigmoidf_(float x) { return __builtin_amdgcn_rcpf(1.f + __expf(-x)); }

#define XB_TMO      128
#define XB_XCNT(j)  (256  + 64 * (j))
#define XB_XSUB(j)  (1280 + 64 * (j))
#define XB_XGEN(j)  (2304 + 64 * (j))
#define XB_TOP      3328
#define XB_TOPGEN   3392
#define XCD_BAR_WORDS 3456
#define XB_SPIN_CAP (1u << 18)
__device__ __forceinline__ unsigned xb_ld(unsigned* p)              { return __hip_atomic_load(p, __ATOMIC_RELAXED, __HIP_MEMORY_SCOPE_AGENT); }
__device__ __forceinline__ unsigned xb_add(unsigned* p, unsigned v) { return __hip_atomic_fetch_add(p, v, __ATOMIC_RELAXED, __HIP_MEMORY_SCOPE_AGENT); }
__device__ __forceinline__ unsigned xb_xcc_id() { return (unsigned)__builtin_amdgcn_s_getreg((3 << 11) | 20) & 0xFu; }
#define XB_SPIN(cond, bar) do { unsigned _sp = 0; while (cond) { __builtin_amdgcn_s_sleep(1); \
    if ((++_sp & 255u) == 0u) { if (xb_ld(&(bar)[XB_TMO])) break; if (_sp > XB_SPIN_CAP) { atomicAdd(&(bar)[XB_TMO], 1u); break; } } } } while (0)
struct XcdBarrier { unsigned* bar; unsigned x; volatile LAS unsigned* st; };
__device__ __forceinline__ XcdBarrier xcd_barrier_post(unsigned* bar, volatile LAS unsigned* st) {
    XcdBarrier b; b.bar = bar; b.x = xb_xcc_id(); b.st = st;
    if (threadIdx.x == 0) (void)xb_add(&bar[XB_XCNT(b.x)], 1u);
    return b;
}
__device__ __forceinline__ void xcd_barrier_complete(unsigned* bar, unsigned x, unsigned& nloc, unsigned& nx) {
    const unsigned G = gridDim.x * gridDim.y * gridDim.z;
    unsigned sum, cnt, mine, sp = 0u;
    for (;;) {
        sum = 0u; cnt = 0u; mine = 0u;
#pragma unroll
        for (unsigned j = 0; j < 16; ++j) { const unsigned c = xb_ld(&bar[XB_XCNT(j)]); sum += c; cnt += (c > 0u) ? 1u : 0u; mine = (j == x) ? c : mine; }
        if (sum == G) break;
        __builtin_amdgcn_s_sleep(1);
        if ((++sp & 255u) == 0u) { if (xb_ld(&bar[XB_TMO])) break; if (sp > XB_SPIN_CAP) { atomicAdd(&bar[XB_TMO], 1u); break; } }
    }
    nloc = mine > 0u ? mine : 1u; nx = cnt > 0u ? cnt : 1u;
}
__device__ __forceinline__ void xcd_barrier(const XcdBarrier& b) {
    asm volatile("s_waitcnt vmcnt(0)" ::: "memory");
    __syncthreads();
    if (threadIdx.x == 0) {
        unsigned* bar = b.bar;
        __builtin_amdgcn_s_waitcnt(0);
        unsigned nloc = b.st[0], nx = b.st[1];
        if (nloc == 0u) { xcd_barrier_complete(bar, b.x, nloc, nx); b.st[0] = nloc; b.st[1] = nx; }
        const unsigned old = xb_add(&bar[XB_XSUB(b.x)], 1u);
        const unsigned gen = old / nloc;
        if (old + 1u == (gen + 1u) * nloc) {
            __builtin_amdgcn_fence(__ATOMIC_RELEASE, "agent");
            asm volatile("s_waitcnt vmcnt(0)" ::: "memory");
            const unsigned og = xb_add(&bar[XB_TOP], 1u);
            const unsigned tg = og / nx;
            if (og + 1u == (tg + 1u) * nx) xb_add(&bar[XB_TOPGEN], 1u);
            else XB_SPIN(xb_ld(&bar[XB_TOPGEN]) == tg, bar);
            __builtin_amdgcn_fence(__ATOMIC_ACQUIRE, "agent");
            xb_add(&bar[XB_XGEN(b.x)], 1u);
            asm volatile("s_waitcnt vmcnt(0)" ::: "memory");
        } else {
            XB_SPIN(xb_ld(&bar[XB_XGEN(b.x)]) == gen, bar);
            __builtin_amdgcn_fence(__ATOMIC_ACQUIRE, "agent");
            asm volatile("s_waitcnt vmcnt(0)" ::: "memory");
        }
    }
    __syncthreads();
}

struct Args { const float* in[23]; float* out; unsigned char* ws; };
struct Frame {
    LAS unsigned char* lds;
    unsigned* ctl;
    int tid, lane, wave, G, vcu;
    const float* in[23];
    unsigned char* ws; unsigned char* dout;
};
enum { I_X = 0, I_G1, I_WIN, I_REL, I_LQ1, I_LK1, I_LQ2, I_LK2, I_DNG, I_CONVW, I_CONVB, I_GATEB, I_OB, I_MLG, I_WOUT, I_G2, I_RW, I_RB, I_WGU, I_BGU, I_WDN, I_BDN, I_GF };

__device__ __forceinline__ bf16* proj_buf(const Frame& F, int b) { return (bf16*)(F.ws + proj_off(b)); }

__device__ __forceinline__ void tr_item(const float* W, int ldw, int k0, int n0, bf16* WT, int K, int r0, const float* gk, LAS float* scr, int lane) {
#pragma unroll
    for (int i = 0; i < 32; ++i) { const int kk = 2 * i + (lane >> 5); scr[kk * 33 + (lane & 31)] = W[(size_t)(k0 + kk) * ldw + n0 + (lane & 31)]; }
    LDS_WAIT(); asm volatile("" ::: "memory");
    const int c = lane & 7;
    float gv[8];
#pragma unroll
    for (int i = 0; i < 8; ++i) gv[i] = gk ? gk[k0 + 8 * c + i] : 1.f;
#pragma unroll
    for (int j = 0; j < 4; ++j) { const int n = (lane >> 3) + 8 * j; const LAS float* s = scr + (8 * c) * 33 + n;
        v4u o; o.x = pk2(s[0 * 33] * gv[0], s[1 * 33] * gv[1]); o.y = pk2(s[2 * 33] * gv[2], s[3 * 33] * gv[3]); o.z = pk2(s[4 * 33] * gv[4], s[5 * 33] * gv[5]); o.w = pk2(s[6 * 33] * gv[6], s[7 * 33] * gv[7]);
        *(v4u*)(WT + (size_t)(r0 + n) * K + k0 + 8 * c) = o; }
    LDS_WAIT(); asm volatile("" ::: "memory");
}

__device__ __forceinline__ void tr_item8(const float* W, int ldw, int k0, int n0, unsigned char* WT, int K, int r0, const float* gk, float wscale, LAS float* scr, int lane) {
#pragma unroll 8
    for (int i = 0; i < 32; ++i) { const int kk = 2 * i + (lane >> 5); scr[kk * 33 + (lane & 31)] = W[(size_t)(k0 + kk) * ldw + n0 + (lane & 31)]; }
    LDS_WAIT(); asm volatile("" ::: "memory");
    const int c = lane & 7;
    float gv[8];
#pragma unroll
    for (int i = 0; i < 8; ++i) gv[i] = (gk ? gk[k0 + 8 * c + i] : 1.f) * wscale;
#pragma unroll
    for (int j = 0; j < 4; ++j) { const int n = (lane >> 3) + 8 * j; const LAS float* sp = scr + (8 * c) * 33 + n;
        v2u o; o.x = pk4_fp8(sp[0 * 33] * gv[0], sp[1 * 33] * gv[1], sp[2 * 33] * gv[2], sp[3 * 33] * gv[3]); o.y = pk4_fp8(sp[4 * 33] * gv[4], sp[5 * 33] * gv[5], sp[6 * 33] * gv[6], sp[7 * 33] * gv[7]);
        *(v2u*)(WT + (size_t)(r0 + n) * K + k0 + 8 * c) = o; }
    LDS_WAIT(); asm volatile("" ::: "memory");
}

__device__ __forceinline__ float log_sigmoid(float x) { return fminf(x, 0.f) - log1pf(__expf(-fabsf(x))); }

__device__ __forceinline__ void p0_prologue(Frame& F_) {
    Frame F = F_; { int t_ = F.tid; asm volatile("" : "+v"(t_)); F.tid = t_; F.lane = t_ & 63; }
    LAS float* scr = (LAS float*)(F.lds + F.wave * 8704);
    const int gw = F.vcu * NWAVES + F.wave, NGW = F.G * NWAVES;
    constexpr int I_IN = 16 * 96, I_OUT = 16 * 32;
    constexpr int NITEMS = I_IN + I_OUT;
    for (int it = gw; it < NITEMS; it += NGW) {
        int r = it;
        if (r < I_IN) { const int kb = r / 96, nb = r % 96; tr_item(F.in[I_WIN], INC, 64 * kb, 32 * nb, (bf16*)(F.ws + WS_WIN), D, 32 * nb, F.in[I_G1], scr, F.lane); continue; } r -= I_IN;
        { const int kb = r / 32, nb = r % 32; tr_item8(F.in[I_WOUT], D, 64 * kb, 32 * nb, F.ws + WS_WOUT, D, 32 * nb, nullptr, 64.f, scr, F.lane); }
    }
    __syncthreads();
    LAS float* wg = (LAS float*)F.lds;
    { float tmp[D * 8 / NTHR];
#pragma unroll
      for (int j = 0; j < D * 8 / NTHR; ++j) { const int i = F.tid + j * NTHR; tmp[j] = F.in[I_WIN][(size_t)(i >> 3) * INC + 3072 + (i & 7)] * F.in[I_G1][i >> 3]; }
#pragma unroll
      for (int j = 0; j < D * 8 / NTHR; ++j) { const int i = F.tid + j * NTHR; wg[(i & 7) * D + (i >> 3)] = tmp[j]; } }
    __syncthreads();
    const float* x = F.in[I_X]; const float* gb = F.in[I_GATEB];
    bf16* XN = (bf16*)(F.ws + WS_XN); float* GT = (float*)(F.ws + WS_GATES);
    const float gbv = gb[(F.lane >> 3) & 7];
    constexpr int RPS = 4;
    for (int m0 = gw; m0 < T; m0 += RPS * NGW) {
        f32x4 v[RPS][4]; float s[RPS];
#pragma unroll
        for (int r = 0; r < RPS; ++r) { const int mm = m0 + r * NGW; const int m = mm < T ? mm : m0; const f32x4* xr = (const f32x4*)(x + (size_t)m * D) + F.lane;
#pragma unroll
            for (int j = 0; j < 4; ++j) v[r][j] = xr[64 * j]; }
#pragma unroll
        for (int r = 0; r < RPS; ++r) { s[r] = 0.f;
#pragma unroll
            for (int j = 0; j < 4; ++j) s[r] += (v[r][j].x * v[r][j].x + v[r][j].y * v[r][j].y) + (v[r][j].z * v[r][j].z + v[r][j].w * v[r][j].w); }
#pragma unroll
        for (int r = 0; r < RPS; ++r) s[r] = wave_sum(s[r]);
#pragma unroll
        for (int r = 0; r < RPS; ++r) { const int m = m0 + r * NGW; if (m >= T) break;
            const float rstd = rsqrtf(s[r] * (1.f / D) + EPS);
            if (F.lane == 0) GT[(WS_RSTD1 - WS_GATES) / 4 + m] = sqrtf(s[r] * (1.f / D) + EPS);
            float ga[8];
#pragma unroll
            for (int i = 0; i < 8; ++i) ga[i] = 0.f;
            unsigned long long* o8 = (unsigned long long*)(XN + (size_t)m * D) + F.lane;
#pragma unroll
            for (int j = 0; j < 4; ++j) {
                const f32x4 h = v[r][j] * rstd;
                o8[64 * j] = (unsigned long long)pkh(h.x, h.y) | ((unsigned long long)pkh(h.z, h.w) << 32);
#pragma unroll
                for (int gi = 0; gi < 8; ++gi) { const f32x4 w = *(const LAS f32x4*)(wg + gi * D + 256 * j + 4 * F.lane); ga[gi] += (h.x * w.x + h.y * w.y) + (h.z * w.z + h.w * w.w); }
            }
#pragma unroll
            for (int i = 0; i < 4; ++i) { const bool up = (F.lane & 32) != 0; const float send = up ? ga[i] : ga[4 + i], keep = up ? ga[4 + i] : ga[i]; ga[i] = keep + __shfl_xor(send, 32); }
#pragma unroll
            for (int i = 0; i < 2; ++i) { const bool up = (F.lane & 16) != 0; const float send = up ? ga[i] : ga[2 + i], keep = up ? ga[2 + i] : ga[i]; ga[i] = keep + __shfl_xor(send, 16); }
            { const bool up = (F.lane & 8) != 0; const float send = up ? ga[0] : ga[1], keep = up ? ga[1] : ga[0]; ga[0] = keep + __shfl_xor(send, 8); }
            ga[0] += __shfl_xor(ga[0], 4); ga[0] += __shfl_xor(ga[0], 2); ga[0] += __shfl_xor(ga[0], 1);
            { const int gi = (F.lane >> 3) & 7; const float vv = ga[0] + gbv;
              if ((F.lane & 7) == 0) GT[(size_t)m * 8 + gi] = gi < 4 ? vv : log_sigmoid(vv); }
        }
    }
}


namespace pg8 {
#define PG8_LAS __attribute__((address_space(3)))
constexpr int BM = 256, BK = 64, HALF = 128, HTB = HALF * BK * 2, STAGE_BYTES = 8 * HTB, NXCD = 8, WGM = 8;
__host__ __device__ __forceinline__ int lds_byte(int r, int c) { const int st = (r >> 4) * 2 + (c >> 5), rr = r & 15, cc = c & 31, ob = rr * 64 + cc * 2; return st * 1024 + (ob ^ (((ob >> 9) & 1) << 5)); }
__host__ __device__ __forceinline__ void stage_rc(int b, int& R, int& C) { const int st = b / 1024, sb = b % 1024, swz = sb ^ (((sb >> 9) & 1) << 5); R = (st >> 1) * 16 + swz / 64; C = (st & 1) * 32 + (swz % 64) / 2; }
__host__ __device__ __forceinline__ int perm32(int rho) { const int n = rho >> 4, i = rho & 15; return 8 * (i >> 2) + 4 * n + (i & 3); }
struct Unit { int pm, pn, e, pos0, cnt; };
constexpr int UTAB_OFF = 131072 + 8192, UTAB_MAX = 128;
struct TileOrder {
    int nM, nN, nwg, G, c;
    __device__ void init(int nM_, int nN_, int G_, int c_) { nM = nM_; nN = nN_; nwg = nM * nN; G = G_; c = c_; }
    __device__ bool next_tile(int i, int& pm, int& pn) const {
        const long L = (long)i * G + c; if (L >= nwg) return false;
        int wgid = (int)L; { const int q = nwg / NXCD, r = nwg % NXCD, xcd = wgid % NXCD, off = wgid / NXCD; wgid = (xcd < r ? xcd * (q + 1) : r * (q + 1) + (xcd - r) * q) + off; }
        const int nig = WGM * nN, gid = wgid / nig, fm = gid * WGM, gsz = (nM - fm) < WGM ? (nM - fm) : WGM;
        pm = fm + ((wgid % nig) % gsz); pn = (wgid % nig) / gsz; return true;
    }
};
__device__ __forceinline__ unsigned cvt_pk_bf16(float lo, float hi) { unsigned r; asm volatile("v_cvt_pk_bf16_f32 %0, %1, %2" : "=v"(r) : "v"(lo), "v"(hi)); return r; }

typedef int v8i_t __attribute__((ext_vector_type(8))); typedef int v4i_t __attribute__((ext_vector_type(4)));
template <class Epi, class Sched, bool ALIGN_EPI, bool SP2, bool F8 = false, int SCA = 0x7f7f7f7f, int SCB = 0x7f7f7f7f>
__device__ __forceinline__ void gemm_phase(PG8_LAS unsigned char* lds, const int nt, const int pitchB, const Sched& S, const Epi& E) {
    static_assert(SP2, "only the SP2 loop is carried here");
    int tid = threadIdx.x; asm volatile("" : "+v"(tid));
    const int wid = __builtin_amdgcn_readfirstlane(tid >> 6), lane = tid & 63, wr = wid >> 2, wc = wid & 3, fr = lane & 15, fq = lane >> 4;
    int RA[2], CA[2]; unsigned voffB[2];
#pragma unroll
    for (int i = 0; i < 2; ++i) { int R, C; stage_rc(tid * 16 + i * 8192, R, C); RA[i] = R; CA[i] = C; const int Rb = (R & ~31) + perm32(R & 31); voffB[i] = (unsigned)(Rb * pitchB + C * 2); }
    const size_t kstep = (size_t)(BK * 2);
    const size_t hstep = (size_t)HALF * pitchB;
    const unsigned ldsw = (unsigned)wid * 1024u;
    const int aoff = lds_byte(wr * 64 + fr, fq * 8), boff = lds_byte(wc * 32 + fr, fq * 8);
#define PG8_SA(b, h) (((b) * 2 + (h)) * HTB)
#define PG8_SB(b, h) ((4 + (b) * 2 + (h)) * HTB)
#define PG8_STAGE(bufoff, gbase, voff) do { _Pragma("unroll") for (int _i = 0; _i < 2; ++_i) \
        __builtin_amdgcn_global_load_lds((const unsigned*)((const char*)(gbase) + (voff)[_i]), (PG8_LAS unsigned*)(lds + (bufoff) + ldsw + _i * 8192), 16, 0, 0); } while (0)
#define PG8_LDA(dst, b, h) do { if constexpr (F8) { _Pragma("unroll") for (int m = 0; m < 4; ++m) { dst##8[m].lo = *(const PG8_LAS v4i_t*)(lds + PG8_SA(b, h) + aoff + m * 2048); dst##8[m].hi = *(const PG8_LAS v4i_t*)(lds + PG8_SA(b, h) + aoff + m * 2048 + 1024); } } \
        else { _Pragma("unroll") for (int m = 0; m < 4; ++m) _Pragma("unroll") for (int k = 0; k < 2; ++k) dst[m][k] = *(const PG8_LAS bf16x8*)(lds + PG8_SA(b, h) + aoff + m * 2048 + k * 1024); } } while (0)
#define PG8_LDB(dst, b, h) do { if constexpr (F8) { _Pragma("unroll") for (int n = 0; n < 2; ++n) { dst##8[n].lo = *(const PG8_LAS v4i_t*)(lds + PG8_SB(b, h) + boff + n * 2048); dst##8[n].hi = *(const PG8_LAS v4i_t*)(lds + PG8_SB(b, h) + boff + n * 2048 + 1024); } } \
        else { _Pragma("unroll") for (int n = 0; n < 2; ++n) _Pragma("unroll") for (int k = 0; k < 2; ++k) dst[n][k] = *(const PG8_LAS bf16x8*)(lds + PG8_SB(b, h) + boff + n * 2048 + k * 1024); } } while (0)
#define PG8_MMA(ai, bj, At, Bt) do { __builtin_amdgcn_s_setprio(1); _Pragma("unroll") for (int m = 0; m < 4; ++m) _Pragma("unroll") for (int n = 0; n < 2; ++n) { \
        if constexpr (F8) asm volatile("v_mfma_scale_f32_16x16x128_f8f6f4 %0, %1, %2, %0, %3, %4 op_sel_hi:[0,0,0]" : "+v"(acc[ai][bj][m][n]) : "v"(Bt##8[n]), "v"(At##8[m]), "v"(sca_), "v"(scb_));   \
        else { _Pragma("unroll") for (int k = 0; k < 2; ++k) acc[ai][bj][m][n] = __builtin_amdgcn_mfma_f32_16x16x32_bf16(Bt[n][k], At[m][k], acc[ai][bj][m][n], 0, 0, 0); } } \
        __builtin_amdgcn_s_setprio(0); } while (0)
#define PG8_MMA0(ai, bj, At, Bt) do { __builtin_amdgcn_s_setprio(1); _Pragma("unroll") for (int m = 0; m < 4; ++m) _Pragma("unroll") for (int n = 0; n < 2; ++n) { \
        if constexpr (F8) asm volatile("v_mfma_scale_f32_16x16x128_f8f6f4 %0, %1, %2, 0, %3, %4 op_sel_hi:[0,0,0]" : "=v"(acc[ai][bj][m][n]) : "v"(Bt##8[n]), "v"(At##8[m]), "v"(sca_), "v"(scb_)); \
        else { acc[ai][bj][m][n] = __builtin_amdgcn_mfma_f32_16x16x32_bf16(Bt[n][0], At[m][0], (f32x4){0.f, 0.f, 0.f, 0.f}, 0, 0, 0); acc[ai][bj][m][n] = __builtin_amdgcn_mfma_f32_16x16x32_bf16(Bt[n][1], At[m][1], acc[ai][bj][m][n], 0, 0, 0); } } \
        __builtin_amdgcn_s_setprio(0); } while (0)
#define PG8_WAIT_V(n) asm volatile("s_waitcnt vmcnt(" #n ")" ::: "memory")
#define PG8_WAIT_L(n) asm volatile("s_waitcnt lgkmcnt(" #n ")" ::: "memory")
#define PG8_BAR __builtin_amdgcn_s_barrier()
#define PG8_SCHED __builtin_amdgcn_sched_barrier(0)
    Unit cur, nxt; int ui = 0;
    PG8_LAS int* utab = (PG8_LAS int*)(lds + UTAB_OFF);
    if (tid < UTAB_MAX) { Unit u_; u_.pm = 0; u_.pn = 0; u_.e = 0; u_.pos0 = 0; u_.cnt = 0; const bool ok_ = S.next(tid, u_);
        utab[tid * 8 + 0] = u_.pm; utab[tid * 8 + 1] = u_.pn; utab[tid * 8 + 2] = u_.e; utab[tid * 8 + 3] = u_.pos0; utab[tid * 8 + 4] = u_.cnt; utab[tid * 8 + 5] = ok_ ? 1 : 0; }
    asm volatile("s_waitcnt lgkmcnt(0)\n\ts_barrier" ::: "memory");
    auto unit_at = [&](const int i, Unit& u) -> bool {
        if (i >= UTAB_MAX) return false;
        const v4i_t q = *(const PG8_LAS v4i_t*)(utab + i * 8); const int c4 = utab[i * 8 + 4], ok = utab[i * 8 + 5];
        u.pm = __builtin_amdgcn_readfirstlane(q.x); u.pn = __builtin_amdgcn_readfirstlane(q.y); u.e = __builtin_amdgcn_readfirstlane(q.z); u.pos0 = __builtin_amdgcn_readfirstlane(q.w); u.cnt = __builtin_amdgcn_readfirstlane(c4);
        return __builtin_amdgcn_readfirstlane(ok) != 0; };
    if (!unit_at(0, cur)) return;
    f32x4 acc[2][2][4][2];
    if constexpr (!F8) {
#pragma unroll
        for (int a = 0; a < 2; ++a)
#pragma unroll
            for (int b = 0; b < 2; ++b)
#pragma unroll
                for (int m = 0; m < 4; ++m)
#pragma unroll
                    for (int n = 0; n < 2; ++n) acc[a][b][m][n] = (f32x4){0.f, 0.f, 0.f, 0.f};
    }
    const int sca_ = SCA, scb_ = SCB;
    bf16x8 At[4][2], B0[2][2], B1[2][2];
    v8i_t At8[4], B08[2], B18[2];
    const char* cA; unsigned cAo[2][2]; S.a_view(cur, RA, CA, cA, cAo);
    const char* cB = S.b_base(cur);
    const int kmask = nt - 1, kq4 = nt >> 2;
    int rc = (cur.pn * kq4 + cur.pm) & kmask;
    { const size_t k0 = (size_t)rc * kstep, k1 = (size_t)((rc + 1) & kmask) * kstep;
      PG8_STAGE(PG8_SB(0, 0), cB + k0, voffB); PG8_STAGE(PG8_SB(0, 1), cB + hstep + k0, voffB); PG8_STAGE(PG8_SA(0, 0), cA + k0, cAo[0]); PG8_STAGE(PG8_SA(0, 1), cA + k0, cAo[1]);
      if (wr == 1) PG8_BAR;
      PG8_WAIT_V(2); PG8_BAR;
      PG8_STAGE(PG8_SB(1, 0), cB + k1, voffB); PG8_STAGE(PG8_SA(1, 0), cA + k1, cAo[0]); PG8_STAGE(PG8_SB(1, 1), cB + hstep + k1, voffB);
      PG8_WAIT_V(6); PG8_BAR; }
    for (;;) {
        const bool has_next = unit_at(ui + 1, nxt);
        const int rn = has_next ? ((nxt.pn * kq4 + nxt.pm) & kmask) : rc;
        const char* nA = cA; const char* nB = cB; unsigned nAo[2][2];
#pragma unroll
        for (int h = 0; h < 2; ++h)
#pragma unroll
            for (int i = 0; i < 2; ++i) nAo[h][i] = cAo[h][i];
        unsigned pre[2][2] = {{0u, 0u}, {0u, 0u}};
        E.pre(cur, wid, lane, ui & 1);
        if (has_next) { S.a_pre(nxt, RA, pre); nB = S.b_base(nxt); }
        for (int t = 0; t < nt; t += 2) {
            const bool last = (t == nt - 2);
            if (last && has_next) S.a_post(nxt, pre, RA, CA, nA, nAo);
            const char* a1 = cA + (size_t)((t + 1 + rc) & kmask) * kstep;
            const int k2 = last ? rn : ((t + 2 + rc) & kmask), k3 = last ? ((rn + 1) & kmask) : ((t + 3 + rc) & kmask);
            const char* a2 = (last ? nA : cA) + (size_t)k2 * kstep; const char* b2 = (last ? nB : cB) + (size_t)k2 * kstep;
            const char* a3 = (last ? nA : cA) + (size_t)k3 * kstep; const char* b3 = (last ? nB : cB) + (size_t)k3 * kstep;
            unsigned o2[2][2];
#pragma unroll
            for (int h = 0; h < 2; ++h)
#pragma unroll
                for (int i = 0; i < 2; ++i) o2[h][i] = last ? nAo[h][i] : cAo[h][i];
            PG8_LDB(B0, 0, 0); PG8_LDB(B1, 0, 1); PG8_SCHED; PG8_LDA(At, 0, 0); PG8_STAGE(PG8_SA(1, 1), a1, cAo[1]);
            PG8_WAIT_V(8); PG8_WAIT_L(0); PG8_BAR; if (F8 && t == 0) { PG8_MMA0(0, 0, At, B0); PG8_MMA0(0, 1, At, B1); } else { PG8_MMA(0, 0, At, B0); PG8_MMA(0, 1, At, B1); } PG8_BAR; PG8_SCHED;
            PG8_LDA(At, 0, 1); PG8_STAGE(PG8_SB(0, 0), b2, voffB); PG8_STAGE(PG8_SB(0, 1), b2 + hstep, voffB); PG8_STAGE(PG8_SA(0, 0), a2, o2[0]);
            PG8_WAIT_V(8); PG8_WAIT_L(0); PG8_BAR; if (F8 && t == 0) { PG8_MMA0(1, 0, At, B0); PG8_MMA0(1, 1, At, B1); } else { PG8_MMA(1, 0, At, B0); PG8_MMA(1, 1, At, B1); } PG8_BAR; PG8_SCHED;
            PG8_LDB(B0, 1, 0); PG8_LDB(B1, 1, 1); PG8_SCHED; PG8_LDA(At, 1, 0); PG8_STAGE(PG8_SA(0, 1), a2, o2[1]);
            PG8_WAIT_V(8); PG8_WAIT_L(0); PG8_BAR; PG8_MMA(0, 0, At, B0); PG8_MMA(0, 1, At, B1); PG8_BAR; PG8_SCHED;
            PG8_LDA(At, 1, 1); PG8_STAGE(PG8_SB(1, 0), b3, voffB); PG8_STAGE(PG8_SB(1, 1), b3 + hstep, voffB); PG8_STAGE(PG8_SA(1, 0), a3, o2[0]);
            PG8_WAIT_V(8); PG8_WAIT_L(0); PG8_BAR; PG8_MMA(1, 0, At, B0); PG8_MMA(1, 1, At, B1); PG8_BAR; PG8_SCHED;
        }
        if constexpr (ALIGN_EPI) { if (wr == 0) PG8_BAR; }
        if constexpr (F8) asm volatile("s_nop 15\n\ts_nop 7" ::: "memory");
        E(acc, cur, wr, wc, fr, fq, ui & 1);
        if (!has_next) break;
        if constexpr (!F8) {
#pragma unroll
            for (int a = 0; a < 2; ++a)
#pragma unroll
                for (int b = 0; b < 2; ++b)
#pragma unroll
                    for (int m = 0; m < 4; ++m)
#pragma unroll
                        for (int n = 0; n < 2; ++n) acc[a][b][m][n] = (f32x4){0.f, 0.f, 0.f, 0.f};
        }
        cur = nxt; cA = nA; cB = nB; rc = rn; ++ui;
#pragma unroll
        for (int h = 0; h < 2; ++h)
#pragma unroll
            for (int i = 0; i < 2; ++i) cAo[h][i] = nAo[h][i];
        if constexpr (ALIGN_EPI) { if (wr == 1) PG8_BAR; }
    }
    PG8_WAIT_V(0);
    if constexpr (!ALIGN_EPI) { if (wr == 0) PG8_BAR; }
    PG8_BAR;
#undef PG8_SA
#undef PG8_SB
#undef PG8_STAGE
#undef PG8_LDA
#undef PG8_LDB
#undef PG8_MMA
#undef PG8_MMA0
#undef PG8_WAIT_V
#undef PG8_WAIT_L
#undef PG8_BAR
#undef PG8_SCHED
}
}

__device__ const unsigned char T5_BUCKET[128] = {0, 1, 2, 3, 4, 5, 6, 7, 8, 9, 10, 11, 12, 13, 14, 15, 16, 16, 16, 17, 17, 18, 18, 18, 19, 19, 19, 20, 20, 20, 20, 21, 21, 21, 21, 22, 22, 22, 22, 22, 23, 23, 23, 23, 23, 23, 24, 24, 24, 24, 24, 24, 25, 25, 25, 25, 25, 25, 25, 26, 26, 26, 26, 26, 26, 26, 26, 27, 27, 27, 27, 27, 27, 27, 27, 27, 27, 28, 28, 28, 28, 28, 28, 28, 28, 28, 28, 29, 29, 29, 29, 29, 29, 29, 29, 29, 29, 29, 29, 30, 30, 30, 30, 30, 30, 30, 30, 30, 30, 30, 30, 30, 30, 31, 31, 31, 31, 31, 31, 31, 31, 31, 31, 31, 31, 31, 31, 31};

__device__ __forceinline__ float compute_lambda(const Frame& F) {
    const int l = threadIdx.x & 63;
    const float p1 = F.in[I_LQ1][l] * F.in[I_LK1][l], p2 = F.in[I_LQ2][l] * F.in[I_LK2][l];
    const float s1 = wave_sum(p1), s2 = wave_sum(p2);
    return __expf(s1) - __expf(s2) + LAM_INIT;
}

namespace attn_body {
using bf16=unsigned short;
using bf16x8=__attribute__((ext_vector_type(8)))short;
using s16x4=__attribute__((ext_vector_type(4)))short;
using f32x16=__attribute__((ext_vector_type(16)))float;
using u32x4=__attribute__((ext_vector_type(4)))unsigned;
constexpr int SEQ=4096,D=64,DM=512,OP=1024;
constexpr int NW=8,QBLK=32,QB=QBLK*NW,KVBLK=64,NQB=SEQ/QB;
__device__ __forceinline__ int crow(int r,int hi){return (r&3)+8*(r>>2)+4*hi;}
#define SBAR() __builtin_amdgcn_sched_barrier(0)
__device__ __forceinline__ void cmask(f32x16&p0,f32x16&p1,int jb,int qrel,int hi){
  const float NEG=-INFINITY; int kb=64*jb+4*hi;
  #pragma unroll
  for(int r=0;r<16;++r){int kv=kb+(r&3)+8*(r>>2); if(kv>qrel)p0[r]=NEG; if(kv+32>qrel)p1[r]=NEG;}
}

typedef __attribute__((address_space(3))) const float* lds_cfptr;
__device__ __forceinline__ void bcorr(f32x16&p0,f32x16&p1,int jb,int qrel,int hi,lds_cfptr dtab){
  lds_cfptr tp=dtab+(qrel+256-64*jb-4*hi-59);
  float t0[16],t1[16];
  #pragma unroll
  for(int r=0;r<16;++r){const int c=(r&3)+8*(r>>2); t0[r]=tp[59-c]; t1[r]=tp[27-c];}
  asm volatile("":"+v"(t0[0]),"+v"(t0[1]),"+v"(t0[2]),"+v"(t0[3]),"+v"(t0[4]),"+v"(t0[5]),"+v"(t0[6]),"+v"(t0[7]));
  asm volatile("":"+v"(t0[8]),"+v"(t0[9]),"+v"(t0[10]),"+v"(t0[11]),"+v"(t0[12]),"+v"(t0[13]),"+v"(t0[14]),"+v"(t0[15]));
  asm volatile("":"+v"(t1[0]),"+v"(t1[1]),"+v"(t1[2]),"+v"(t1[3]),"+v"(t1[4]),"+v"(t1[5]),"+v"(t1[6]),"+v"(t1[7]));
  asm volatile("":"+v"(t1[8]),"+v"(t1[9]),"+v"(t1[10]),"+v"(t1[11]),"+v"(t1[12]),"+v"(t1[13]),"+v"(t1[14]),"+v"(t1[15]));
  #pragma unroll
  for(int r=0;r<16;++r){p0[r]+=t0[r]; p1[r]+=t1[r];}
}
constexpr int NSLOT=3, SLOTB=8192;
constexpr int LDS_K=0, LDS_V=NSLOT*SLOTB, LDS_WS=2*NSLOT*SLOTB, LDS_OST=LDS_WS+NW*64*4, LDS_BYTES=LDS_OST+NW*4096;
__device__ __forceinline__ void glds16(const void*gsrc,unsigned lds_dst){unsigned keep;
  asm volatile("s_mov_b32 %0, m0\n\ts_mov_b32 m0, %2\n\ts_nop 0\n\tglobal_load_lds_dwordx4 %1, off\n\ts_mov_b32 m0, %0":"=&s"(keep):"v"(gsrc),"s"(lds_dst):"memory");}
__device__ __forceinline__ float max3f(float a,float b,float c){float r;asm("v_max3_f32 %0, %1, %2, %3":"=v"(r):"v"(a),"v"(b),"v"(c));return r;}
__device__ __forceinline__ float max2f(float a,float b){float r;asm("v_max_f32_e32 %0, %1, %2":"=v"(r):"v"(a),"v"(b));return r;}
__device__ __forceinline__ float fadd_s(float a,float b){float r;asm("v_add_f32_e32 %0, %1, %2":"=v"(r):"v"(a),"v"(b));return r;}
__device__ __forceinline__ float fsub_s(float a,float b){float r;asm("v_sub_f32_e32 %0, %1, %2":"=v"(r):"v"(a),"v"(b));return r;}
typedef float f32x2_t __attribute__((ext_vector_type(2))); typedef __bf16 bf16x2_t __attribute__((ext_vector_type(2)));
__device__ __forceinline__ unsigned cvtpk_s(float lo,float hi){f32x2_t v={lo,hi};bf16x2_t b=__builtin_convertvector(v,bf16x2_t);return __builtin_bit_cast(unsigned,b);}
#define WAIT_BAR(N) asm volatile("s_waitcnt vmcnt(" #N ") lgkmcnt(0)\n\ts_barrier":::"memory")

__device__ __forceinline__ void qkt(f32x16&p0,f32x16&p1,const char*Kslot,const bf16x8*qr,const f32x16&negm,int r32,int hi){
  const char*kb=Kslot+hi*1024+r32*16;
  #pragma unroll
  for(int d0=0;d0<4;++d0){
    const bf16x8 b0=*reinterpret_cast<const bf16x8*>(kb+d0*2048);
    const bf16x8 b1=*reinterpret_cast<const bf16x8*>(kb+d0*2048+512);
    if(d0==0){p0=__builtin_amdgcn_mfma_f32_32x32x16_bf16(b0,qr[0],negm,0,0,0);p1=__builtin_amdgcn_mfma_f32_32x32x16_bf16(b1,qr[0],negm,0,0,0);}
    else{p0=__builtin_amdgcn_mfma_f32_32x32x16_bf16(b0,qr[d0],p0,0,0,0);p1=__builtin_amdgcn_mfma_f32_32x32x16_bf16(b1,qr[d0],p1,0,0,0);}}
}
typedef __attribute__((address_space(3))) const char* lds_cptr;
typedef short v4i16_t __attribute__((ext_vector_type(4)));
__device__ __forceinline__ void kload8(bf16x8*kf,lds_cptr kp){
  kf[0]=*(const __attribute__((address_space(3))) bf16x8*)(kp);      kf[1]=*(const __attribute__((address_space(3))) bf16x8*)(kp+512);
  kf[2]=*(const __attribute__((address_space(3))) bf16x8*)(kp+2048); kf[3]=*(const __attribute__((address_space(3))) bf16x8*)(kp+2560);
  kf[4]=*(const __attribute__((address_space(3))) bf16x8*)(kp+4096); kf[5]=*(const __attribute__((address_space(3))) bf16x8*)(kp+4608);
  kf[6]=*(const __attribute__((address_space(3))) bf16x8*)(kp+6144); kf[7]=*(const __attribute__((address_space(3))) bf16x8*)(kp+6656);
}
__device__ __forceinline__ void kload2(bf16x8*kf,lds_cptr kp,int j){ kf[2*j]=*(const __attribute__((address_space(3))) bf16x8*)(kp+j*2048); kf[2*j+1]=*(const __attribute__((address_space(3))) bf16x8*)(kp+j*2048+512); }
__device__ __forceinline__ s16x4 vtr(lds_cptr p){ return __builtin_bit_cast(s16x4,__builtin_amdgcn_ds_read_tr16_b64_v4i16((__attribute__((address_space(3))) v4i16_t*)p)); }
__device__ __forceinline__ float rowmax(const f32x16&p0,const f32x16&p1){
  float a=max3f(p0[0],p0[1],p1[0]),b=max3f(p0[2],p0[3],p1[1]);a=max3f(a,p1[2],p1[3]);
  #pragma unroll
  for(int r=4;r<16;r+=4){a=max3f(a,p0[r],p0[r+1]);b=max3f(b,p0[r+2],p0[r+3]);a=max3f(a,p1[r],p1[r+1]);b=max3f(b,p1[r+2],p1[r+3]);}
  const float m=max2f(a,b);
  auto rr=__builtin_amdgcn_permlane32_swap(__float_as_uint(m),__float_as_uint(m),false,false);
  return max2f(__uint_as_float(rr[0]),__uint_as_float(rr[1]));
}
__device__ __forceinline__ void pv(f32x16*o,int vb,bf16x8 pa0,bf16x8 pa1,bf16x8 pa2,bf16x8 pa3){
  #pragma unroll
  for(int d0=0;d0<2;++d0){s16x4 lo[4],hi[4];
    #pragma unroll
    for(int ks=0;ks<4;++ks){
      asm volatile("ds_read_b64_tr_b16 %0,%1 offset:%c2":"=&v"(lo[ks]):"v"(vb),"i"(d0*4096+ks*1024):"memory");
      asm volatile("ds_read_b64_tr_b16 %0,%1 offset:%c2":"=&v"(hi[ks]):"v"(vb),"i"(d0*4096+ks*1024+512):"memory");}
    asm volatile("s_waitcnt lgkmcnt(0)":::"memory");SBAR();
    #define PK(k) (bf16x8){lo[k][0],lo[k][1],lo[k][2],lo[k][3],hi[k][0],hi[k][1],hi[k][2],hi[k][3]}
    o[d0]=__builtin_amdgcn_mfma_f32_32x32x16_bf16(pa0,PK(0),o[d0],0,0,0);
    o[d0]=__builtin_amdgcn_mfma_f32_32x32x16_bf16(pa1,PK(1),o[d0],0,0,0);
    o[d0]=__builtin_amdgcn_mfma_f32_32x32x16_bf16(pa2,PK(2),o[d0],0,0,0);
    o[d0]=__builtin_amdgcn_mfma_f32_32x32x16_bf16(pa3,PK(3),o[d0],0,0,0);
    #undef PK
  }
}

#ifndef ATTN_STORE16
#define ATTN_STORE16(p,v) (*(u32x4*)(p)=(v))
#endif
constexpr int L2_K=0, L2_V=3*8192, L2_WS=L2_V+4*16384, L2_OST=L2_V, L2_BYTES=L2_WS+NW*64*4;
__device__ __forceinline__ float rowmax_c(const f32x16&p0,const f32x16&p1){
  float a=__builtin_fmaxf(__builtin_fmaxf(p0[0],p0[1]),p1[0]),b=__builtin_fmaxf(__builtin_fmaxf(p0[2],p0[3]),p1[1]); a=__builtin_fmaxf(__builtin_fmaxf(a,p1[2]),p1[3]);
  #pragma unroll
  for(int r=4;r<16;r+=4){a=__builtin_fmaxf(__builtin_fmaxf(a,p0[r]),p0[r+1]);b=__builtin_fmaxf(__builtin_fmaxf(b,p0[r+2]),p0[r+3]);a=__builtin_fmaxf(__builtin_fmaxf(a,p1[r]),p1[r+1]);b=__builtin_fmaxf(__builtin_fmaxf(b,p1[r+2]),p1[r+3]);}
  float m=__builtin_fmaxf(a,b);
  auto rr=__builtin_amdgcn_permlane32_swap(__float_as_uint(m),__float_as_uint(m),false,false);
  return __builtin_fmaxf(__uint_as_float(rr[0]),__uint_as_float(rr[1]));
}
__device__ __forceinline__ void pv128(f32x16 (&o)[4],const bf16x8 (&pa)[4],lds_cptr vp_){
  s16x4 vl[2][4],vh_[2][4];
  #pragma unroll
  for(int ks=0;ks<4;++ks){vl[0][ks]=vtr(vp_+ks*1024);vh_[0][ks]=vtr(vp_+ks*1024+512);}
  #pragma unroll
  for(int d0=0;d0<4;++d0){
    if(d0<3){
      #pragma unroll
      for(int ks=0;ks<4;++ks){vl[(d0+1)&1][ks]=vtr(vp_+(d0+1)*4096+ks*1024);vh_[(d0+1)&1][ks]=vtr(vp_+(d0+1)*4096+ks*1024+512);} }
    #pragma unroll
    for(int ks=0;ks<4;++ks){ const s16x4 a_=vl[d0&1][ks],b_=vh_[d0&1][ks];
      o[d0]=__builtin_amdgcn_mfma_f32_32x32x16_bf16(pa[ks],(bf16x8){a_[0],a_[1],a_[2],a_[3],b_[0],b_[1],b_[2],b_[3]},o[d0],0,0,0); }
  }
}
template<int THRL,bool KEEP> __device__ __forceinline__ void attn_unit128(int b,int qb,const bf16*Q,const bf16*__restrict__ K,const bf16*__restrict__ V,bf16*O,char*shm,const float cfar,lds_cfptr dtab,
                                                                          bf16x8 (&qr)[4],const bool pre,const bf16*Qn,const bf16*Kn,const int qbn){
  int tid=threadIdx.x; asm volatile("":"+v"(tid));
  const int lane=tid&63,r32=lane&31,hi=lane>>5; const int wid=__builtin_amdgcn_readfirstlane(tid>>6);
  constexpr bool grpB=true;
  const long rowbase=(long)b*SEQ; const int q0=qb*QB;
  const bf16*Qw=Q+(rowbase+q0+wid*QBLK)*DM;
  const bf16*Kh=K+rowbase*DM,*Vh=V+rowbase*DM;
  const unsigned lds0=(unsigned)(uintptr_t)shm;
  float*wsf=(float*)(shm+L2_WS)+wid*64;
  const bf16*ksrc=Kh+(long)lane*DM+wid*8;
  const bf16*vsrc=Vh+(long)(16*(wid&3)+(lane>>2))*DM+(wid>>2)*32+(lane&3)*8;
  const unsigned kdst=lds0+L2_K+wid*1024, vdst=lds0+L2_V+wid*1024;
  #define DMA2_K(t,slot) glds16(ksrc+(long)(t)*KVBLK*DM,(unsigned)__builtin_amdgcn_readfirstlane(kdst+(slot)*8192))
  #define DMA2_V(t,slot) do{ glds16(vsrc+(long)(t)*KVBLK*DM,(unsigned)__builtin_amdgcn_readfirstlane(vdst+(slot)*16384)); glds16(vsrc+64+(long)(t)*KVBLK*DM,(unsigned)__builtin_amdgcn_readfirstlane(vdst+8192+(slot)*16384)); }while(0)
  const int NT=(q0+QB)/KVBLK;
  const int NTw=NT-3+(wid>>1);
  if(!pre){ DMA2_K(0,0);DMA2_V(0,0);DMA2_K(1,1);DMA2_V(1,1);
    #pragma unroll
    for(int d0=0;d0<4;++d0)qr[d0]=*reinterpret_cast<const bf16x8*>(&Qw[(long)r32*DM+d0*16+hi*8]); }
  else{ DMA2_V(0,0);DMA2_V(1,1); }
  __builtin_amdgcn_s_waitcnt(0x0F70);
  float mhat=0.f,l_reg=0.f; f32x16 o[4];
  #pragma unroll
  for(int d=0;d<4;++d)o[d]=f32x16{};
  f32x16 negm;
  #pragma unroll
  for(int r=0;r<16;++r)negm[r]=cfar;
  const int qrel=wid*QBLK+r32;
  const lds_cptr shm3=(lds_cptr)shm; const lds_cptr vp0=shm3+L2_V+((lane>>4)&1)*32+(lane&3)*8+(4*hi+((lane&15)>>2))*64; const lds_cptr kp0=shm3+L2_K+hi*1024+r32*16;
  int kslot=0,vslot=0;
  bf16x8 pa[4],pb[4];
  #pragma unroll
  for(int i=0;i<4;++i){pa[i]=bf16x8{};pb[i]=bf16x8{};}
  #define PIN8(A,B) asm volatile("":"+v"(A[0]),"+v"(A[1]),"+v"(A[2]),"+v"(A[3]),"+v"(B[0]),"+v"(B[1]),"+v"(B[2]),"+v"(B[3]))
  #define VLD(buf,blk) do{ _Pragma("unroll") for(int ks=0;ks<4;++ks){vl[buf][ks]=vtr(vp_+(blk)*4096+ks*1024);vh_[buf][ks]=vtr(vp_+(blk)*4096+ks*1024+512);} }while(0)
  #define VFRAG(buf,ks) (bf16x8){vl[buf][ks][0],vl[buf][ks][1],vl[buf][ks][2],vl[buf][ks][3],vh_[buf][ks][0],vh_[buf][ks][1],vh_[buf][ks][2],vh_[buf][ks][3]}
  auto tile=[&](const int t,const bf16x8 (&pin)[4],bf16x8 (&pout)[4]) __attribute__((always_inline)) {
    if(t+1<NT){WAIT_BAR(3);}else{WAIT_BAR(0);}
    if(t+2<NT){int k2=kslot+2; if(k2>=3)k2-=3; const int v2=(vslot+2)&3; DMA2_K(t+2,k2); DMA2_V(t+2,v2);}
    if(t>=NTw){ kslot=(kslot==2)?0:kslot+1; vslot=(vslot+1)&3; return; }
    f32x16 p0,p1;
    { bf16x8 kf[8]; kload8(kf,kp0+kslot*8192);
      asm volatile("":"+v"(kf[0]),"+v"(kf[1]),"+v"(kf[2]),"+v"(kf[3]),"+v"(kf[4]),"+v"(kf[5]),"+v"(kf[6]),"+v"(kf[7]));
      p0=__builtin_amdgcn_mfma_f32_32x32x16_bf16(kf[0],qr[0],negm,0,0,0); SBAR(); p1=__builtin_amdgcn_mfma_f32_32x32x16_bf16(kf[1],qr[0],negm,0,0,0); SBAR();
      p0=__builtin_amdgcn_mfma_f32_32x32x16_bf16(kf[2],qr[1],p0,0,0,0);   SBAR(); p1=__builtin_amdgcn_mfma_f32_32x32x16_bf16(kf[3],qr[1],p1,0,0,0);   SBAR();
      p0=__builtin_amdgcn_mfma_f32_32x32x16_bf16(kf[4],qr[2],p0,0,0,0);   SBAR(); p1=__builtin_amdgcn_mfma_f32_32x32x16_bf16(kf[5],qr[2],p1,0,0,0);   SBAR();
      p0=__builtin_amdgcn_mfma_f32_32x32x16_bf16(kf[6],qr[3],p0,0,0,0);   SBAR(); p1=__builtin_amdgcn_mfma_f32_32x32x16_bf16(kf[7],qr[3],p1,0,0,0);   SBAR(); }
    { const int jb_=t-(NT-4); if(jb_>=-3)bcorr(p0,p1,jb_,qrel,hi,dtab); if(jb_==(wid>>1))cmask(p0,p1,jb_,qrel,hi); }
    const float rm=rowmax_c(p0,p1);
    const bool resc=(t==0)||__any(rm>(float)THRL);
    if(resc){
      const float dl=(t==0)?rm:__builtin_fmaxf(rm,0.f); mhat+=dl;
      #pragma unroll
      for(int r=0;r<16;++r){p0[r]-=dl;p1[r]-=dl;negm[r]=cfar-mhat;}
      const float f=__builtin_amdgcn_exp2f(-dl); l_reg*=f; if(hi==0)wsf[r32]=f; }
    { const lds_cptr vp_=vp0+((t>0)?((vslot+3)&3):vslot)*16384;
      s16x4 vl[2][4],vh_[2][4]; float sa0=0.f,sa1=0.f; unsigned q0w[8],q1w[8];
      #define GAPX(d0,ks,i) do{ o[d0]=__builtin_amdgcn_mfma_f32_32x32x16_bf16(pin[ks],VFRAG((d0)&1,ks),o[d0],0,0,0); \
          p0[i]=__builtin_amdgcn_exp2f(p0[i]); p1[i]=__builtin_amdgcn_exp2f(p1[i]); sa0+=p0[i]; sa1+=p1[i]; \
          if((i)&1){ q0w[(i)>>1]=cvtpk_s(p0[(i)-1],p0[i]); q1w[(i)>>1]=cvtpk_s(p1[(i)-1],p1[i]); asm volatile("":"+v"(q0w[(i)>>1]),"+v"(q1w[(i)>>1])); } \
          asm volatile("":"+v"(sa0),"+v"(sa1)); SBAR(); }while(0)
      VLD(0,0); VLD(1,1); PIN8(vl[0],vh_[0]); PIN8(vl[1],vh_[1]);
      GAPX(0,0,0); GAPX(1,0,1); GAPX(0,1,2); GAPX(1,1,3); GAPX(0,2,4); GAPX(1,2,5); GAPX(0,3,6); GAPX(1,3,7);
      VLD(0,2); VLD(1,3); PIN8(vl[0],vh_[0]); PIN8(vl[1],vh_[1]);
      GAPX(2,0,8); GAPX(3,0,9); GAPX(2,1,10); GAPX(3,1,11); GAPX(2,2,12); GAPX(3,2,13); GAPX(2,3,14); GAPX(3,3,15);
      #undef GAPX
      l_reg+=sa0+sa1;
      pout[0]=__builtin_bit_cast(bf16x8,(u32x4){q0w[0],q0w[1],q0w[2],q0w[3]}); pout[1]=__builtin_bit_cast(bf16x8,(u32x4){q0w[4],q0w[5],q0w[6],q0w[7]});
      pout[2]=__builtin_bit_cast(bf16x8,(u32x4){q1w[0],q1w[1],q1w[2],q1w[3]}); pout[3]=__builtin_bit_cast(bf16x8,(u32x4){q1w[4],q1w[5],q1w[6],q1w[7]}); }
    if(resc&&t>0){ asm volatile("s_waitcnt lgkmcnt(0)":::"memory");
      #pragma unroll
      for(int r=0;r<16;++r){const float fr_=wsf[crow(r,hi)]; o[0][r]*=fr_;o[1][r]*=fr_;o[2][r]*=fr_;o[3][r]*=fr_;} }
    kslot=(kslot==2)?0:kslot+1; vslot=(vslot+1)&3;
  };
  #pragma unroll 1
  for(int t=0;t<NT;t+=2){ tile(t,pa,pb); tile(t+1,pb,pa); }
  if(((NTw-1)&1)==0){
    #pragma unroll
    for(int i=0;i<4;++i)pa[i]=pb[i]; }
  { const lds_cptr vp_=vp0+((NTw-1)&3)*16384; s16x4 vl[2][4],vh_[2][4];
    VLD(0,0);
    #pragma unroll
    for(int d0=0;d0<4;++d0){ if(d0<3)VLD((d0+1)&1,d0+1);
      #pragma unroll
      for(int ks=0;ks<4;++ks)o[d0]=__builtin_amdgcn_mfma_f32_32x32x16_bf16(pa[ks],VFRAG(d0&1,ks),o[d0],0,0,0);
      SBAR(); } }
  #undef PIN8
  #undef VLD
  #undef VFRAG
  asm volatile("s_waitcnt lgkmcnt(0)\n\ts_barrier":::"memory");
  bf16x8 qn[4];
  if(Qn){ const bf16*ksn=Kn+rowbase*DM+(long)lane*DM+wid*8;
    glds16(ksn,(unsigned)__builtin_amdgcn_readfirstlane(kdst)); glds16(ksn+(long)KVBLK*DM,(unsigned)__builtin_amdgcn_readfirstlane(kdst+8192));
    const bf16*Qwn=Qn+(rowbase+qbn*QB+wid*QBLK)*DM;
    #pragma unroll
    for(int d0=0;d0<4;++d0)qn[d0]=*reinterpret_cast<const bf16x8*>(&Qwn[(long)r32*DM+d0*16+hi*8]); }
  {auto rr=__builtin_amdgcn_permlane32_swap(__float_as_uint(l_reg),__float_as_uint(l_reg),false,false);l_reg=__uint_as_float(rr[0])+__uint_as_float(rr[1]);}
  if(hi==0)wsf[32+r32]=l_reg;asm volatile("s_waitcnt lgkmcnt(0)":::"memory");
  float rli[16];
  #pragma unroll
  for(int r=0;r<16;++r)rli[r]=__builtin_amdgcn_rcpf(wsf[32+crow(r,hi)]);
  bf16*Ow=O+(rowbase+q0+wid*QBLK)*OP;
  if constexpr(KEEP){
    bf16*stg=(bf16*)(shm+L2_OST)+wid*4096;
    #pragma unroll
    for(int r=0;r<16;++r){const int orow=crow(r,hi);
      #pragma unroll
      for(int d0=0;d0<4;d0+=2){ const unsigned w_=cvtpk_s(o[d0][r]*rli[r],o[d0+1][r]*rli[r]); stg[orow*128+d0*32+r32]=(bf16)(w_&0xffffu); stg[orow*128+(d0+1)*32+r32]=(bf16)(w_>>16); } }
  } else {
  bf16*stg=(bf16*)(shm+L2_OST)+wid*2048;
  #pragma unroll
  for(int hf=0;hf<2;++hf){
    #pragma unroll
    for(int r=0;r<16;++r){const int orow=crow(r,hi);
      { const unsigned w_=cvtpk_s(o[2*hf][r]*rli[r],o[2*hf+1][r]*rli[r]); stg[orow*64+r32]=(bf16)(w_&0xffffu); stg[orow*64+32+r32]=(bf16)(w_>>16); } }
    asm volatile("s_waitcnt lgkmcnt(0)":::"memory");
    #pragma unroll
    for(int i=0;i<4;++i){const int row=i*8+(lane>>3),ch=lane&7; const u32x4 v=*(const u32x4*)(stg+row*64+ch*8); ATTN_STORE16(Ow+(long)row*OP+hf*64+ch*8,v);}
    asm volatile("s_waitcnt lgkmcnt(0)":::"memory");
  }
  }
  asm volatile("s_waitcnt lgkmcnt(0)\n\ts_barrier":::"memory");
  if(Qn){
    #pragma unroll
    for(int d0=0;d0<4;++d0)qr[d0]=qn[d0]; }
  #undef DMA2_K
  #undef DMA2_V
}
static_assert(L2_BYTES<=110592,"attention LDS map vs DTAB_OFF");
constexpr int ATTN_LDS_BYTES=LDS_BYTES;
#undef SBAR
#undef WAIT_BAR
}

constexpr int PREP_GU = NE * 8 * 64, PREP_DN = NE * 8 * 32, PREP_ITEMS = PREP_GU + PREP_DN, PREP_WAVES = 64 * 8, PREP_PER_BH = PREP_ITEMS / PREP_WAVES;
static_assert(PREP_PER_BH * PREP_WAVES == PREP_ITEMS, "prep items must deal evenly over the 64 (b,h) groups");
struct PrepIt { const float* src; unsigned char* dst; const float* gk; int ldw, K; bool gu; };
__device__ __forceinline__ PrepIt prep_decode(const Frame& F, int id, int lane) {
    PrepIt it; int k0, n0, r0; const float* W; unsigned char* WT;
    if (id < PREP_GU) { const int e = id >> 9, q = id & 511; k0 = 128 * (q >> 6); n0 = 32 * (q & 63);
        const int bj = n0 >> 10, j = n0 & 1023; r0 = 256 * (j >> 7) + 128 * bj + (j & 127);
        W = F.in[I_WGU] + (size_t)e * D * 2 * DFF; WT = F.ws + WS_WGU + (size_t)e * 2 * DFF * D; it.ldw = 2 * DFF; it.K = D; it.gu = true;
    } else { id -= PREP_GU; const int e = id >> 8, q = id & 255; k0 = 128 * (q >> 5); n0 = 32 * (q & 31); r0 = n0;
        W = F.in[I_WDN] + (size_t)e * DFF * D; WT = F.ws + WS_WDOWN + (size_t)e * D * DFF; it.ldw = D; it.K = DFF; it.gu = false; }
    const int kq = k0 + 16 * (lane >> 3), nq = 4 * (lane & 7);
    it.src = W + (size_t)kq * it.ldw + n0 + nq; it.dst = WT + (size_t)(r0 + nq) * it.K + kq; it.gk = F.in[I_G2] + kq;
    return it;
}
__device__ __forceinline__ void prep_load(const PrepIt& it, f32x4 (&g)[4], f32x4 (&v)[16]) {
#pragma unroll
    for (int i = 0; i < 4; ++i) g[i] = *(const f32x4*)(it.gk + 4 * i);
#pragma unroll
    for (int i = 0; i < 16; ++i) v[i] = __builtin_nontemporal_load((const f32x4*)(it.src + (size_t)i * it.ldw));
}
__device__ __forceinline__ void prep_store(const PrepIt& it, const f32x4 (&g)[4], const f32x4 (&v)[16]) {
    float gv[16];
#pragma unroll
    for (int i = 0; i < 16; ++i) gv[i] = it.gu ? g[i >> 2][i & 3] * 64.f : 64.f;
#pragma unroll
    for (int c = 0; c < 4; ++c) {
        v4u o;
        o.x = pk4_fp8(v[0][c] * gv[0], v[1][c] * gv[1], v[2][c] * gv[2], v[3][c] * gv[3]);
        o.y = pk4_fp8(v[4][c] * gv[4], v[5][c] * gv[5], v[6][c] * gv[6], v[7][c] * gv[7]);
        o.z = pk4_fp8(v[8][c] * gv[8], v[9][c] * gv[9], v[10][c] * gv[10], v[11][c] * gv[11]);
        o.w = pk4_fp8(v[12][c] * gv[12], v[13][c] * gv[13], v[14][c] * gv[14], v[15][c] * gv[15]);
        __builtin_nontemporal_store(o, (v4u*)(it.dst + (size_t)c * it.K));
    }
}
__device__ __forceinline__ void p2_prep(const Frame& F, int pa, int i0, int i1) {
    if (i0 >= i1) return;
    int ln = F.lane; asm volatile("" : "+v"(ln));
    const int base = pa * 8 + F.wave;
    f32x4 ga[4], gb[4], va[16], vb[16];
    PrepIt ia = prep_decode(F, base + PREP_WAVES * i0, ln), ib;
    prep_load(ia, ga, va);
    int i = i0;
#pragma unroll 1
    while (i + 2 < i1) {
        ib = prep_decode(F, base + PREP_WAVES * (i + 1), ln); prep_load(ib, gb, vb); prep_store(ia, ga, va);
        ia = prep_decode(F, base + PREP_WAVES * (i + 2), ln); prep_load(ia, ga, va); prep_store(ib, gb, vb);
        i += 2;
    }
    if (i + 1 < i1) { ib = prep_decode(F, base + PREP_WAVES * (i + 1), ln); prep_load(ib, gb, vb); prep_store(ia, ga, va); prep_store(ib, gb, vb); }
    else prep_store(ia, ga, va);
}
constexpr int DTAB_OFF = 110592, DTAB_N = 704;
__device__ __forceinline__ void p2_attn_setup(Frame& F_) {
    Frame F = F_; { int t_ = F.tid; asm volatile("" : "+v"(t_)); F.tid = t_; F.lane = t_ & 63; }
    LAS float* dt = (LAS float*)(F.lds + DTAB_OFF);
    {
        constexpr int NJ = (4 * DTAB_N + NTHR - 1) / NTHR;
        int bk[NJ]; float bv[NJ], bf_[NJ];
#pragma unroll
        for (int j = 0; j < NJ; ++j) { const int i = F.tid + j * NTHR, rel = i % DTAB_N - 256; bk[j] = (i < 4 * DTAB_N && rel >= 0 && rel < 128) ? (int)T5_BUCKET[rel] : -1; }
#pragma unroll
        for (int j = 0; j < NJ; ++j) { const int i = F.tid + j * NTHR, h = (i / DTAB_N) & 3; bv[j] = F.in[I_REL][(bk[j] < 0 ? 31 : bk[j]) * 4 + h]; bf_[j] = F.in[I_REL][31 * 4 + h]; }
#pragma unroll
        for (int j = 0; j < NJ; ++j) { const int i = F.tid + j * NTHR; if (i < 4 * DTAB_N) dt[i] = bk[j] >= 0 ? (bv[j] - bf_[j]) * LOG2E : 0.f; }
    }
    __syncthreads();
}
__device__ __forceinline__ void p2_attn_unit(Frame& F, unsigned char* lds_generic, int bh, int qb, int qbn, attn_body::bf16x8 (&qr)[4], bool pre, float lam, int pa, int slot, int nslot) {
    const int b = bh >> 2, h = bh & 3;
    const bf16* QA = proj_buf(F, 0); const bf16* KA = proj_buf(F, 1); const bf16* VA = proj_buf(F, 2);
    bf16* OT = (bf16*)(F.dout + DO_OTMP); bf16* MIX = (bf16*)(F.ws + WS_MIX8);
    const float cfar = F.in[I_REL][31 * 4 + h] * LOG2E;
    attn_body::lds_cfptr dtab = (attn_body::lds_cfptr)(F.lds + DTAB_OFF) + h * DTAB_N;
    attn_body::attn_unit128<8, false>(b, qb, QA + h * 128, KA + h * 128, VA + h * 128, OT + h * 256, (char*)lds_generic, cfar, dtab, qr, pre, QA + h * 128 + 64, KA + h * 128 + 64, qb);
    attn_body::attn_unit128<8, true>(b, qb, QA + h * 128 + 64, KA + h * 128 + 64, VA + h * 128, OT + h * 256 + 128, (char*)lds_generic, cfar, dtab, qr, true, qbn >= 0 ? QA + h * 128 : nullptr, KA + h * 128, qbn);
    int ln = F.lane; asm volatile("" : "+v"(ln));
    const size_t R = (size_t)b * SEQ + qb * 256 + F.wave * 32 + (ln >> 1); const int half = ln & 1;
    const v4u* o0 = (const v4u*)(OT + R * 1024 + h * 256 + half * 64);
    const LAS v4u* o1 = (const LAS v4u*)(F.lds + attn_body::L2_OST + F.wave * 8192 + (ln >> 1) * 256 + half * 128);
    float d[64]; float ss = 0.f;
#pragma unroll
    for (int c = 0; c < 8; ++c) { const v4u a = o0[c], bb = o1[c];
        d[8 * c] = bflo(a.x) - lam * bflo(bb.x); d[8 * c + 1] = bfhi(a.x) - lam * bfhi(bb.x); d[8 * c + 2] = bflo(a.y) - lam * bflo(bb.y); d[8 * c + 3] = bfhi(a.y) - lam * bfhi(bb.y);
        d[8 * c + 4] = bflo(a.z) - lam * bflo(bb.z); d[8 * c + 5] = bfhi(a.z) - lam * bfhi(bb.z); d[8 * c + 6] = bflo(a.w) - lam * bflo(bb.w); d[8 * c + 7] = bfhi(a.w) - lam * bfhi(bb.w); }
#pragma unroll
    for (int i = 0; i < 64; ++i) ss += d[i] * d[i];
    ss += __shfl_xor(ss, 1);
    const float rs = rsqrtf(ss * (1.f / 128.f) + EPS) * (1.f - LAM_INIT);
    const float* g = F.in[I_DNG] + h * 128 + half * 64; v4u* mp = (v4u*)((unsigned char*)MIX + R * 1024 + h * 128 + half * 64);
    f32x4 gg[16];
#pragma unroll
    for (int c = 0; c < 16; ++c) gg[c] = *(const f32x4*)(g + 4 * c);
#pragma unroll
    for (int c = 0; c < 4; ++c) { v4u w;
#pragma unroll
        for (int k = 0; k < 4; ++k) { const f32x4 gk_ = gg[4 * c + k]; const int i0_ = 16 * c + 4 * k;
            const unsigned pw = pk4_fp8(d[i0_] * rs * gk_.x, d[i0_ + 1] * rs * gk_.y, d[i0_ + 2] * rs * gk_.z, d[i0_ + 3] * rs * gk_.w);
            if (k == 0) w.x = pw; else if (k == 1) w.y = pw; else if (k == 2) w.z = pw; else w.w = pw; }
        mp[c] = w; }
    if (pa >= 0) p2_prep(F, pa, slot, nslot);
    asm volatile("s_waitcnt lgkmcnt(0)\n\ts_barrier" ::: "memory");
}
namespace ml {
constexpr int STR = 72;
constexpr int QS = 0, KS = 9216, KTS = 18432, VTS = 27648, PS = 46080, CWL = 55296, GSL = 57856, WV = 58368, HS = 74752, HSTR = 132, END = HS + 64 * HSTR * 4;
static_assert(END <= 131072, "mLSTM LDS map");
__device__ __forceinline__ f32x4 mfma16(bf16x8 a, bf16x8 b, f32x4 c) { return __builtin_amdgcn_mfma_f32_16x16x32_bf16(a, b, c, 0, 0, 0); }
__device__ __forceinline__ float red_q(float v) { v += __shfl_xor(v, 16); v += __shfl_xor(v, 32); return v; }
__device__ __forceinline__ float bfe(const bf16x8& v, int i) { return __uint_as_float(((unsigned)(unsigned short)v[i]) << 16); }
}
__device__ __forceinline__ void p2_mlstm_fast(Frame& F, int bh) {
    using namespace ml;
#define ML_BAR() asm volatile("s_waitcnt lgkmcnt(0)\n\ts_barrier" ::: "memory")
    int tid = F.tid; asm volatile("" : "+v"(tid));
    const int lane = tid & 63, w = __builtin_amdgcn_readfirstlane(tid >> 6), c = lane & 15, q = lane >> 4;
    const int b = bh >> 2, h = bh & 3; const size_t R0 = (size_t)b * SEQ;
    LAS unsigned char* L = F.lds;
    LAS bf16* Qs = (LAS bf16*)(L + QS); LAS bf16* Ks = (LAS bf16*)(L + KS); LAS bf16* KTs = (LAS bf16*)(L + KTS); LAS bf16* VTs = (LAS bf16*)(L + VTS); LAS bf16* Ps = (LAS bf16*)(L + PS);
    LAS float* cwl = (LAS float*)(L + CWL); LAS float* gs = (LAS float*)(L + GSL); LAS float* wv = (LAS float*)(L + WV) + w * 512; LAS float* Hs = (LAS float*)(L + HS);
    LAS float* Aw = wv, *Mw = wv + 64, *WIw = wv + 128, *EMw = wv + 192, *WKw = wv + 256, *Nw = wv + 320, *DNw = wv + 384;
    const bf16* MQK = proj_buf(F, 3); const bf16* MV = proj_buf(F, 4); const bf16* MO = proj_buf(F, 5); const float* GT = (const float*)(F.ws + WS_GATES);
    bf16* MIX = (bf16*)(F.ws + WS_MIX8);
    __syncthreads();
    for (int i = tid; i < 5 * 128; i += NTHR) { const int tap = i >> 7, cc = i & 127; const int chn = cc < 64 ? h * 64 + cc : 256 + h * 64 + (cc - 64); cwl[i] = tap < 4 ? F.in[I_CONVW][tap * 512 + chn] : F.in[I_CONVB][chn]; }
    f32x4 accC[4], nacc[4];
#pragma unroll
    for (int i = 0; i < 4; ++i) { accC[i] = (f32x4){0.f, 0.f, 0.f, 0.f}; nacc[i] = (f32x4){0.f, 0.f, 0.f, 0.f}; }
    float m_prev = 0.f;
    const int sc = tid & 31, jg = tid >> 5, cc = 4 * sc;
    const int chq = (cc < 64) ? h * 64 + cc : 256 + h * 64 + (cc - 64);
    const bool isk = cc >= 64; const float kscale = isk ? 0.125f : 1.f;
    f32x4 cw4[5];
#pragma unroll
    for (int tap = 0; tap < 5; ++tap) cw4[tap] = (f32x4){0.f, 0.f, 0.f, 0.f};
    const float mg0 = F.in[I_MLG][h * 128 + 2 * lane], mg1 = F.in[I_MLG][h * 128 + 2 * lane + 1], ob0 = F.in[I_OB][h * 128 + 2 * lane], ob1 = F.in[I_OB][h * 128 + 2 * lane + 1];
    v2u raw[7], vr[4]; float gli = 0.f, glf = 0.f;
#define ML_LOAD(ch_) do { const int ch__ = (ch_); \
        _Pragma("unroll") for (int i = 0; i < 7; ++i) { const int rr = 64 * ch__ + 4 * jg - 3 + i; \
            raw[i] = *(const v2u*)(MQK + (R0 + (rr < 0 ? 0 : rr)) * 512 + chq); }   \
        _Pragma("unroll") for (int i = 0; i < 4; ++i) vr[i] = *(const v2u*)(MV + (R0 + 64 * ch__ + 4 * jg + i) * 512 + h * 128 + cc); \
        gli = GT[(R0 + 64 * ch__ + lane) * 8 + h]; glf = GT[(R0 + 64 * ch__ + lane) * 8 + 4 + h]; } while (0)
    ML_LOAD(0);
    __syncthreads();
#pragma unroll
    for (int tap = 0; tap < 5; ++tap) cw4[tap] = *(const LAS f32x4*)(cwl + 128 * tap + cc);
#pragma unroll 1
    for (int ch = 0; ch < SEQ / 64; ++ch) {
        unsigned moc[8];
#pragma unroll
        for (int i = 0; i < 8; ++i) moc[i] = *(const unsigned*)(MO + (R0 + 64 * ch + 8 * w + i) * 512 + h * 128 + 2 * lane);
        ML_BAR();
        {
            float x[7][4];
#pragma unroll
            for (int i = 0; i < 7; ++i) { const bool in_ = 64 * ch + 4 * jg - 3 + i >= 0; x[i][0] = in_ ? bflo(raw[i].x) : 0.f; x[i][1] = in_ ? bfhi(raw[i].x) : 0.f; x[i][2] = in_ ? bflo(raw[i].y) : 0.f; x[i][3] = in_ ? bfhi(raw[i].y) : 0.f; }
            float y[4][4];
#pragma unroll
            for (int r = 0; r < 4; ++r)
#pragma unroll
                for (int k = 0; k < 4; ++k) { const float t_ = cw4[4][k] + cw4[0][k] * x[r][k] + cw4[1][k] * x[r + 1][k] + cw4[2][k] * x[r + 2][k] + cw4[3][k] * x[r + 3][k]; y[r][k] = t_ * __builtin_amdgcn_rcpf(1.f + __expf(-t_)) * kscale; }
            LAS bf16* dst = isk ? Ks + (cc - 64) : Qs + cc;
#pragma unroll
            for (int r = 0; r < 4; ++r) { v2u o; o.x = pkh(y[r][0], y[r][1]); o.y = pkh(y[r][2], y[r][3]); *(LAS v2u*)(dst + (4 * jg + r) * STR) = o; }
            if (isk) {
#pragma unroll
                for (int k = 0; k < 4; ++k) { v2u o; o.x = pkh(y[0][k], y[1][k]); o.y = pkh(y[2][k], y[3][k]); *(LAS v2u*)(KTs + (cc - 64 + k) * STR + 4 * jg) = o; } }
            { v2u o;
              o.x = (vr[0].x & 0xffffu) | (vr[1].x << 16); o.y = (vr[2].x & 0xffffu) | (vr[3].x << 16); *(LAS v2u*)(VTs + (cc + 0) * STR + 4 * jg) = o;
              o.x = (vr[0].x >> 16) | (vr[1].x & 0xffff0000u); o.y = (vr[2].x >> 16) | (vr[3].x & 0xffff0000u); *(LAS v2u*)(VTs + (cc + 1) * STR + 4 * jg) = o;
              o.x = (vr[0].y & 0xffffu) | (vr[1].y << 16); o.y = (vr[2].y & 0xffffu) | (vr[3].y << 16); *(LAS v2u*)(VTs + (cc + 2) * STR + 4 * jg) = o;
              o.x = (vr[0].y >> 16) | (vr[1].y & 0xffff0000u); o.y = (vr[2].y >> 16) | (vr[3].y & 0xffff0000u); *(LAS v2u*)(VTs + (cc + 3) * STR + 4 * jg) = o; }
        }
        float decay, m_next;
        {   const float li = gli, lf = glf;
            const float bsum = wave_scan_add(lf);
            const float a = li - bsum; const float am = wave_scan_max(a);
            const float M = fmaxf(am, m_prev);
            const float g = lane63(bsum), M63 = lane63(M);
            Aw[lane] = a; Mw[lane] = M; WIw[lane] = __expf(m_prev - M); EMw[lane] = __expf(-(bsum + M)); WKw[lane] = __expf(a - M63);
            decay = __expf(m_prev - M63); m_next = g + M63;
        }
        ML_LOAD(ch + 1 < SEQ / 64 ? ch + 1 : ch);
        ML_BAR();
        {   const int tt = w >> 1; const bf16x8 qb0 = *(const LAS bf16x8*)(Qs + (16 * tt + c) * STR + 8 * q), qb1 = *(const LAS bf16x8*)(Qs + (16 * tt + c) * STR + 32 + 8 * q);
            const float Mt = Mw[16 * tt + c];
#pragma unroll
            for (int jj = 0; jj < 2; ++jj) { const int jt = 2 * (w & 1) + jj;
                const bf16x8 ka0 = *(const LAS bf16x8*)(Ks + (16 * jt + c) * STR + 8 * q), ka1 = *(const LAS bf16x8*)(Ks + (16 * jt + c) * STR + 32 + 8 * q);
                f32x4 sacc = mfma16(ka0, qb0, (f32x4){0.f, 0.f, 0.f, 0.f}); sacc = mfma16(ka1, qb1, sacc);
                const f32x4 a4 = *(const LAS f32x4*)(Aw + 16 * jt + 4 * q);
                float p[4];
#pragma unroll
                for (int r = 0; r < 4; ++r) p[r] = (16 * jt + 4 * q + r <= 16 * tt + c) ? sacc[r] * __expf(a4[r] - Mt) : 0.f;
                v2u pw; pw.x = pkh(p[0], p[1]); pw.y = pkh(p[2], p[3]);
                *(LAS v2u*)(Ps + (16 * tt + c) * STR + 16 * jt + 4 * q) = pw; }
        }
        ML_BAR();
        {   bf16x8 vb[2]; vb[0] = *(const LAS bf16x8*)(VTs + (16 * w + c) * STR + 8 * q); vb[1] = *(const LAS bf16x8*)(VTs + (16 * w + c) * STR + 32 + 8 * q);
            bf16x8 cbf[2];
#pragma unroll
            for (int ks = 0; ks < 2; ++ks) { v4u t_; t_.x = pkh(accC[2 * ks][0], accC[2 * ks][1]); t_.y = pkh(accC[2 * ks][2], accC[2 * ks][3]); t_.z = pkh(accC[2 * ks + 1][0], accC[2 * ks + 1][1]); t_.w = pkh(accC[2 * ks + 1][2], accC[2 * ks + 1][3]); cbf[ks] = __builtin_bit_cast(bf16x8, t_); }
            bf16x8 nb[2];
#pragma unroll
            for (int ks = 0; ks < 2; ++ks) { v4u t_; t_.x = pkh(nacc[2 * ks][0], nacc[2 * ks][1]); t_.y = pkh(nacc[2 * ks][2], nacc[2 * ks][3]); t_.z = pkh(nacc[2 * ks + 1][0], nacc[2 * ks + 1][1]); t_.w = pkh(nacc[2 * ks + 1][2], nacc[2 * ks + 1][3]); nb[ks] = __builtin_bit_cast(bf16x8, t_); }
            const bf16x8 ones8 = {(short)0x3f80, (short)0x3f80, (short)0x3f80, (short)0x3f80, (short)0x3f80, (short)0x3f80, (short)0x3f80, (short)0x3f80};
#pragma unroll
            for (int m = 0; m < 4; ++m) {
                f32x4 ia = (f32x4){0.f, 0.f, 0.f, 0.f}, ie = (f32x4){0.f, 0.f, 0.f, 0.f}, rs4 = (f32x4){0.f, 0.f, 0.f, 0.f}, qn4 = (f32x4){0.f, 0.f, 0.f, 0.f};
#pragma unroll
                for (int ks = 0; ks < 2; ++ks) {
                    const bf16x8 pa = *(const LAS bf16x8*)(Ps + (16 * m + c) * STR + 32 * ks + 8 * q);
                    ia = mfma16(pa, vb[ks], ia); rs4 = mfma16(pa, ones8, rs4);
                    const v2u qlo = *(const LAS v2u*)(Qs + (16 * m + c) * STR + 32 * ks + 4 * q), qhi = *(const LAS v2u*)(Qs + (16 * m + c) * STR + 32 * ks + 16 + 4 * q);
                    v4u qq; qq.x = qlo.x; qq.y = qlo.y; qq.z = qhi.x; qq.w = qhi.y; const bf16x8 qa = __builtin_bit_cast(bf16x8, qq);
                    ie = mfma16(qa, cbf[ks], ie); qn4 = mfma16(qa, nb[ks], qn4);
                }
                const f32x4 wi4 = *(const LAS f32x4*)(WIw + 16 * m + 4 * q), em4 = *(const LAS f32x4*)(EMw + 16 * m + 4 * q);
#pragma unroll
                for (int r = 0; r < 4; ++r) { const float den = rs4[r] + wi4[r] * qn4[r]; const float rden = __builtin_amdgcn_rcpf(fmaxf(fabsf(den), em4[r]));
                    Hs[(16 * m + 4 * q + r) * HSTR + 16 * w + c] = (ia[r] + wi4[r] * ie[r]) * rden; }
            }
            f32x4 wk8[2][2];
#pragma unroll
            for (int ks = 0; ks < 2; ++ks) { wk8[ks][0] = *(const LAS f32x4*)(WKw + 32 * ks + 8 * q); wk8[ks][1] = *(const LAS f32x4*)(WKw + 32 * ks + 8 * q + 4); }
            bf16x8 vs[2], wkb[2];
#pragma unroll
            for (int ks = 0; ks < 2; ++ks) { v4u t_; t_.x = pkh(bfe(vb[ks], 0) * wk8[ks][0][0], bfe(vb[ks], 1) * wk8[ks][0][1]); t_.y = pkh(bfe(vb[ks], 2) * wk8[ks][0][2], bfe(vb[ks], 3) * wk8[ks][0][3]);
                t_.z = pkh(bfe(vb[ks], 4) * wk8[ks][1][0], bfe(vb[ks], 5) * wk8[ks][1][1]); t_.w = pkh(bfe(vb[ks], 6) * wk8[ks][1][2], bfe(vb[ks], 7) * wk8[ks][1][3]); vs[ks] = __builtin_bit_cast(bf16x8, t_);
                v4u u_; u_.x = pkh(wk8[ks][0][0], wk8[ks][0][1]); u_.y = pkh(wk8[ks][0][2], wk8[ks][0][3]); u_.z = pkh(wk8[ks][1][0], wk8[ks][1][1]); u_.w = pkh(wk8[ks][1][2], wk8[ks][1][3]); wkb[ks] = __builtin_bit_cast(bf16x8, u_); }
#pragma unroll
            for (int dt = 0; dt < 4; ++dt) { f32x4 ca = accC[dt] * decay, na = nacc[dt] * decay;
#pragma unroll
                for (int ks = 0; ks < 2; ++ks) { const bf16x8 ka = *(const LAS bf16x8*)(KTs + (16 * dt + c) * STR + 32 * ks + 8 * q); ca = mfma16(ka, vs[ks], ca); na = mfma16(ka, wkb[ks], na); }
                accC[dt] = ca; nacc[dt] = na; }
            m_prev = m_next;
        }
        ML_BAR();
#pragma unroll
        for (int i = 0; i < 8; ++i) { const int t = 8 * w + i; const float h0 = Hs[t * HSTR + 2 * lane], h1 = Hs[t * HSTR + 2 * lane + 1];
            const float rsn = rsqrtf(wave_sum(h0 * h0 + h1 * h1) * (1.f / 128.f) + EPS);
            const float o0 = h0 * rsn * mg0 * sigmoidf_(bflo(moc[i]) + ob0), o1 = h1 * rsn * mg1 * sigmoidf_(bfhi(moc[i]) + ob1);
            *(unsigned short*)((unsigned char*)MIX + (R0 + 64 * ch + t) * 1024 + 512 + h * 128 + 2 * lane) = (unsigned short)__builtin_amdgcn_cvt_pk_fp8_f32(o0, o1, 0, false); }
    }
#undef ML_LOAD
#undef ML_BAR
    __syncthreads();
}

__device__ __forceinline__ int find_expert(const LAS int* tb, int tile256) {
    int v[NE];
#pragma unroll
    for (int i = 0; i < NE; i += 4) { const v4u q = *(const LAS v4u*)(tb + i); v[i] = (int)q.x; v[i + 1] = (int)q.y; v[i + 2] = (int)q.z; v[i + 3] = (int)q.w; }
    int e = 0;
#pragma unroll
    for (int i = 1; i < NE; ++i) e += (tile256 >= v[i]) ? 1 : 0;
    return e; }

__device__ __forceinline__ void p4_route(Frame& F_) {
    Frame F = F_; { int t_ = F.tid; asm volatile("" : "+v"(t_)); F.tid = t_; F.lane = t_ & 63; }
    LAS v4u* wf = (LAS v4u*)F.lds;
    LAS unsigned* hist = (LAS unsigned*)(F.lds + L_HIST);
    {
        constexpr int NP = 32 * 2 * 64 / NTHR;
        float wv[NP][8];
#pragma unroll
        for (int p = 0; p < NP; ++p) { const int i = F.tid + p * NTHR, ln = i & 63, nt = (i >> 6) & 1, s_ = i >> 7, e = 16 * nt + (ln & 15), k0 = 32 * s_ + 8 * (ln >> 4);
#pragma unroll
            for (int j = 0; j < 8; ++j) wv[p][j] = F.in[I_RW][(k0 + j) * NE + e] * F.in[I_G2][k0 + j]; }
#pragma unroll
        for (int p = 0; p < NP; ++p) { const int i = F.tid + p * NTHR, ln = i & 63, nt = (i >> 6) & 1, s_ = i >> 7;
            unsigned hi16[8], lo16[8];
#pragma unroll
            for (int j = 0; j < 8; ++j) { hi16[j] = f2bf(wv[p][j]); lo16[j] = f2bf(wv[p][j] - __uint_as_float(hi16[j] << 16)); }
            v4u h4, l4; h4.x = hi16[0] | (hi16[1] << 16); h4.y = hi16[2] | (hi16[3] << 16); h4.z = hi16[4] | (hi16[5] << 16); h4.w = hi16[6] | (hi16[7] << 16);
            l4.x = lo16[0] | (lo16[1] << 16); l4.y = lo16[2] | (lo16[3] << 16); l4.z = lo16[4] | (lo16[5] << 16); l4.w = lo16[6] | (lo16[7] << 16);
            wf[((s_ * 2 + nt) * 2 + 0) * 64 + ln] = h4; wf[((s_ * 2 + nt) * 2 + 1) * 64 + ln] = l4; }
    }
    const bf16* X1 = (const bf16*)(F.ws + WS_X1B);
    float* RS = (float*)(F.ws + WS_RSTD2); unsigned* TI = (unsigned*)(F.ws + WS_TOKINFO); float* GA = (float*)(F.ws + WS_GATE); unsigned* HIST = (unsigned*)(F.ws + WS_HIST);
    const int c = F.lane & 15, q = F.lane >> 4;
    const float rb0 = F.in[I_RB][c], rb1 = F.in[I_RB][16 + c];
    for (int blk = F.vcu; blk < T / 256; blk += F.G) {
        if (F.tid < 32) hist[F.tid] = 0u;
        __syncthreads();
#pragma unroll 1
        for (int grp = 0; grp < 2; ++grp) {
            const int t0 = blk * 256 + F.wave * 32 + grp * 16;
            const bf16x8* xr = (const bf16x8*)(X1 + (size_t)(t0 + c) * D + 8 * q);
            bf16x8 xa[32];
#pragma unroll
            for (int s_ = 0; s_ < 32; ++s_) xa[s_] = xr[4 * s_];
            f32x4 l0 = (f32x4){0.f, 0.f, 0.f, 0.f}, l1 = (f32x4){0.f, 0.f, 0.f, 0.f}; float ss = 0.f;
#pragma unroll
            for (int s_ = 0; s_ < 32; ++s_) {
                const bf16x8 b0h = __builtin_bit_cast(bf16x8, wf[((s_ * 2 + 0) * 2 + 0) * 64 + F.lane]), b0l = __builtin_bit_cast(bf16x8, wf[((s_ * 2 + 0) * 2 + 1) * 64 + F.lane]);
                const bf16x8 b1h = __builtin_bit_cast(bf16x8, wf[((s_ * 2 + 1) * 2 + 0) * 64 + F.lane]), b1l = __builtin_bit_cast(bf16x8, wf[((s_ * 2 + 1) * 2 + 1) * 64 + F.lane]);
                l0 = __builtin_amdgcn_mfma_f32_16x16x32_bf16(xa[s_], b0h, l0, 0, 0, 0); l0 = __builtin_amdgcn_mfma_f32_16x16x32_bf16(xa[s_], b0l, l0, 0, 0, 0);
                l1 = __builtin_amdgcn_mfma_f32_16x16x32_bf16(xa[s_], b1h, l1, 0, 0, 0); l1 = __builtin_amdgcn_mfma_f32_16x16x32_bf16(xa[s_], b1l, l1, 0, 0, 0);
#pragma unroll
                for (int j = 0; j < 8; ++j) { const float xv = __uint_as_float(((unsigned)(unsigned short)xa[s_][j]) << 16); ss += xv * xv; }
            }
            ss += __shfl_xor(ss, 16); ss += __shfl_xor(ss, 32);
            const float rstd_c = rsqrtf(ss * (1.f / D) + EPS);
#pragma unroll
            for (int r = 0; r < 4; ++r) {
                const float rstd = __shfl(rstd_c, 4 * q + r);
                const float g0 = l0[r] * rstd + rb0, g1 = l1[r] * rstd + rb1;
                int k0, k1; { const int b_ = __float_as_int(g0); k0 = b_ ^ ((b_ >> 31) & 0x7fffffff); k0 = (k0 & ~31) | (31 - c); }
                { const int b_ = __float_as_int(g1); k1 = b_ ^ ((b_ >> 31) & 0x7fffffff); k1 = (k1 & ~31) | (15 - c); }
                float tv[4]; int te[4];
#pragma unroll
                for (int k = 0; k < 4; ++k) { int mx = k0 > k1 ? k0 : k1;
                    { int other;
                      other = __builtin_amdgcn_update_dpp(mx, mx, 0xB1, 0xF, 0xF, false); mx = other > mx ? other : mx;
                      other = __builtin_amdgcn_update_dpp(mx, mx, 0x4E, 0xF, 0xF, false); mx = other > mx ? other : mx;
                      other = __builtin_amdgcn_update_dpp(mx, mx, 0x141, 0xF, 0xF, false); mx = other > mx ? other : mx;
                      other = __builtin_amdgcn_update_dpp(mx, mx, 0x140, 0xF, 0xF, false); mx = other > mx ? other : mx; }
                    te[k] = 31 - (mx & 31); { const int kk = mx & ~31; tv[k] = __int_as_float(kk ^ ((kk >> 31) & 0x7fffffff)); }
                    if (te[k] == c) k0 = (int)0x80000000; if (te[k] == 16 + c) k1 = (int)0x80000000; }
                const float e1 = __expf(tv[1] - tv[0]), e2 = __expf(tv[2] - tv[0]), e3 = __expf(tv[3] - tv[0]); const float inv = 1.f / (1.f + e1 + e2 + e3);
                if (c == 0) { const int t = t0 + 4 * q + r;
                    RS[t] = rstd;
                    f32x4 g; g.x = inv; g.y = e1 * inv; g.z = e2 * inv; g.w = e3 * inv; *(f32x4*)(GA + (size_t)t * 4) = g;
                    v4u ti;
                    ti.x = ((unsigned)te[0] << 20) | atomicAdd((unsigned*)&hist[te[0]], 1u); ti.y = ((unsigned)te[1] << 20) | atomicAdd((unsigned*)&hist[te[1]], 1u);
                    ti.z = ((unsigned)te[2] << 20) | atomicAdd((unsigned*)&hist[te[2]], 1u); ti.w = ((unsigned)te[3] << 20) | atomicAdd((unsigned*)&hist[te[3]], 1u);
                    *(v4u*)(TI + (size_t)t * 4) = ti; }
            }
        }
        __syncthreads();
        if (F.tid < 32) HIST[blk * 32 + F.tid] = hist[F.tid];
        __syncthreads();
    }
}

__device__ __forceinline__ void p4b_lists(Frame& F_) {
    Frame F = F_; { int t_ = F.tid; asm volatile("" : "+v"(t_)); F.tid = t_; F.lane = t_ & 63; }
    LAS int* pb = (LAS int*)F.lds; LAS int* pa = pb + 512; LAS unsigned* basew = (LAS unsigned*)(F.lds + L_BASE);
    LAS int* tb = (LAS int*)(F.lds + L_ETAB); LAS int* cn = tb + 40;
    const unsigned* HIST = (const unsigned*)(F.ws + WS_HIST); const float* RS = (const float*)(F.ws + WS_RSTD2);
    unsigned* TI = (unsigned*)(F.ws + WS_TOKINFO); int* LIST = (int*)(F.ws + WS_LIST); float* LRS = (float*)(F.ws + WS_LISTRS);
    { const int e = F.tid & 31, p = F.tid >> 5; int sa = 0;
#pragma unroll
      for (int i = 0; i < 16; ++i) sa += (int)HIST[(16 * p + i) * 32 + e];
      pa[F.tid] = sa; }
    __syncthreads();
    if (F.tid < 32) { int sa = 0;
#pragma unroll
        for (int p = 0; p < 16; ++p) sa += pa[32 * p + F.tid];
        cn[F.tid] = sa; }
    __syncthreads();
    if (F.tid == 0) { int acc = 0; for (int e = 0; e < NE; ++e) { tb[e] = acc; acc += (cn[e] + 255) >> 8; } tb[NE] = acc; }
    __syncthreads();
    { LAS unsigned char* pexp = (LAS unsigned char*)(F.lds + L_PEXP); const int ntile = tb[NE];
      for (int p = F.tid; p < ntile; p += NTHR) pexp[p] = (unsigned char)find_expert(tb, p); }
    for (int blk = F.vcu; blk < T / 256; blk += F.G) {
        { const int e = F.tid & 31, p = F.tid >> 5; int sb = 0;
#pragma unroll
          for (int i = 0; i < 16; ++i) { const int bb = 16 * p + i; const int hv = (int)HIST[bb * 32 + e]; sb += bb < blk ? hv : 0; }
          pb[F.tid] = sb; }
        __syncthreads();
        if (F.tid < 32) { int sb = 0;
#pragma unroll
            for (int p = 0; p < 16; ++p) sb += pb[32 * p + F.tid];
            basew[F.tid] = (unsigned)sb; }
        __syncthreads();
        for (int i = F.tid; i < 1024; i += NTHR) {
            const int t = blk * 256 + (i >> 2); const unsigned ti = TI[(size_t)t * 4 + (i & 3)]; const unsigned e = ti >> 20, pos = basew[e] + (ti & 0xfffffu);
            TI[(size_t)t * 4 + (i & 3)] = (e << 20) | pos; LIST[(size_t)e * T + pos] = t; LRS[(size_t)e * T + pos] = RS[t];
        }
        __syncthreads();
    }
}


__device__ __forceinline__ void glds4(const void* gsrc, unsigned lds_dst) { unsigned keep;
    asm volatile("s_mov_b32 %0, m0\n\ts_mov_b32 m0, %2\n\ts_nop 0\n\tglobal_load_lds_dword %1, off\n\ts_mov_b32 m0, %0" : "=&s"(keep) : "v"(gsrc), "s"(lds_dst) : "memory"); }
constexpr int L_EPI = LDSCTL_OFF + 4096;
struct DenseSched {
    pg8::TileOrder ord; const char* A; const char* Bt; int K;
    __device__ __forceinline__ bool next(int i, pg8::Unit& u) const { u.e = 0; u.pos0 = 0; u.cnt = 0; return ord.next_tile(i, u.pm, u.pn); }
    __device__ __forceinline__ void a_view(const pg8::Unit& u, const int (&R)[2], const int (&C)[2], const char*& base, unsigned (&off)[2][2]) const {
        base = A + (size_t)u.pm * 256 * K * 2;
#pragma unroll
        for (int h = 0; h < 2; ++h)
#pragma unroll
            for (int i = 0; i < 2; ++i) off[h][i] = (unsigned)((h * 128 + R[i]) * K + C[i]) * 2u;
    }
    __device__ __forceinline__ void a_pre(const pg8::Unit&, const int (&)[2], unsigned (&)[2][2]) const {}
    __device__ __forceinline__ void a_post(const pg8::Unit& u, unsigned (&)[2][2], const int (&R)[2], const int (&C)[2], const char*& base, unsigned (&off)[2][2]) const { a_view(u, R, C, base, off); }
    __device__ __forceinline__ const char* b_base(const pg8::Unit& u) const { return Bt + (size_t)u.pn * 256 * K * 2; }
};
struct DenseSched8 {
    pg8::TileOrder ord; const char* A; const char* Bt; int K;
    __device__ __forceinline__ bool next(int i, pg8::Unit& u) const { u.e = 0; u.pos0 = 0; u.cnt = 0; return ord.next_tile(i, u.pm, u.pn); }
    __device__ __forceinline__ void a_view(const pg8::Unit& u, const int (&R)[2], const int (&C)[2], const char*& base, unsigned (&off)[2][2]) const {
        base = A + (size_t)u.pm * 256 * K;
#pragma unroll
        for (int h = 0; h < 2; ++h)
#pragma unroll
            for (int i = 0; i < 2; ++i) off[h][i] = (unsigned)((h * 128 + R[i]) * K + C[i] * 2);
    }
    __device__ __forceinline__ void a_pre(const pg8::Unit&, const int (&)[2], unsigned (&)[2][2]) const {}
    __device__ __forceinline__ void a_post(const pg8::Unit& u, unsigned (&)[2][2], const int (&R)[2], const int (&C)[2], const char*& base, unsigned (&off)[2][2]) const { a_view(u, R, C, base, off); }
    __device__ __forceinline__ const char* b_base(const pg8::Unit& u) const { return Bt + (size_t)u.pn * 256 * K; }
};
__device__ __forceinline__ v4u pair16(v2u x, v2u y) {
    const auto s0 = __builtin_amdgcn_permlane16_swap(x.x, y.x, false, false); const auto s1 = __builtin_amdgcn_permlane16_swap(x.y, y.y, false, false);
    v4u o; o.x = s0[0]; o.y = s1[0]; o.z = s0[1]; o.w = s1[1]; return o; }
struct EpiProj {
    unsigned char* ws;
    __device__ __forceinline__ void pre(const pg8::Unit&, int, int, int) const {}
    __device__ __forceinline__ void operator()(const f32x4 (&acc)[2][2][4][2], const pg8::Unit& u, int wr, int wc, int fr, int fq, int par) const {
        asm volatile("" : "+v"(fr));
        const int buf = u.pn >> 1; bf16* base = (bf16*)(ws + proj_off(buf)); const float sc = buf == 0 ? C2 : 1.f;
        const int row0 = u.pm * 256 + wr * 64 + fr, col0 = (u.pn & 1) * 256 + wc * 32 + 8 * fq;
#pragma unroll
        for (int ai = 0; ai < 2; ++ai)
#pragma unroll
            for (int m = 0; m < 4; ++m) { bf16* rowp = base + (size_t)(row0 + ai * 128 + m * 16) * 512 + col0;
#pragma unroll
                for (int bj = 0; bj < 2; ++bj) { const f32x4 v0 = acc[ai][bj][m][0] * sc, v1 = acc[ai][bj][m][1] * sc;
                    v4u w; w.x = pg8::cvt_pk_bf16(v0[0], v0[1]); w.y = pg8::cvt_pk_bf16(v0[2], v0[3]); w.z = pg8::cvt_pk_bf16(v1[0], v1[1]); w.w = pg8::cvt_pk_bf16(v1[2], v1[3]);
                    *(v4u*)(rowp + bj * 128) = w; } }
    }
};
struct EpiOutProj {
    const bf16* XH; const float* RS1; bf16* X1; unsigned char* X8; const LAS float* sc; unsigned scb;
    __device__ __forceinline__ void pre(const pg8::Unit& u, int wid, int lane, int par) const {
        if (wid < 4) glds4(RS1 + (size_t)u.pm * 256 + wid * 64 + lane, (unsigned)__builtin_amdgcn_readfirstlane((int)(scb + par * 2048 + wid * 256)));
    }
    __device__ __forceinline__ void operator()(const f32x4 (&acc)[2][2][4][2], const pg8::Unit& u, int wr, int wc, int fr, int fq, int par) const {
        asm volatile("" : "+v"(fr));
        const LAS float* scp = sc + par * 512;
        const int row0 = u.pm * 256 + wr * 64 + fr, col0 = u.pn * 256 + wc * 32 + 8 * fq;
#pragma unroll
        for (int ai = 0; ai < 2; ++ai) {
            v4u xv[4][2]; float ir[4];
#pragma unroll
            for (int m = 0; m < 4; ++m) { const size_t ro = (size_t)(row0 + ai * 128 + m * 16) * D + col0; ir[m] = scp[ai * 128 + wr * 64 + m * 16 + fr];
#pragma unroll
                for (int bj = 0; bj < 2; ++bj) xv[m][bj] = *(const v4u*)(XH + ro + bj * 128); }
#pragma unroll
            for (int m = 0; m < 4; ++m) { v2u w8k; const size_t ro = (size_t)(row0 + ai * 128 + m * 16) * D + col0; const float iv = ir[m];
#pragma unroll
                for (int bj = 0; bj < 2; ++bj) { const v4u xw = xv[m][bj];
                    f32x4 v0, v1; v0[0] = acc[ai][bj][m][0][0] + bflo(xw.x) * iv; v0[1] = acc[ai][bj][m][0][1] + bfhi(xw.x) * iv; v0[2] = acc[ai][bj][m][0][2] + bflo(xw.y) * iv; v0[3] = acc[ai][bj][m][0][3] + bfhi(xw.y) * iv;
                    v1[0] = acc[ai][bj][m][1][0] + bflo(xw.z) * iv; v1[1] = acc[ai][bj][m][1][1] + bfhi(xw.z) * iv; v1[2] = acc[ai][bj][m][1][2] + bflo(xw.w) * iv; v1[3] = acc[ai][bj][m][1][3] + bfhi(xw.w) * iv;
                    v4u w; w.x = pg8::cvt_pk_bf16(v0[0], v0[1]); w.y = pg8::cvt_pk_bf16(v0[2], v0[3]); w.z = pg8::cvt_pk_bf16(v1[0], v1[1]); w.w = pg8::cvt_pk_bf16(v1[2], v1[3]);
                    *(v4u*)(X1 + ro + bj * 128) = w;
                    v2u w8; w8.x = pk4_fp8(v0[0], v0[1], v0[2], v0[3]); w8.y = pk4_fp8(v1[0], v1[1], v1[2], v1[3]);
                    if (bj == 0) w8k = w8; else *(v4u*)(X8 + ro + ((fq & 1) ? 120 : 0)) = pair16(w8k, w8); } }
        }
    }
};
template <bool GATHER> struct MoeSched8 {
    pg8::TileOrder ord; const LAS int* tb; const LAS int* cn; const char* A; const char* W; const int* LIST; int wrows; const LAS unsigned char* pe;
    __device__ __forceinline__ bool next(int i, pg8::Unit& u) const { if (!ord.next_tile(i, u.pm, u.pn)) return false; u.e = (int)pe[u.pm]; u.pos0 = (u.pm - tb[u.e]) * 256; u.cnt = cn[u.e]; return true; }
    __device__ __forceinline__ void a_view(const pg8::Unit& u, const int (&R)[2], const int (&C)[2], const char*& base, unsigned (&off)[2][2]) const {
        if constexpr (GATHER) {
            base = A; const int pos0 = u.pos0, cnt = u.cnt; const int* lst = LIST + (size_t)u.e * T;
#pragma unroll
            for (int h = 0; h < 2; ++h)
#pragma unroll
                for (int i = 0; i < 2; ++i) { int p = pos0 + h * 128 + R[i]; p = p < cnt ? p : cnt - 1; off[h][i] = (unsigned)(lst[p] * D + C[i] * 2); }
        } else {
            base = A + (size_t)u.pm * 256 * DFF;
#pragma unroll
            for (int h = 0; h < 2; ++h)
#pragma unroll
                for (int i = 0; i < 2; ++i) off[h][i] = (unsigned)((h * 128 + R[i]) * DFF + C[i] * 2);
        }
    }
    __device__ __forceinline__ void a_pre(const pg8::Unit& u, const int (&R)[2], unsigned (&pre)[2][2]) const {
        if constexpr (GATHER) { const int pos0 = u.pos0, cnt = u.cnt; const int* lst = LIST + (size_t)u.e * T;
#pragma unroll
            for (int h = 0; h < 2; ++h)
#pragma unroll
                for (int i = 0; i < 2; ++i) { int p = pos0 + h * 128 + R[i]; p = p < cnt ? p : cnt - 1; const int* ptr = lst + p;
                    asm volatile("global_load_dword %0, %1, off" : "=v"(pre[h][i]) : "v"(ptr)); }
        }
    }
    __device__ __forceinline__ void a_post(const pg8::Unit& u, unsigned (&pre)[2][2], const int (&R)[2], const int (&C)[2], const char*& base, unsigned (&off)[2][2]) const {
        if constexpr (GATHER) { base = A;
#pragma unroll
            for (int h = 0; h < 2; ++h)
#pragma unroll
                for (int i = 0; i < 2; ++i) { asm volatile("" : "+v"(pre[h][i])); off[h][i] = pre[h][i] * (unsigned)D + (unsigned)(C[i] * 2); }
        } else a_view(u, R, C, base, off);
    }
    __device__ __forceinline__ const char* b_base(const pg8::Unit& u) const { return W + ((size_t)u.e * wrows + (size_t)u.pn * 256) * D; }
};
typedef float f32x2v __attribute__((ext_vector_type(2)));
__device__ __forceinline__ f32x2v swiglu_pk(f32x2v accg, f32x2v accl, f32x2v rs2, f32x2v bgv, f32x2v blv) {
    f32x2v g = __builtin_elementwise_fma(accg, rs2, bgv), l = __builtin_elementwise_fma(accl, rs2, blv);
    g.x = fminf(g.x, 7.f); g.y = fminf(g.y, 7.f); l.x = __builtin_amdgcn_fmed3f(l.x, -7.f, 7.f); l.y = __builtin_amdgcn_fmed3f(l.y, -7.f, 7.f);
    f32x2v z = g * -2.45546696f;
    f32x2v e; e.x = __builtin_amdgcn_exp2f(z.x); e.y = __builtin_amdgcn_exp2f(z.y);
    e = e + 1.0f; f32x2v r; r.x = __builtin_amdgcn_rcpf(e.x); r.y = __builtin_amdgcn_rcpf(e.y);
    return (g * r) * (l + 1.0f);
}
struct EpiGateUp8 {
    const LAS int* tb; const LAS int* cn; const float* LRS; const float* bgu; unsigned char* ACT8; const LAS float* sc; unsigned scb;
    __device__ __forceinline__ void pre(const pg8::Unit& u, int wid, int lane, int par) const {
        const float* src;
        if (wid < 4) { const int pos0 = u.pos0, cnt = u.cnt; int p = pos0 + wid * 64 + lane; p = p < cnt ? p : cnt - 1; src = LRS + (size_t)u.e * T + p; }
        else { const int q = wid - 4; src = bgu + (size_t)u.e * 2 * DFF + (q >> 1) * DFF + u.pn * 128 + (q & 1) * 64 + lane; }
        glds4(src, (unsigned)__builtin_amdgcn_readfirstlane((int)(scb + par * 2048 + wid * 256)));
    }
    __device__ __forceinline__ void operator()(const f32x4 (&acc)[2][2][4][2], const pg8::Unit& u, int wr, int wc, int fr, int fq, int par) const {
        asm volatile("" : "+v"(fr));
        const LAS float* scp = sc + par * 512;
        const int j0 = u.pn * 128 + wc * 32 + 8 * fq, jl = wc * 32 + 8 * fq;
        const f32x4 bg0 = *(const LAS f32x4*)(scp + 256 + jl), bg1 = *(const LAS f32x4*)(scp + 256 + jl + 4), bl0 = *(const LAS f32x4*)(scp + 384 + jl), bl1 = *(const LAS f32x4*)(scp + 384 + jl + 4);
        unsigned char* abase = ACT8 + (size_t)u.pm * 256 * DFF; v2u wk[2];
#pragma unroll
        for (int ai = 0; ai < 2; ++ai)
#pragma unroll
            for (int m = 0; m < 4; ++m) { const int rl = ai * 128 + wr * 64 + m * 16 + fr; const float rs = scp[rl]; const f32x2v rs2 = {rs, rs};
                const f32x4 ag0 = acc[ai][0][m][0], ag1 = acc[ai][0][m][1], al0 = acc[ai][1][m][0], al1 = acc[ai][1][m][1];
                const f32x2v o0 = swiglu_pk((f32x2v){ag0[0], ag0[1]}, (f32x2v){al0[0], al0[1]}, rs2, (f32x2v){bg0[0], bg0[1]}, (f32x2v){bl0[0], bl0[1]});
                const f32x2v o1 = swiglu_pk((f32x2v){ag0[2], ag0[3]}, (f32x2v){al0[2], al0[3]}, rs2, (f32x2v){bg0[2], bg0[3]}, (f32x2v){bl0[2], bl0[3]});
                const f32x2v o2 = swiglu_pk((f32x2v){ag1[0], ag1[1]}, (f32x2v){al1[0], al1[1]}, rs2, (f32x2v){bg1[0], bg1[1]}, (f32x2v){bl1[0], bl1[1]});
                const f32x2v o3 = swiglu_pk((f32x2v){ag1[2], ag1[3]}, (f32x2v){al1[2], al1[3]}, rs2, (f32x2v){bg1[2], bg1[3]}, (f32x2v){bl1[2], bl1[3]});
                v2u w; w.x = pk4_fp8(o0.x, o0.y, o1.x, o1.y); w.y = pk4_fp8(o2.x, o2.y, o3.x, o3.y);
                if (m & 1) {
                    const int rl2 = (fq & 1) ? rl : rl - 16;
                    *(v4u*)(abase + (size_t)rl2 * DFF + j0 - ((fq & 1) ? 8 : 0)) = pair16(wk[ai], w);
                } else wk[ai] = w; }
    }
};
struct EpiDown {
    const float* bdn; unsigned char* YK8; const LAS float* sc; unsigned scb;
    __device__ __forceinline__ void pre(const pg8::Unit& u, int wid, int lane, int par) const {
        if (wid < 4) glds4(bdn + (size_t)u.e * D + u.pn * 256 + wid * 64 + lane, (unsigned)__builtin_amdgcn_readfirstlane((int)(scb + par * 2048 + wid * 256)));
    }
    __device__ __forceinline__ void operator()(const f32x4 (&acc)[2][2][4][2], const pg8::Unit& u, int wr, int wc, int fr, int fq, int par) const {
        asm volatile("" : "+v"(fr));
        const LAS float* scp = sc + par * 512; const int row0 = u.pm * 256 + wr * 64 + fr, col0 = u.pn * 256 + wc * 32 + 8 * fq, cl = wc * 32 + 8 * fq;
        f32x4 bv[2][2];
#pragma unroll
        for (int bj = 0; bj < 2; ++bj)
#pragma unroll
            for (int n = 0; n < 2; ++n) bv[bj][n] = *(const LAS f32x4*)(scp + cl + bj * 128 + 4 * n);
#pragma unroll
        for (int ai = 0; ai < 2; ++ai)
#pragma unroll
            for (int m = 0; m < 4; ++m) { unsigned char* rowp = YK8 + (size_t)(row0 + ai * 128 + m * 16) * D + col0;
                v2u wb[2];
#pragma unroll
                for (int bj = 0; bj < 2; ++bj) { const f32x4 v0 = acc[ai][bj][m][0] + bv[bj][0], v1 = acc[ai][bj][m][1] + bv[bj][1];
                    wb[bj].x = pk4_fp8(v0[0], v0[1], v0[2], v0[3]); wb[bj].y = pk4_fp8(v1[0], v1[1], v1[2], v1[3]); }
                *(v4u*)(rowp + ((fq & 1) ? 120 : 0)) = pair16(wb[0], wb[1]); }
    }
};

__device__ __forceinline__ void p7_final(Frame& F_) {
    Frame F = F_; { int t_ = F.tid; asm volatile("" : "+v"(t_)); F.tid = t_; F.lane = t_ & 63; }
    const LAS int* tb = (const LAS int*)(F.lds + L_ETAB);
    const bf16* X1 = (const bf16*)(F.ws + WS_X1B); const unsigned char* YK = F.ws + WS_YK; const unsigned* TI = (const unsigned*)(F.ws + WS_TOKINFO); const float* GA = (const float*)(F.ws + WS_GATE);
    const float* gf = F.in[I_GF]; float* out = (float*)F.dout;
    const int gw = F.vcu * NWAVES + F.wave, NGW = F.G * NWAVES;
    f32x4 gfr[4];
#pragma unroll
    for (int j = 0; j < 4; ++j) gfr[j] = *((const f32x4*)gf + F.lane + 64 * j);
    v4u ti_n[2]; f32x4 ga_n[2];
#pragma unroll
    for (int r = 0; r < 2; ++r) { const int tt = gw + r * NGW; const int tc = tt < T ? tt : 0; ti_n[r] = *(const v4u*)(TI + (size_t)tc * 4); ga_n[r] = *(const f32x4*)(GA + (size_t)tc * 4); }
    for (int t0 = gw; t0 < T; t0 += 2 * NGW) {
        v4u ti[2]; f32x4 ga[2];
#pragma unroll
        for (int r = 0; r < 2; ++r) { ti[r] = ti_n[r]; ga[r] = ga_n[r]; }
#pragma unroll
        for (int r = 0; r < 2; ++r) { const int tt = t0 + (2 + r) * NGW; const int tc = tt < T ? tt : 0; ti_n[r] = *(const v4u*)(TI + (size_t)tc * 4); ga_n[r] = *(const f32x4*)(GA + (size_t)tc * 4); }
        v2u xw[2][4]; int yw[2][4][4];
#pragma unroll
        for (int r = 0; r < 2; ++r) { const int tt = t0 + r * NGW; const int t = tt < T ? tt : t0;
            const unsigned tw[4] = {ti[r].x, ti[r].y, ti[r].z, ti[r].w};
#pragma unroll
            for (int j = 0; j < 4; ++j) xw[r][j] = *((const v2u*)(X1 + (size_t)t * D) + F.lane + 64 * j);
#pragma unroll
            for (int k = 0; k < 4; ++k) { const unsigned char* yr = YK + (size_t)(256 * tb[tw[k] >> 20] + (int)(tw[k] & 0xfffffu)) * D;
#pragma unroll
                for (int j = 0; j < 4; ++j) yw[r][k][j] = *((const int*)yr + F.lane + 64 * j); } }
#pragma unroll
        for (int r = 0; r < 2; ++r) { const int t = t0 + r * NGW; if (t >= T) break;
            f32x4 v[4]; float ss = 0.f;
#pragma unroll
            for (int j = 0; j < 4; ++j) { const v2u w = xw[r][j];
                f32x4 a; a.x = bflo(w.x); a.y = bfhi(w.x); a.z = bflo(w.y); a.w = bfhi(w.y);
#pragma unroll
                for (int k = 0; k < 4; ++k) { const int y = yw[r][k][j]; const float gk = ga[r][k];
                    a.x += gk * __builtin_amdgcn_cvt_f32_fp8(y, 0); a.y += gk * __builtin_amdgcn_cvt_f32_fp8(y, 1); a.z += gk * __builtin_amdgcn_cvt_f32_fp8(y, 2); a.w += gk * __builtin_amdgcn_cvt_f32_fp8(y, 3); }
                v[j] = a; ss += a.x * a.x + a.y * a.y + a.z * a.z + a.w * a.w; }
            const float rs = rsqrtf(wave_sum(ss) * (1.f / D) + EPS);
#pragma unroll
            for (int j = 0; j < 4; ++j) *((f32x4*)(out + (size_t)t * D) + F.lane + 64 * j) = v[j] * rs * gfr[j];
        }
    }
}

__global__ void __launch_bounds__(NTHR, 2) hymba_fwd(Args args) {
    extern __shared__ __attribute__((aligned(16))) unsigned char lds[];
    Frame F;
    F.lds = (LAS unsigned char*)lds;
    F.tid = threadIdx.x; F.lane = F.tid & 63; F.wave = __builtin_amdgcn_readfirstlane(F.tid >> 6);
    F.G = gridDim.x; { const int bx = blockIdx.x; F.vcu = (F.G % 8 == 0) ? (bx % 8) * (F.G / 8) + bx / 8 : bx; }
    F.ws = args.ws; F.dout = (unsigned char*)args.out; F.ctl = (unsigned*)(args.ws + WS_CTL);
#pragma unroll
    for (int i = 0; i < 23; ++i) F.in[i] = args.in[i];
    for (int u = F.tid; u < (LDS_BYTES - LDSCTL_OFF) / 4; u += NTHR) ((LAS unsigned*)(F.lds + LDSCTL_OFF))[u] = 0u;
    __syncthreads();
    XcdBarrier bar = xcd_barrier_post(F.ctl + CW_BAR, (volatile LAS unsigned*)(F.lds + MISC_OFF) + 8);

#ifndef PROBE_DUP
#define PROBE_DUP (-1)
#endif
#define RUN_PHASE(n, ...) do { __VA_ARGS__; if (PROBE_DUP == (n)) { xcd_barrier(bar); __VA_ARGS__; } } while (0)
    const LAS int* etb = (const LAS int*)(F.lds + L_ETAB);
    RUN_PHASE(0, p0_prologue(F));
    xcd_barrier(bar);
    RUN_PHASE(1, { DenseSched S; S.ord.init(T / 256, 12, F.G, (int)blockIdx.x); S.A = (const char*)(F.ws + WS_XN); S.Bt = (const char*)(F.ws + WS_WIN); S.K = D;
        EpiProj E{F.ws}; pg8::gemm_phase<EpiProj, DenseSched, true, true>(F.lds, D / 64, D * 2, S, E); });
    xcd_barrier(bar);
    { const float lam = compute_lambda(F);
      p2_attn_setup(F);
#pragma unroll 1
      for (int rep = 0; rep < (PROBE_DUP == 2 ? 2 : 1); ++rep) {
          if (rep) xcd_barrier(bar);
          for (int v = F.vcu; v < 256; v += F.G) { const int bh = v >> 2, ty = v & 3;
              if (ty == 0) p2_mlstm_fast(F, bh);
              const unsigned long long sched = ty == 0 ? 0x012ull : ty == 1 ? 0xDEFull : ty == 2 ? 0x8ABCull : 0x345679ull;
              const int nq = ty == 0 ? 3 : ty == 1 ? 3 : ty == 2 ? 4 : 6;
              const int pk0 = ty == 0 ? 0 : ty == 1 ? 10 : ty == 2 ? 24 : 34, pk1 = ty == 0 ? 10 : ty == 1 ? 24 : ty == 2 ? 34 : 48, nslot = ty == 2 ? 2 : 3; int slot = 0;
              attn_body::bf16x8 qr[4];
#pragma unroll 1
              for (int i = nq - 1, j = 0; i >= 0; --i, ++j) { const bool has = ty < 2 || (j & 1);
                  const int i0 = pk0 + (pk1 - pk0) * slot / nslot, i1 = pk0 + (pk1 - pk0) * (slot + 1) / nslot;
                  p2_attn_unit(F, lds, bh, (int)((sched >> (4 * i)) & 15ull), i > 0 ? (int)((sched >> (4 * (i - 1))) & 15ull) : -1, qr, j > 0, lam, has ? bh : -1, i0, i1); if (has) ++slot; }
          }
      }
    }
    xcd_barrier(bar);
    RUN_PHASE(3, { DenseSched8 S; S.ord.init(T / 256, 4, F.G, (int)blockIdx.x); S.A = (const char*)(F.ws + WS_MIX8); S.Bt = (const char*)(F.ws + WS_WOUT); S.K = D;
        EpiOutProj E{(const bf16*)(F.ws + WS_XN), (const float*)(F.ws + WS_RSTD1), (bf16*)(F.ws + WS_X1B), F.ws + WS_X1F8, (const LAS float*)(F.lds + L_EPI), (unsigned)(uintptr_t)(F.lds + L_EPI)}; pg8::gemm_phase<EpiOutProj, DenseSched8, true, true, true, 0x79797979, 0x7f7f7f7f>(F.lds, D / 128, D, S, E); });
    xcd_barrier(bar);
    p4_route(F);
    xcd_barrier(bar);
    p4b_lists(F);
    xcd_barrier(bar);
    RUN_PHASE(5, { MoeSched8<true> S; S.ord.init(etb[NE], 8, F.G, (int)blockIdx.x); S.tb = etb; S.cn = etb + 40; S.A = (const char*)(F.ws + WS_X1F8); S.W = (const char*)(F.ws + WS_WGU); S.LIST = (const int*)(F.ws + WS_LIST); S.wrows = 2 * DFF; S.pe = (const LAS unsigned char*)(F.lds + L_PEXP);
        EpiGateUp8 E{etb, etb + 40, (const float*)(F.ws + WS_LISTRS), F.in[I_BGU], F.ws + WS_ACT, (const LAS float*)(F.lds + L_EPI), (unsigned)(uintptr_t)(F.lds + L_EPI)};
        pg8::gemm_phase<EpiGateUp8, MoeSched8<true>, true, true, true, 0x79797979, 0x7f7f7f7f>(F.lds, D / 128, D, S, E); });
    xcd_barrier(bar);
    RUN_PHASE(6, { MoeSched8<false> S; S.ord.init(etb[NE], 4, F.G, (int)blockIdx.x); S.tb = etb; S.cn = etb + 40; S.A = (const char*)(F.ws + WS_ACT); S.W = (const char*)(F.ws + WS_WDOWN); S.LIST = nullptr; S.wrows = D; S.pe = (const LAS unsigned char*)(F.lds + L_PEXP);
        EpiDown E{F.in[I_BDN], F.ws + WS_YK, (const LAS float*)(F.lds + L_EPI), (unsigned)(uintptr_t)(F.lds + L_EPI)};
        pg8::gemm_phase<EpiDown, MoeSched8<false>, true, true, true, 0x79797979, 0x7f7f7f7f>(F.lds, DFF / 128, DFF, S, E); });
    xcd_barrier(bar);
    RUN_PHASE(7, p7_final(F));
}

extern "C" void kernel_launch(void* const* d_in, const int* in_sizes, int n_in, void* d_out, int out_size, void* d_ws, size_t ws_size, hipStream_t stream) {
    static int grid = 0;
    if (grid == 0) {
        if (n_in != 23 || in_sizes[0] != T * D || out_size != T * D || ws_size < WS_END) { fprintf(stderr, "kernel_launch: unexpected shapes (n_in %d, in0 %d, out %d, ws %zu); nothing launched\n", n_in, n_in > 0 ? in_sizes[0] : -1, out_size, ws_size); grid = -1; return; }
        int dev = 0, cus = 0, per_cu = 0;
        if (hipGetDevice(&dev) != hipSuccess || hipDeviceGetAttribute(&cus, hipDeviceAttributeMultiprocessorCount, dev) != hipSuccess) { grid = -1; return; }
        if (hipFuncSetAttribute((const void*)hymba_fwd, hipFuncAttributeMaxDynamicSharedMemorySize, LDS_BYTES) != hipSuccess) { fprintf(stderr, "kernel_launch: hipFuncSetAttribute failed\n"); grid = -1; return; }
        if (hipOccupancyMaxActiveBlocksPerMultiprocessor(&per_cu, (const void*)hymba_fwd, NTHR, LDS_BYTES) != hipSuccess || per_cu < 1) fprintf(stderr, "kernel_launch: occupancy query reports %d\n", per_cu);
        (void)hipGetLastError();
        grid = cus;
    }
    if (grid < 0) return;
    if (hipMemsetAsync((char*)d_ws + WS_CTL, 0, CTL_ZERO_BYTES, stream) != hipSuccess) return;
    Args a{};
    for (int i = 0; i < 23; ++i) a.in[i] = (const float*)d_in[i];
    a.out = (float*)d_out; a.ws = (unsigned char*)d_ws;
    hipLaunchKernelGGL(hymba_fwd, dim3(grid), dim3(NTHR), LDS_BYTES, stream, a);
}
```
